# Optimizing an MI355X kernel written in HIP

```python
import jax
import jax.numpy as jnp
from jax import lax
import numpy as np

D_MODEL = 1024
BATCH = 8
SEQ = 4096
DEPTH = 2
DEC_BATCH = 4
DEC_SEQ = 8192
PAST_LEN = 128

GRID_W = 64
HEAD_DIM = 64
NA_HEADS = 8
NA_WIN_H = 8
NA_WIN_W = 16
MLA_HEADS = 8
MLA_Q_RANK = 256
MLA_KV_RANK = 128
MLA_NOPE = 64
MLA_ROPE = 32
MLA_V = 64
MLA_BLOCK = 128
DIL_PAIRS = ((128, 1), (512, 4), (2048, 16))
DIL_HEADS = 8
DIL_BLOCK = 128
N_EXPERTS = 16
EC_CAPACITY = 2
EXPERT_FF = 2816
ROPE_THETA = 10000.0
LN_EPS = 1e-5
RMS_EPS = 1e-6
DEEPNORM_ALPHA = (2 * DEPTH) ** 0.25
DEEPNORM_BETA = (8 * DEPTH) ** -0.25
N_AB_LAYERS = (DEPTH + 1) // 2
N_C_LAYERS = DEPTH // 2
NA_WIDTH = NA_HEADS * HEAD_DIM
MLA_Q_COLS = MLA_HEADS * (MLA_NOPE + MLA_ROPE)
MLA_KV_COLS = MLA_HEADS * (MLA_NOPE + MLA_V)
AB_IN_COLS = 3 * NA_WIDTH + MLA_Q_RANK + MLA_KV_RANK + MLA_ROPE
AB_OUT_COLS = NA_WIDTH + MLA_HEADS * MLA_V
DIL_WIDTH = DIL_HEADS * HEAD_DIM
DIL_IN_COLS = 3 * len(DIL_PAIRS) * DIL_WIDTH

kernel_name = 'hybrid_na_mla_dilated_ec_encoder'


def layer_norm(x, g, b):
    xf = x.astype(jnp.float32)
    mu = jnp.mean(xf, -1, keepdims=True)
    var = jnp.mean(jnp.square(xf - mu), -1, keepdims=True)
    return ((xf - mu) * lax.rsqrt(var + LN_EPS) * g + b).astype(x.dtype)


def rms_norm(x, g):
    xf = x.astype(jnp.float32)
    return (xf * lax.rsqrt(jnp.mean(xf * xf, -1, keepdims=True) + RMS_EPS) * g).astype(x.dtype)


def rope_tables(n, dim):
    inv = 1.0 / (ROPE_THETA ** (jnp.arange(0, dim, 2, dtype=jnp.float32) / dim))
    ang = jnp.arange(n, dtype=jnp.float32)[:, None] * inv[None, :]
    return jnp.cos(ang), jnp.sin(ang)


def apply_rope(x, cos, sin):
    x1, x2 = jnp.split(x.astype(jnp.float32), 2, axis=-1)
    c = cos[:, None, :]
    s = sin[:, None, :]
    return jnp.concatenate([x1 * c - x2 * s, x1 * s + x2 * c], axis=-1).astype(x.dtype)


def ada_modulation(c, w, b):
    mod = jax.nn.silu(c) @ w + b
    shift, scale, gate = jnp.split(mod[:, None, :], 3, axis=-1)
    return shift, scale, gate


def neighbourhood_attention(q, k, v, rpb):
    B, S, H, dh = q.shape
    rows = S // GRID_W
    kh = min(NA_WIN_H, rows)
    kw = NA_WIN_W
    qg = q.reshape(B, rows, GRID_W, H, dh)
    kg = k.reshape(B, rows, GRID_W, H, dh)
    vg = v.reshape(B, rows, GRID_W, H, dh)
    cols = jnp.arange(GRID_W)
    c0 = jnp.clip(cols - kw // 2, 0, GRID_W - kw)
    col_idx = c0[:, None] + jnp.arange(kw)[None, :]
    col_off = col_idx - cols[:, None] + (NA_WIN_W - 1)
    scale = dh ** -0.5

    def row_step(args):
        r, q_row = args
        r0 = jnp.clip(r - kh // 2, 0, rows - kh)
        k_rows = lax.dynamic_slice_in_dim(kg, r0, kh, axis=1)
        v_rows = lax.dynamic_slice_in_dim(vg, r0, kh, axis=1)
        k_win = k_rows[:, :, col_idx]
        v_win = v_rows[:, :, col_idx]
        row_off = r0 + jnp.arange(kh) - r + (NA_WIN_H - 1)
        bias = rpb[:, row_off[:, None, None], col_off[None, :, :]]
        s = jnp.einsum('bqhd,brqjhd->bhqrj', q_row, k_win).astype(jnp.float32) * scale
        s = s + jnp.transpose(bias, (0, 2, 1, 3))[None].astype(jnp.float32)
        p = jax.nn.softmax(s.reshape(B, H, GRID_W, kh * kw), axis=-1)
        p = p.reshape(B, H, GRID_W, kh, kw).astype(v.dtype)
        return jnp.einsum('bhqrj,brqjhd->bqhd', p, v_win)

    out = lax.map(row_step, (jnp.arange(rows), jnp.moveaxis(qg, 1, 0)))
    return jnp.moveaxis(out, 0, 1).reshape(B, S, H, dh)


def mla_attention(q_lat, kv_lat, k_rope, q_norm, w_q_up, kv_norm, w_kv_up, cos_r, sin_r):
    B, S, _ = q_lat.shape
    q = (rms_norm(q_lat, q_norm) @ w_q_up).reshape(B, S, MLA_HEADS, MLA_NOPE + MLA_ROPE)
    q_nope = q[..., :MLA_NOPE]
    q_pe = apply_rope(q[..., MLA_NOPE:], cos_r, sin_r)
    kv = (rms_norm(kv_lat, kv_norm) @ w_kv_up).reshape(B, S, MLA_HEADS, MLA_NOPE + MLA_V)
    k_nope = kv[..., :MLA_NOPE]
    v = kv[..., MLA_NOPE:]
    k_pe = apply_rope(k_rope[:, :, None, :], cos_r, sin_r)[:, :, 0]
    scale = (MLA_NOPE + MLA_ROPE) ** -0.5
    nblk = S // MLA_BLOCK
    qn_blocks = q_nope.reshape(B, nblk, MLA_BLOCK, MLA_HEADS, MLA_NOPE).swapaxes(0, 1)
    qp_blocks = q_pe.reshape(B, nblk, MLA_BLOCK, MLA_HEADS, MLA_ROPE).swapaxes(0, 1)

    def block(args):
        qn, qp = args
        s = (jnp.einsum('bqhd,bkhd->bhqk', qn, k_nope).astype(jnp.float32)
             + jnp.einsum('bqhd,bkd->bhqk', qp, k_pe).astype(jnp.float32)) * scale
        p = jax.nn.softmax(s, axis=-1).astype(v.dtype)
        return jnp.einsum('bhqk,bkhd->bqhd', p, v)

    out = lax.map(block, (qn_blocks, qp_blocks))
    return out.swapaxes(0, 1).reshape(B, S, MLA_HEADS * MLA_V)


def na_mla_mixer(h, w_in, rpb, q_norm, w_q_up, kv_norm, w_kv_up, w_out, cos_r, sin_r):
    B, S, _ = h.shape
    proj = h @ w_in
    s1 = 3 * NA_WIDTH
    s2 = s1 + MLA_Q_RANK
    s3 = s2 + MLA_KV_RANK
    na_qkv = proj[..., :s1].reshape(B, S, 3, NA_HEADS, HEAD_DIM)
    na_out = neighbourhood_attention(na_qkv[:, :, 0], na_qkv[:, :, 1], na_qkv[:, :, 2], rpb)
    mla_out = mla_attention(proj[..., s1:s2], proj[..., s2:s3], proj[..., s3:],
                            q_norm, w_q_up, kv_norm, w_kv_up, cos_r, sin_r)
    return jnp.concatenate([na_out.reshape(B, S, NA_WIDTH), mla_out], axis=-1) @ w_out


def dilated_group(q, k, v, window, dilation):
    B, S, H, dh = q.shape
    half = (window // 2) // dilation
    offs = dilation * jnp.arange(-half, half + 1)
    nblk = S // DIL_BLOCK
    q_blocks = q.reshape(B, nblk, DIL_BLOCK, H, dh).swapaxes(0, 1)
    scale = dh ** -0.5

    def block(args):
        i, qb = args
        pos = i * DIL_BLOCK + jnp.arange(DIL_BLOCK)
        idx = pos[:, None] + offs[None, :]
        valid = (idx >= 0) & (idx < S)
        idx = jnp.clip(idx, 0, S - 1)
        kb = k[:, idx]
        vb = v[:, idx]
        s = jnp.einsum('bqhd,bqnhd->bhqn', qb, kb).astype(jnp.float32) * scale
        s = jnp.where(valid[None, None], s, -jnp.inf)
        lse = jax.nn.logsumexp(s, axis=-1, keepdims=True)
        p = jnp.exp(s - lse).astype(v.dtype)
        o = jnp.einsum('bhqn,bqnhd->bqhd', p, vb)
        return o, jnp.transpose(lse[..., 0], (0, 2, 1))

    o, lse = lax.map(block, (jnp.arange(nblk), q_blocks))
    return o.swapaxes(0, 1).reshape(B, S, H, dh), lse.swapaxes(0, 1).reshape(B, S, H)


def dilated_mixer(h, w_in, w_out, cos_h, sin_h):
    B, S, _ = h.shape
    qkv = (h @ w_in).reshape(B, S, len(DIL_PAIRS), 3, DIL_HEADS, HEAD_DIM)
    outs = []
    lses = []
    for g, (window, dilation) in enumerate(DIL_PAIRS):
        q = apply_rope(qkv[:, :, g, 0], cos_h, sin_h)
        k = apply_rope(qkv[:, :, g, 1], cos_h, sin_h)
        o, lse = dilated_group(q, k, qkv[:, :, g, 2], window, dilation)
        outs.append(o)
        lses.append(lse)
    wts = jax.nn.softmax(jnp.stack(lses, axis=0), axis=0).astype(h.dtype)
    out = jnp.einsum('gbsh,gbshd->bshd', wts, jnp.stack(outs, axis=0))
    return out.reshape(B, S, DIL_WIDTH) @ w_out


def expert_choice_ffn(h, w_router, w_gate, w_up, w_down):
    B, S, D = h.shape
    n_tok = B * S
    cap = EC_CAPACITY * n_tok // N_EXPERTS
    xt = h.reshape(n_tok, D)
    aff = jax.nn.softmax((xt @ w_router).astype(jnp.float32), axis=-1)
    gates, idx = lax.top_k(aff.T, cap)

    def expert(args):
        wg, wu, wd, ix = args
        xe = xt[ix]
        return (jax.nn.silu(xe @ wg) * (xe @ wu)) @ wd

    ye = lax.map(expert, (w_gate, w_up, w_down, idx))
    contrib = (gates[..., None].astype(ye.dtype) * ye).reshape(-1, D)
    y = jnp.zeros_like(xt).at[idx.reshape(-1)].add(contrib)
    return y.reshape(B, S, D)


def trunk(x, c, ab_w_in, na_rpb, mla_q_norm, mla_w_q_up, mla_kv_norm, mla_w_kv_up, ab_w_out,
          dil_w_in, dil_w_out, mix_ada_w, mix_ada_b, mix_ln_g, mix_ln_b,
          moe_ada_w, moe_ada_b, moe_ln_g, moe_ln_b, moe_w_router, moe_w_gate, moe_w_up, moe_w_down):
    S = x.shape[1]
    cos_h, sin_h = rope_tables(S, HEAD_DIM)
    cos_r, sin_r = rope_tables(S, MLA_ROPE)
    for layer in range(DEPTH):
        j = layer // 2
        shift, scale, gate = ada_modulation(c, mix_ada_w[layer], mix_ada_b[layer])
        h = x * (1 + scale) + shift
        if layer % 2 == 0:
            out = na_mla_mixer(h, ab_w_in[j], na_rpb[j], mla_q_norm[j], mla_w_q_up[j],
                               mla_kv_norm[j], mla_w_kv_up[j], ab_w_out[j], cos_r, sin_r)
        else:
            out = dilated_mixer(h, dil_w_in[j], dil_w_out[j], cos_h, sin_h)
        x = layer_norm(DEEPNORM_ALPHA * x + gate * out, mix_ln_g[layer], mix_ln_b[layer])
        shift, scale, gate = ada_modulation(c, moe_ada_w[layer], moe_ada_b[layer])
        h = x * (1 + scale) + shift
        out = expert_choice_ffn(h, moe_w_router[layer], moe_w_gate[layer], moe_w_up[layer],
                                moe_w_down[layer])
        x = layer_norm(DEEPNORM_ALPHA * x + gate * out, moe_ln_g[layer], moe_ln_b[layer])
    return x


def setup_inputs(seed: int = 0) -> dict:
    key = jax.random.key(seed)
    ks = jax.random.split(key, 25)
    D = D_MODEL
    L = DEPTH
    La = N_AB_LAYERS
    Lc = N_C_LAYERS

    def nrm(k, shape, std):
        return jax.random.normal(k, shape, jnp.float32) * std

    return {
        'x_prompt': nrm(ks[0], (BATCH, SEQ, D), 1.0),
        'x_sample': nrm(ks[1], (DEC_BATCH, DEC_SEQ, D), 1.0),
        'c_prompt': nrm(ks[2], (BATCH, D), 1.0),
        'c_sample': nrm(ks[3], (DEC_BATCH, D), 1.0),
        'ab_w_in': nrm(ks[4], (La, D, AB_IN_COLS), D ** -0.5),
        'na_rpb': nrm(ks[5], (La, NA_HEADS, 2 * NA_WIN_H - 1, 2 * NA_WIN_W - 1), 0.1),
        'mla_q_norm': 1.0 + nrm(ks[6], (La, MLA_Q_RANK), 0.01),
        'mla_w_q_up': nrm(ks[7], (La, MLA_Q_RANK, MLA_Q_COLS), MLA_Q_RANK ** -0.5),
        'mla_kv_norm': 1.0 + nrm(ks[8], (La, MLA_KV_RANK), 0.01),
        'mla_w_kv_up': nrm(ks[9], (La, MLA_KV_RANK, MLA_KV_COLS), MLA_KV_RANK ** -0.5),
        'ab_w_out': nrm(ks[10], (La, AB_OUT_COLS, D), DEEPNORM_BETA * AB_OUT_COLS ** -0.5),
        'dil_w_in': nrm(ks[11], (Lc, D, DIL_IN_COLS), D ** -0.5),
        'dil_w_out': nrm(ks[12], (Lc, DIL_WIDTH, D), DEEPNORM_BETA * DIL_WIDTH ** -0.5),
        'mix_ada_w': nrm(ks[13], (L, D, 3 * D), 0.5 * D ** -0.5),
        'mix_ada_b': nrm(ks[14], (L, 3 * D), 0.01),
        'mix_ln_g': 1.0 + nrm(ks[15], (L, D), 0.01),
        'mix_ln_b': nrm(ks[16], (L, D), 0.01),
        'moe_ada_w': nrm(ks[17], (L, D, 3 * D), 0.5 * D ** -0.5),
        'moe_ada_b': nrm(ks[18], (L, 3 * D), 0.01),
        'moe_ln_g': 1.0 + nrm(ks[19], (L, D), 0.01),
        'moe_ln_b': nrm(ks[20], (L, D), 0.01),
        'moe_w_router': nrm(ks[21], (L, D, N_EXPERTS), D ** -0.5),
        'moe_w_gate': nrm(ks[22], (L, N_EXPERTS, D, EXPERT_FF), D ** -0.5),
        'moe_w_up': nrm(ks[23], (L, N_EXPERTS, D, EXPERT_FF), D ** -0.5),
        'moe_w_down': nrm(ks[24], (L, N_EXPERTS, EXPERT_FF, D), DEEPNORM_BETA * EXPERT_FF ** -0.5),
    }


def reference(x_prompt, x_sample, c_prompt, c_sample, ab_w_in, na_rpb, mla_q_norm, mla_w_q_up,
              mla_kv_norm, mla_w_kv_up, ab_w_out, dil_w_in, dil_w_out, mix_ada_w, mix_ada_b,
              mix_ln_g, mix_ln_b, moe_ada_w, moe_ada_b, moe_ln_g, moe_ln_b, moe_w_router,
              moe_w_gate, moe_w_up, moe_w_down):
    y_prompt = trunk(x_prompt, c_prompt, ab_w_in, na_rpb, mla_q_norm, mla_w_q_up, mla_kv_norm,
                     mla_w_kv_up, ab_w_out, dil_w_in, dil_w_out, mix_ada_w, mix_ada_b, mix_ln_g,
                     mix_ln_b, moe_ada_w, moe_ada_b, moe_ln_g, moe_ln_b, moe_w_router, moe_w_gate,
                     moe_w_up, moe_w_down)
    y_sample = trunk(x_sample, c_sample, ab_w_in, na_rpb, mla_q_norm, mla_w_q_up, mla_kv_norm,
                     mla_w_kv_up, ab_w_out, dil_w_in, dil_w_out, mix_ada_w, mix_ada_b, mix_ln_g,
                     mix_ln_b, moe_ada_w, moe_ada_b, moe_ln_g, moe_ln_b, moe_w_router, moe_w_gate,
                     moe_w_up, moe_w_down)
    return (y_prompt, y_sample)
```

```cpp
#include <hip/hip_runtime.h>
#include <hip/hip_bf16.h>
#include <cstdio>
#include <cstdint>
#include <cmath>

#define LAS __attribute__((address_space(3)))
#define GAS __attribute__((address_space(1)))
__device__ __forceinline__ int opaque_tid() { int t = threadIdx.x; asm volatile("" : "+v"(t)); return t; }

namespace pg8 {
typedef unsigned short bf16_t;
typedef short bf16x8 __attribute__((ext_vector_type(8)));
typedef float f32x4 __attribute__((ext_vector_type(4)));
typedef unsigned u32x4 __attribute__((ext_vector_type(4)));
constexpr int BM = 256, BK = 64, HALF = 128, HTB = HALF * BK * 2, STAGE_BYTES = 8 * HTB, NXCD = 8, WGM = 8;

__host__ __device__ __forceinline__ int lds_byte(int r, int c) { const int st = (r >> 4) * 2 + (c >> 5), rr = r & 15, cc = c & 31, ob = rr * 64 + cc * 2; return st * 1024 + (ob ^ (((ob >> 9) & 1) << 5)); }
__host__ __device__ __forceinline__ void stage_rc(int b, int& R, int& C) { const int st = b / 1024, sb = b % 1024, swz = sb ^ (((sb >> 9) & 1) << 5); R = (st >> 1) * 16 + swz / 64; C = (st & 1) * 32 + (swz % 64) / 2; }
__host__ __device__ __forceinline__ int perm32(int rho) { const int n = rho >> 4, i = rho & 15; return 8 * (i >> 2) + 4 * n + (i & 3); }

struct Unit { int pm, pn, pb; };
struct Gemm { const bf16_t* A; const bf16_t* Bt; int M, N, K; };

struct StaticOrder {
    int nM, nN, nwg, G, c, ne;
    __device__ void init(int M, int N, int G_, int c_, int ne_) { nM = M / BM; nN = N / BM; nwg = nM * nN; G = G_; c = c_; ne = ne_; }
    __device__ bool next(int i, Unit& u) const {
        const long L = (long)i * G + c; if (L >= nwg) return false;
        int wgid = (int)L; { const int q = nwg / NXCD, r = nwg % NXCD, xcd = wgid % NXCD, off = wgid / NXCD; wgid = (xcd < r ? xcd * (q + 1) : r * (q + 1) + (xcd - r) * q) + off; }
        const int nig = WGM * nN, gid = wgid / nig, fm = gid * WGM, gsz = (nM - fm) < WGM ? (nM - fm) : WGM;
        u.pm = fm + ((wgid % nig) % gsz); u.pn = (wgid % nig) / gsz; u.pb = ne ? (u.pm >> 4) * nN + u.pn : u.pn; return true;
    }
};

__device__ __forceinline__ unsigned cvt_pk_bf16(float lo, float hi) { unsigned r; asm volatile("v_cvt_pk_bf16_f32 %0, %1, %2" : "=v"(r) : "v"(lo), "v"(hi)); return r; }

struct EpiBf16 {
    static constexpr bool PERM = true;
    bf16_t* O; int ldc;
    __device__ __forceinline__ void operator()(const f32x4 (&acc)[2][2][4][2], const Unit& u, int wr, int wc, int fr, int fq) const {
        const int row0 = u.pm * BM + wr * 64 + fr; const int col0 = u.pn * BM + wc * 32 + 8 * fq;
#pragma unroll
        for (int ai = 0; ai < 2; ++ai)
#pragma unroll
            for (int m = 0; m < 4; ++m) { bf16_t* rowp = O + (size_t)(row0 + ai * HALF + m * 16) * ldc + col0;
#pragma unroll
                for (int bj = 0; bj < 2; ++bj) { const f32x4 v0 = acc[ai][bj][m][0], v1 = acc[ai][bj][m][1];
                    u32x4 w; w.x = cvt_pk_bf16(v0[0], v0[1]); w.y = cvt_pk_bf16(v0[2], v0[3]); w.z = cvt_pk_bf16(v1[0], v1[1]); w.w = cvt_pk_bf16(v1[2], v1[3]);
                    *(u32x4*)(rowp + bj * HALF) = w; } }
    }
};
__device__ __forceinline__ float silu_f(float g) { return g * __builtin_amdgcn_rcpf(1.0f + __builtin_amdgcn_exp2f(-1.4426950408889634f * g)); }
struct EpiSwiGlu {
    static constexpr bool PERM = true;
    bf16_t* O; int ldc;
    __device__ __forceinline__ void operator()(const f32x4 (&acc)[2][2][4][2], const Unit& u, int wr, int wc, int fr, int fq) const {
        const int row0 = u.pm * BM + wr * 64 + fr; const int col0 = u.pn * HALF + wc * 32 + 8 * fq;
#pragma unroll
        for (int ai = 0; ai < 2; ++ai)
#pragma unroll
            for (int m = 0; m < 4; ++m) { bf16_t* rowp = O + (size_t)(row0 + ai * HALF + m * 16) * ldc + col0;
                const f32x4 g0 = acc[ai][0][m][0], g1 = acc[ai][0][m][1], u0 = acc[ai][1][m][0], u1 = acc[ai][1][m][1];
                u32x4 w; w.x = cvt_pk_bf16(silu_f(g0[0]) * u0[0], silu_f(g0[1]) * u0[1]); w.y = cvt_pk_bf16(silu_f(g0[2]) * u0[2], silu_f(g0[3]) * u0[3]);
                w.z = cvt_pk_bf16(silu_f(g1[0]) * u1[0], silu_f(g1[1]) * u1[1]); w.w = cvt_pk_bf16(silu_f(g1[2]) * u1[2], silu_f(g1[3]) * u1[3]);
                *(u32x4*)rowp = w; }
    }
};

template <class Epi, class Sched>
__device__ __forceinline__ void gemm_phase(LAS unsigned char* lds, const Gemm g, const Sched& S, const Epi& E) {
    const int tid = opaque_tid(), wid = __builtin_amdgcn_readfirstlane(tid >> 6), lane = tid & 63, wr = wid >> 2, wc = wid & 3, fr = lane & 15, fq = lane >> 4;
    const int K = g.K, nt = K / BK;
    unsigned voffA[2], voffB[2];
#pragma unroll
    for (int i = 0; i < 2; ++i) { int R, C; stage_rc(tid * 16 + i * 8192, R, C); const int Rb = Epi::PERM ? ((R & ~31) + perm32(R & 31)) : R;
        voffA[i] = (unsigned)(R * K + C) * 2u; voffB[i] = (unsigned)(Rb * K + C) * 2u; }
    const size_t kstep = (size_t)(BK * 2);
    const size_t hstep = (size_t)HALF * K * 2;
    const size_t tstep = 2 * hstep;
    const unsigned ldsw = (unsigned)wid * 1024u;
    const int aoff = lds_byte(wr * 64 + fr, fq * 8), boff = lds_byte(wc * 32 + fr, fq * 8);
#define PG8_SA(b, h) (((b) * 2 + (h)) * HTB)
#define PG8_SB(b, h) ((4 + (b) * 2 + (h)) * HTB)
#define PG8_STAGE(bufoff, gbase, voff) do { _Pragma("unroll") for (int _i = 0; _i < 2; ++_i) \
        __builtin_amdgcn_global_load_lds((const unsigned*)((const char*)(gbase) + (voff)[_i]), (LAS unsigned*)(lds + (bufoff) + ldsw + _i * 8192), 16, 0, 0); } while (0)
#define PG8_LDA(dst, b, h) do { _Pragma("unroll") for (int m = 0; m < 4; ++m) _Pragma("unroll") for (int k = 0; k < 2; ++k) dst[m][k] = *(const LAS bf16x8*)(lds + PG8_SA(b, h) + aoff + m * 2048 + k * 1024); } while (0)
#define PG8_LDB(dst, b, h) do { _Pragma("unroll") for (int n = 0; n < 2; ++n) _Pragma("unroll") for (int k = 0; k < 2; ++k) dst[n][k] = *(const LAS bf16x8*)(lds + PG8_SB(b, h) + boff + n * 2048 + k * 1024); } while (0)
#define PG8_MMA(ai, bj, At, Bt) do { __builtin_amdgcn_s_setprio(1); _Pragma("unroll") for (int m = 0; m < 4; ++m) _Pragma("unroll") for (int n = 0; n < 2; ++n) _Pragma("unroll") for (int k = 0; k < 2; ++k) \
        acc[ai][bj][m][n] = __builtin_amdgcn_mfma_f32_16x16x32_bf16(Bt[n][k], At[m][k], acc[ai][bj][m][n], 0, 0, 0); __builtin_amdgcn_s_setprio(0); } while (0)
#define PG8_WAIT_V(n) asm volatile("s_waitcnt vmcnt(" #n ")" ::: "memory")
#define PG8_WAIT_L(n) asm volatile("s_waitcnt lgkmcnt(" #n ")" ::: "memory")
#define PG8_BAR __builtin_amdgcn_s_barrier()
#define PG8_SCHED __builtin_amdgcn_sched_barrier(0)
    Unit cur, nxt; int ui = 0;
    if (!S.next(0, cur)) return;
    f32x4 acc[2][2][4][2];
#pragma unroll
    for (int a = 0; a < 2; ++a)
#pragma unroll
        for (int b = 0; b < 2; ++b)
#pragma unroll
            for (int m = 0; m < 4; ++m)
#pragma unroll
                for (int n = 0; n < 2; ++n) acc[a][b][m][n] = (f32x4){0.f, 0.f, 0.f, 0.f};
    bf16x8 At[4][2], B0[2][2], B1[2][2];
    const char* cA = (const char*)g.A + (size_t)cur.pm * tstep; const char* cB = (const char*)g.Bt + (size_t)cur.pb * tstep;
    PG8_STAGE(PG8_SB(0, 0), cB, voffB); PG8_STAGE(PG8_SB(0, 1), cB + hstep, voffB); PG8_STAGE(PG8_SA(0, 0), cA, voffA); PG8_STAGE(PG8_SA(0, 1), cA + hstep, voffA);
    if (wr == 1) PG8_BAR;
    PG8_WAIT_V(2); PG8_BAR;
    PG8_STAGE(PG8_SB(1, 0), cB + kstep, voffB); PG8_STAGE(PG8_SA(1, 0), cA + kstep, voffA); PG8_STAGE(PG8_SB(1, 1), cB + hstep + kstep, voffB);
    PG8_WAIT_V(6); PG8_BAR;
    for (;;) {
        const bool has_next = S.next(ui + 1, nxt);
        const char* nA = has_next ? (const char*)g.A + (size_t)nxt.pm * tstep : cA; const char* nB = has_next ? (const char*)g.Bt + (size_t)nxt.pb * tstep : cB;
        for (int t = 0; t < nt; t += 2) {
            const bool last = (t == nt - 2);
            const char* a1 = cA + (size_t)(t + 1) * kstep;
            const char* a2 = last ? nA : cA + (size_t)(t + 2) * kstep; const char* b2 = last ? nB : cB + (size_t)(t + 2) * kstep;
            const char* a3 = a2 + kstep; const char* b3 = b2 + kstep;
            PG8_LDB(B0, 0, 0); PG8_LDB(B1, 0, 1); PG8_SCHED; PG8_LDA(At, 0, 0); PG8_STAGE(PG8_SA(1, 1), a1 + hstep, voffA);
            PG8_WAIT_V(8); PG8_WAIT_L(0); PG8_BAR; PG8_MMA(0, 0, At, B0); PG8_MMA(0, 1, At, B1); PG8_BAR; PG8_SCHED;
            PG8_LDA(At, 0, 1); PG8_STAGE(PG8_SB(0, 0), b2, voffB); PG8_STAGE(PG8_SB(0, 1), b2 + hstep, voffB); PG8_STAGE(PG8_SA(0, 0), a2, voffA);
            PG8_WAIT_V(8); PG8_WAIT_L(0); PG8_BAR; PG8_MMA(1, 0, At, B0); PG8_MMA(1, 1, At, B1); PG8_BAR; PG8_SCHED;
            PG8_LDB(B0, 1, 0); PG8_LDB(B1, 1, 1); PG8_SCHED; PG8_LDA(At, 1, 0); PG8_STAGE(PG8_SA(0, 1), a2 + hstep, voffA);
            PG8_WAIT_V(8); PG8_WAIT_L(0); PG8_BAR; PG8_MMA(0, 0, At, B0); PG8_MMA(0, 1, At, B1); PG8_BAR; PG8_SCHED;
            PG8_LDA(At, 1, 1); PG8_STAGE(PG8_SB(1, 0), b3, voffB); PG8_STAGE(PG8_SB(1, 1), b3 + hstep, voffB); PG8_STAGE(PG8_SA(1, 0), a3, voffA);
            PG8_WAIT_V(8); PG8_WAIT_L(0); PG8_BAR; PG8_MMA(1, 0, At, B0); PG8_MMA(1, 1, At, B1); PG8_BAR; PG8_SCHED;
        }
        if (wr == 0) PG8_BAR;
        E(acc, cur, wr, wc, fr, fq);
        if (!has_next) break;
#pragma unroll
        for (int a = 0; a < 2; ++a)
#pragma unroll
            for (int b = 0; b < 2; ++b)
#pragma unroll
                for (int m = 0; m < 4; ++m)
#pragma unroll
                    for (int n = 0; n < 2; ++n) acc[a][b][m][n] = (f32x4){0.f, 0.f, 0.f, 0.f};
        cur = nxt; cA = nA; cB = nB; ++ui;
        if (wr == 1) PG8_BAR;
    }
    PG8_WAIT_V(0);
    PG8_BAR;
#undef PG8_SA
#undef PG8_SB
#undef PG8_STAGE
#undef PG8_LDA
#undef PG8_LDB
#undef PG8_MMA
#undef PG8_WAIT_V
#undef PG8_WAIT_L
#undef PG8_BAR
#undef PG8_SCHED
}
}

namespace att {
typedef unsigned short bf16;
typedef short bf16x8 __attribute__((ext_vector_type(8)));
typedef short s16x4 __attribute__((ext_vector_type(4)));
typedef float f32x16 __attribute__((ext_vector_type(16)));
typedef unsigned u32x4 __attribute__((ext_vector_type(4)));
typedef float f32x2_t __attribute__((ext_vector_type(2)));
typedef __bf16 bf16x2_t __attribute__((ext_vector_type(2)));
constexpr int NSLOT = 3, KSLOT = 12288, VSLOT = 8192;
constexpr int L_K = 0, L_V = NSLOT * KSLOT, L_WS = L_V + NSLOT * VSLOT, L_OST = L_WS + 8 * 64 * 4, L_TAB = L_OST + 8 * 4096, L_END = L_TAB + 8 * 465 * 4;
static_assert(L_END <= 131072, "attention LDS");
constexpr float LOG2E = 1.4426950408889634f, LN2 = 0.6931471805599453f;
constexpr float THR = 8.0f;
__device__ __forceinline__ int crow(int r, int hi) { return (r & 3) + 8 * (r >> 2) + 4 * hi; }
#define ATT_SBAR() __builtin_amdgcn_sched_barrier(0)
__device__ __forceinline__ void glds16(const void* gsrc, unsigned lds_dst) { unsigned keep;
  asm volatile("s_mov_b32 %0, m0\n\ts_mov_b32 m0, %2\n\ts_nop 0\n\tglobal_load_lds_dwordx4 %1, off\n\ts_mov_b32 m0, %0" : "=&s"(keep) : "v"(gsrc), "s"(lds_dst) : "memory"); }
__device__ __forceinline__ float max3f(float a, float b, float c) { float r; asm("v_max3_f32 %0, %1, %2, %3" : "=v"(r) : "v"(a), "v"(b), "v"(c)); return r; }
__device__ __forceinline__ unsigned cvtpk_s(float lo, float hi) { f32x2_t v = {lo, hi}; bf16x2_t b = __builtin_convertvector(v, bf16x2_t); return __builtin_bit_cast(unsigned, b); }
__device__ __forceinline__ float bf2f(short s) { return __uint_as_float(((unsigned)(unsigned short)s) << 16); }
#define ATT_WAIT_BAR(N) asm volatile("s_waitcnt vmcnt(" #N ") lgkmcnt(0)\n\ts_barrier" ::: "memory")

template <int ND0> __device__ __forceinline__ void qkt(f32x16& p0, f32x16& p1, const LAS unsigned char* Kslot, const bf16x8* qr, int r32, int hi) {
  const LAS unsigned char* kb = Kslot + hi * 1024 + r32 * 16;
#pragma unroll
  for (int d0 = 0; d0 < ND0; ++d0) {
    const bf16x8 b0 = *(const LAS bf16x8*)(kb + d0 * 2048);
    const bf16x8 b1 = *(const LAS bf16x8*)(kb + d0 * 2048 + 512);
    p0 = __builtin_amdgcn_mfma_f32_32x32x16_bf16(b0, qr[d0], p0, 0, 0, 0); p1 = __builtin_amdgcn_mfma_f32_32x32x16_bf16(b1, qr[d0], p1, 0, 0, 0); }
}
__device__ __forceinline__ float rowmax(const f32x16& p0, const f32x16& p1) {
  float a = max3f(p0[0], p0[1], p1[0]), b = max3f(p0[2], p0[3], p1[1]); a = max3f(a, p1[2], p1[3]);
#pragma unroll
  for (int r = 4; r < 16; r += 4) { a = max3f(a, p0[r], p0[r + 1]); b = max3f(b, p0[r + 2], p0[r + 3]); a = max3f(a, p1[r], p1[r + 1]); b = max3f(b, p1[r + 2], p1[r + 3]); }
  const float m = fmaxf(a, b);
  auto rr = __builtin_amdgcn_permlane32_swap(__float_as_uint(m), __float_as_uint(m), false, false);
  return fmaxf(__uint_as_float(rr[0]), __uint_as_float(rr[1]));
}
__device__ __forceinline__ void pv(f32x16* o, int vb, bf16x8 pa0, bf16x8 pa1, bf16x8 pa2, bf16x8 pa3) {
#pragma unroll
  for (int d0 = 0; d0 < 2; ++d0) { s16x4 lo[4], hi[4];
#pragma unroll
    for (int ks = 0; ks < 4; ++ks) {
      asm volatile("ds_read_b64_tr_b16 %0,%1 offset:%c2" : "=&v"(lo[ks]) : "v"(vb), "i"(d0 * 4096 + ks * 1024) : "memory");
      asm volatile("ds_read_b64_tr_b16 %0,%1 offset:%c2" : "=&v"(hi[ks]) : "v"(vb), "i"(d0 * 4096 + ks * 1024 + 512) : "memory"); }
    asm volatile("s_waitcnt lgkmcnt(0)" ::: "memory"); ATT_SBAR();
#define ATT_PK(k) (bf16x8){lo[k][0], lo[k][1], lo[k][2], lo[k][3], hi[k][0], hi[k][1], hi[k][2], hi[k][3]}
    o[d0] = __builtin_amdgcn_mfma_f32_32x32x16_bf16(pa0, ATT_PK(0), o[d0], 0, 0, 0);
    o[d0] = __builtin_amdgcn_mfma_f32_32x32x16_bf16(pa1, ATT_PK(1), o[d0], 0, 0, 0);
    o[d0] = __builtin_amdgcn_mfma_f32_32x32x16_bf16(pa2, ATT_PK(2), o[d0], 0, 0, 0);
    o[d0] = __builtin_amdgcn_mfma_f32_32x32x16_bf16(pa3, ATT_PK(3), o[d0], 0, 0, 0);
#undef ATT_PK
  }
}

template <class P> __device__ __forceinline__ void attn_unit(const P& pol, LAS unsigned char* shm) {
  constexpr int ND0 = P::ND0;
  const int tid = opaque_tid(), lane = tid & 63, r32 = lane & 31, hi = lane >> 5; const int wid = __builtin_amdgcn_readfirstlane(tid >> 6);
  const unsigned lds0 = (unsigned)(uintptr_t)shm;
  LAS float* wsf = (LAS float*)(shm + L_WS) + wid * 64;
  const int NT = pol.ntiles();
  const bool three = (ND0 == 6) && (wid < 4);
#define ATT_DMA(t, slot) do { \
    glds16(pol.k_src((t), wid, lane), (unsigned)__builtin_amdgcn_readfirstlane(lds0 + L_K + (slot) * KSLOT + wid * 1024)); \
    if (three) glds16(pol.k2_src((t), wid, lane), (unsigned)__builtin_amdgcn_readfirstlane(lds0 + L_K + (slot) * KSLOT + (8 + wid) * 1024)); \
    glds16(pol.v_src((t), wid, lane), (unsigned)__builtin_amdgcn_readfirstlane(lds0 + L_V + (slot) * VSLOT + wid * 1024)); } while (0)
  ATT_DMA(0, 0);
  if (NT > 1) ATT_DMA(1, 1);
  bf16x8 qr[ND0];
  { const bf16* qp = pol.q_ptr(wid, r32);
#pragma unroll
    for (int d0 = 0; d0 < ND0; ++d0) qr[d0] = *reinterpret_cast<const bf16x8*>(qp + d0 * 16 + hi * 8); }
  pol.q_fix(qr, wid, r32, hi);
  float m = -1e30f, lsum = 0.f; f32x16 o[2]; o[0] = f32x16{}; o[1] = f32x16{};
  const int vb0 = (int)(lds0 + L_V) + ((lane >> 4) & 1) * 32 + (lane & 3) * 8 + (4 * hi + ((lane & 15) >> 2)) * 64;
  if (NT > 1) { if (three) ATT_WAIT_BAR(3); else ATT_WAIT_BAR(2); } else ATT_WAIT_BAR(0);
  int s_cur = 0, s_n2 = 2;
  for (int t = 0; t < NT; ++t) {
    if (t + 2 < NT) ATT_DMA(t + 2, s_n2);
    if (pol.needs(t, wid)) {
      f32x16 p0 = f32x16{}, p1 = f32x16{};
      qkt<ND0>(p0, p1, shm + L_K + s_cur * KSLOT, qr, r32, hi);
      pol.transform(p0, p1, t, wid, r32, hi);
      const float rm = rowmax(p0, p1);
      const bool grow = rm > m + THR;
      if (__any(grow)) {
        const float mn = grow ? rm : m; const float f = __builtin_amdgcn_exp2f(m - mn); m = mn; lsum *= f;
        if (hi == 0) wsf[r32] = f;
        asm volatile("s_waitcnt lgkmcnt(0)" ::: "memory");
#pragma unroll
        for (int r = 0; r < 16; ++r) { const float ff = wsf[crow(r, hi)]; o[0][r] *= ff; o[1][r] *= ff; }
      }
      float sacc = 0.f;
#pragma unroll
      for (int r = 0; r < 16; ++r) { p0[r] = __builtin_amdgcn_exp2f(p0[r] - m); p1[r] = __builtin_amdgcn_exp2f(p1[r] - m); sacc += p0[r] + p1[r]; }
      lsum += sacc;
      u32x4 pw0, pw1, pw2, pw3;
      pw0 = (u32x4){cvtpk_s(p0[0], p0[1]), cvtpk_s(p0[2], p0[3]), cvtpk_s(p0[4], p0[5]), cvtpk_s(p0[6], p0[7])};
      pw1 = (u32x4){cvtpk_s(p0[8], p0[9]), cvtpk_s(p0[10], p0[11]), cvtpk_s(p0[12], p0[13]), cvtpk_s(p0[14], p0[15])};
      pw2 = (u32x4){cvtpk_s(p1[0], p1[1]), cvtpk_s(p1[2], p1[3]), cvtpk_s(p1[4], p1[5]), cvtpk_s(p1[6], p1[7])};
      pw3 = (u32x4){cvtpk_s(p1[8], p1[9]), cvtpk_s(p1[10], p1[11]), cvtpk_s(p1[12], p1[13]), cvtpk_s(p1[14], p1[15])};
      ATT_SBAR();
      pv(o, vb0 + s_cur * VSLOT, __builtin_bit_cast(bf16x8, pw0), __builtin_bit_cast(bf16x8, pw1), __builtin_bit_cast(bf16x8, pw2), __builtin_bit_cast(bf16x8, pw3));
    }
    if (t + 2 < NT) { if (three) ATT_WAIT_BAR(3); else ATT_WAIT_BAR(2); } else ATT_WAIT_BAR(0);
    s_cur = (s_cur == NSLOT - 1) ? 0 : s_cur + 1; s_n2 = (s_n2 == NSLOT - 1) ? 0 : s_n2 + 1;
  }
  { auto rr = __builtin_amdgcn_permlane32_swap(__float_as_uint(lsum), __float_as_uint(lsum), false, false); lsum = __uint_as_float(rr[0]) + __uint_as_float(rr[1]); }
  if (hi == 0) { wsf[32 + r32] = lsum; pol.lse_out(wid, r32, (m + __builtin_amdgcn_logf(lsum)) * LN2); }
  asm volatile("s_waitcnt lgkmcnt(0)" ::: "memory");
  float rli[16];
#pragma unroll
  for (int r = 0; r < 16; ++r) rli[r] = __builtin_amdgcn_rcpf(wsf[32 + crow(r, hi)]);
  { LAS bf16* stg = (LAS bf16*)(shm + L_OST) + wid * 2048;
#pragma unroll
    for (int r = 0; r < 16; ++r) { const int orow = crow(r, hi);
#pragma unroll
      for (int d0 = 0; d0 < 2; ++d0) stg[orow * 64 + d0 * 32 + r32] = (bf16)(cvtpk_s(o[d0][r] * rli[r], 0.f) & 0xffffu); }
    asm volatile("s_waitcnt lgkmcnt(0)" ::: "memory");
#pragma unroll
    for (int i = 0; i < 4; ++i) { const int row = i * 8 + (lane >> 3), ch = lane & 7; const u32x4 v = *(const LAS u32x4*)(stg + row * 64 + ch * 8); *(u32x4*)(pol.o_ptr(wid, row) + ch * 8) = v; } }
  asm volatile("s_waitcnt vmcnt(0) lgkmcnt(0)\n\ts_barrier" ::: "memory");
#undef ATT_DMA
}
}

constexpr int NWAVES = 8, NTHREADS = NWAVES * 64;
constexpr int DM = 1024, NTOK = 65536, GTOK = 32768;
constexpr int NEXP = 16, CAP = 4096, FF = 2816;
constexpr int N_IN0 = 2048  , N_UP = 1792, K_UP = 384, N_DIL = 4608;
constexpr float LN_EPS = 1e-5f, RMS_EPS = 1e-6f, DN_ALPHA = 1.4142135623730951f;
constexpr int KSPLIT = 8;

constexpr size_t MiB = 1u << 20;
constexpr size_t WS_CTL = 0, CTL_ZERO_BYTES = 1 * MiB;
constexpr size_t WS_MODP = 1 * MiB;
constexpr size_t WS_ROPE_R = 6 * MiB;
constexpr size_t WS_ROPE_H = 7 * MiB;
constexpr size_t WS_WIN0 = 9 * MiB, WS_WUP = 13 * MiB, WS_WOUT0 = 15 * MiB, WS_WDIL = 17 * MiB, WS_WOUT1 = 26 * MiB;
constexpr size_t WS_AFF = 27 * MiB, WS_SLOTOF = 31 * MiB, WS_IDX = 35 * MiB, WS_GATEV = 35 * MiB + 512 * 1024;
constexpr size_t WS_W13 = 36 * MiB, WS_W2 = 212 * MiB, WS_H = 300 * MiB, WS_R = 428 * MiB;
constexpr size_t WS_PROJ = WS_R, WS_A2 = WS_R + 256 * MiB, WS_KPE = WS_R + 304 * MiB, WS_QKV2 = WS_R + 308 * MiB, WS_ATT = WS_R + 532 * MiB, WS_MIX = WS_R;
constexpr size_t WS_XE = WS_R, WS_HH = WS_R + 128 * MiB, WS_YE = WS_R + 480 * MiB;
constexpr size_t WS_QKV = WS_R, WS_OG = WS_R + 576 * MiB, WS_LSE = WS_R + 768 * MiB, WS_MRG = WS_R + 774 * MiB;
constexpr size_t WS_END = WS_R + 838 * MiB;
constexpr int CW_BAR = 4096;

constexpr int RING_BYTES = 131072, LDSCTL_OFF = RING_BYTES, MISC_OFF = LDSCTL_OFF + 320, LDS_BYTES = 147456;

typedef unsigned short bf16;
typedef unsigned v4u __attribute__((ext_vector_type(4)));
typedef unsigned v2u __attribute__((ext_vector_type(2)));
typedef float f32x4 __attribute__((ext_vector_type(4)));
typedef GAS unsigned gu32;
#define RLX_AGENT __ATOMIC_RELAXED, __HIP_MEMORY_SCOPE_AGENT
#define LDS_WAIT() asm volatile("s_waitcnt lgkmcnt(0)" ::: "memory")
__device__ __forceinline__ unsigned f2bf(float f) { unsigned u = __builtin_bit_cast(unsigned, f); return (u + 0x7fffu + ((u >> 16) & 1u)) >> 16; }
__device__ __forceinline__ unsigned pk2(float lo, float hi) { return f2bf(lo) | (f2bf(hi) << 16); }
__device__ __forceinline__ float bflo(unsigned w) { return __uint_as_float(w << 16); }
__device__ __forceinline__ float bfhi(unsigned w) { return __uint_as_float(w & 0xffff0000u); }

#define XB_TMO      128
#define XB_XCNT(j)  (256  + 64 * (j))
#define XB_XSUB(j)  (1280 + 64 * (j))
#define XB_XGEN(j)  (2304 + 64 * (j))
#define XB_TOP      3328
#define XB_TOPGEN   3392
#define XCD_BAR_WORDS 3456
#define XB_SPIN_CAP (1u << 18)
__device__ __forceinline__ unsigned xb_ld(unsigned* p)              { return __hip_atomic_load(p, __ATOMIC_RELAXED, __HIP_MEMORY_SCOPE_AGENT); }
__device__ __forceinline__ unsigned xb_add(unsigned* p, unsigned v) { return __hip_atomic_fetch_add(p, v, __ATOMIC_RELAXED, __HIP_MEMORY_SCOPE_AGENT); }
__device__ __forceinline__ unsigned xb_xcc_id() { return (unsigned)__builtin_amdgcn_s_getreg((3 << 11) | 20) & 0xFu; }
#define XB_SPIN(cond, bar) do { unsigned _sp = 0; while (cond) { __builtin_amdgcn_s_sleep(1); \
    if ((++_sp & 255u) == 0u) { if (xb_ld(&(bar)[XB_TMO])) break; if (_sp > XB_SPIN_CAP) { atomicAdd(&(bar)[XB_TMO], 1u); break; } } } } while (0)
struct XcdBarrier { unsigned* bar; unsigned x; volatile LAS unsigned* st; };
__device__ __forceinline__ XcdBarrier xcd_barrier_post(unsigned* bar, volatile LAS unsigned* st) {
    XcdBarrier b; b.bar = bar; b.x = xb_xcc_id(); b.st = st;
    if (threadIdx.x == 0) (void)xb_add(&bar[XB_XCNT(b.x)], 1u);
    return b;
}
__device__ __forceinline__ void xcd_barrier_complete(unsigned* bar, unsigned x, unsigned& nloc, unsigned& nx) {
    const unsigned G = gridDim.x * gridDim.y * gridDim.z;
    unsigned sum, cnt, mine, sp = 0u;
    for (;;) {
        sum = 0u; cnt = 0u; mine = 0u;
#pragma unroll
        for (unsigned j = 0; j < 16; ++j) { const unsigned c = xb_ld(&bar[XB_XCNT(j)]); sum += c; cnt += (c > 0u) ? 1u : 0u; mine = (j == x) ? c : mine; }
        if (sum == G) break;
        __builtin_amdgcn_s_sleep(1);
        if ((++sp & 255u) == 0u) { if (xb_ld(&bar[XB_TMO])) break; if (sp > XB_SPIN_CAP) { atomicAdd(&bar[XB_TMO], 1u); break; } }
    }
    nloc = mine > 0u ? mine : 1u; nx = cnt > 0u ? cnt : 1u;
}
__device__ __forceinline__ void xcd_barrier(const XcdBarrier& b) {
    asm volatile("s_waitcnt vmcnt(0)" ::: "memory");
    __syncthreads();
    if (threadIdx.x == 0) {
        unsigned* bar = b.bar;
        __builtin_amdgcn_s_waitcnt(0);
        unsigned nloc = b.st[0], nx = b.st[1];
        if (nloc == 0u) { xcd_barrier_complete(bar, b.x, nloc, nx); b.st[0] = nloc; b.st[1] = nx; }
        const unsigned old = xb_add(&bar[XB_XSUB(b.x)], 1u);
        const unsigned gen = old / nloc;
        if (old + 1u == (gen + 1u) * nloc) {
            __builtin_amdgcn_fence(__ATOMIC_RELEASE, "agent");
            asm volatile("s_waitcnt vmcnt(0)" ::: "memory");
            const unsigned og = xb_add(&bar[XB_TOP], 1u);
            const unsigned tg = og / nx;
            if (og + 1u == (tg + 1u) * nx) xb_add(&bar[XB_TOPGEN], 1u);
            else XB_SPIN(xb_ld(&bar[XB_TOPGEN]) == tg, bar);
            __builtin_amdgcn_fence(__ATOMIC_ACQUIRE, "agent");
            xb_add(&bar[XB_XGEN(b.x)], 1u);
            asm volatile("s_waitcnt vmcnt(0)" ::: "memory");
        } else {
            XB_SPIN(xb_ld(&bar[XB_XGEN(b.x)]) == gen, bar);
            __builtin_amdgcn_fence(__ATOMIC_ACQUIRE, "agent");
            asm volatile("s_waitcnt vmcnt(0)" ::: "memory");
        }
    }
    __syncthreads();
}

struct Params {
    const float* in[25];
    float* out; unsigned char* ws;
    int ph_hi; int pad;
};
typedef const __attribute__((address_space(4))) Params* PP;
__device__ __forceinline__ PP params_ptr() { PP q = (PP)__builtin_amdgcn_kernarg_segment_ptr(); asm volatile("" : "+s"(q)); return q; }
__device__ __forceinline__ int tok_bidx(int t) { return t < GTOK ? (t >> 12) : 8 + ((t - GTOK) >> 13); }
__device__ __forceinline__ int tok_pos(int t) { return t < GTOK ? (t & 4095) : (t & 8191); }
__device__ __forceinline__ const float* x_in_row(PP p, int t) { return t < GTOK ? p->in[0] + (size_t)t * DM : p->in[1] + (size_t)(t - GTOK) * DM; }

__device__ __forceinline__ float wave_sum(float v) {
#pragma unroll
    for (int o = 1; o < 64; o <<= 1) v += __shfl_xor(v, o);
    return v;
}
__device__ __forceinline__ int wave_sum_i(int v) {
#pragma unroll
    for (int o = 1; o < 64; o <<= 1) v += __shfl_xor(v, o);
    return v;
}

__device__ const float INV_R[16] = {1.0f, 0.562341332f, 0.316227764f, 0.177827939f, 0.100000001f, 0.0562341325f, 0.0316227749f, 0.0177827943f, 0.00999999978f, 0.00562341325f, 0.00316227763f, 0.00177827943f, 0.00100000005f, 0.000562341302f, 0.000316227757f, 0.00017782794f};
__device__ const float INV_H[32] = {1.0f, 0.749894202f, 0.562341332f, 0.421696514f, 0.316227764f, 0.237137377f, 0.177827939f, 0.133352146f, 0.100000001f, 0.0749894232f, 0.0562341325f, 0.0421696492f, 0.0316227749f, 0.0237137377f, 0.0177827943f, 0.013335214f, 0.00999999978f, 0.00749894232f, 0.00562341325f, 0.00421696482f, 0.00316227763f, 0.00237137382f, 0.00177827943f, 0.00133352145f, 0.00100000005f, 0.000749894185f, 0.000562341302f, 0.000421696517f, 0.000316227757f, 0.00023713737f, 0.00017782794f, 0.00013335215f};
__device__ __forceinline__ void cvt_item(const float* __restrict__ W, int ldw, int k0, int n0, bf16* WT, size_t ldk, size_t wt0, LAS float* scr, int lane) {
#pragma unroll 8
    for (int i = 0; i < 32; ++i) { const int kk = 2 * i + (lane >> 5); scr[kk * 33 + (lane & 31)] = W[(size_t)(k0 + kk) * ldw + n0 + (lane & 31)]; }
    LDS_WAIT(); asm volatile("" ::: "memory");
    const int c = lane & 7;
#pragma unroll
    for (int j = 0; j < 4; ++j) { const int n = (lane >> 3) + 8 * j; const LAS float* s = scr + (8 * c) * 33 + n;
        v4u o; o.x = pk2(s[0 * 33], s[1 * 33]); o.y = pk2(s[2 * 33], s[3 * 33]); o.z = pk2(s[4 * 33], s[5 * 33]); o.w = pk2(s[6 * 33], s[7 * 33]);
        *(GAS v4u*)(WT + wt0 + (size_t)n * ldk + 8 * c) = o; }
    LDS_WAIT(); asm volatile("" ::: "memory");
}
__device__ __forceinline__ void cvt_moe_item(PP p, int layer, int it, LAS float* scr, int lane) {
    const int e = it / 4224, r = it % 4224, which = r / 1408, q = r % 1408;
    if (which < 2) { const int kb = q / 88, nb = q % 88, n0 = nb * 32, k0 = kb * 64;
        const float* W = p->in[22 + which] + ((size_t)layer * NEXP + e) * (size_t)DM * FF;
        const size_t row0 = (size_t)e * 5632 + (size_t)(n0 >> 7) * 256 + which * 128 + (n0 & 127);
        cvt_item(W, FF, k0, n0, (bf16*)(p->ws + WS_W13), DM, row0 * DM + k0, scr, lane);
    } else { const int kb = q / 32, nb = q % 32, n0 = nb * 32, k0 = kb * 64;
        const float* W = p->in[24] + ((size_t)layer * NEXP + e) * (size_t)FF * DM;
        cvt_item(W, DM, k0, n0, (bf16*)(p->ws + WS_W2), FF, ((size_t)e * DM + n0) * FF + k0, scr, lane); }
}
constexpr int MOE_CVT_ITEMS = NEXP * 4224;

__device__ __forceinline__ void p0_prologue(PP p, LAS unsigned char* lds, int vcu, int G, int tid, int lane, int wave) {
    LAS float* scr = (LAS float*)(lds + wave * 8448);
    LAS float* sc = (LAS float*)(lds + 69632);
    for (int i = tid; i < 12 * DM; i += NTHREADS) { const int b = i >> 10, k = i & 1023; const float c = b < 8 ? p->in[2][b * DM + k] : p->in[3][(b - 8) * DM + k];
        sc[i] = c / (1.0f + __expf(-c)); }
    __syncthreads();
    const int gw = vcu * NWAVES + wave, NGW = G * NWAVES;
    for (int it = gw; it < 4 * 48 * KSPLIT; it += NGW) {
        const int kc = it % KSPLIT, jb = (it / KSPLIT) % 48, mi = it / (KSPLIT * 48);
        const float* W = (mi & 1 ? p->in[17] : p->in[13]) + (size_t)(mi >> 1) * DM * 3072 + jb * 64 + lane;
        float acc[12];
#pragma unroll
        for (int b = 0; b < 12; ++b) acc[b] = 0.f;
        for (int k0 = kc * 128; k0 < kc * 128 + 128; k0 += 8) {
            float w[8];
#pragma unroll
            for (int i = 0; i < 8; ++i) w[i] = W[(size_t)(k0 + i) * 3072];
#pragma unroll
            for (int b = 0; b < 12; ++b) { const f32x4 s0 = *(const LAS f32x4*)(sc + b * DM + k0), s1 = *(const LAS f32x4*)(sc + b * DM + k0 + 4);
                acc[b] += w[0] * s0[0] + w[1] * s0[1] + w[2] * s0[2] + w[3] * s0[3] + w[4] * s1[0] + w[5] * s1[1] + w[6] * s1[2] + w[7] * s1[3]; }
        }
        float* o = (float*)(p->ws + WS_MODP) + ((size_t)(kc * 4 + mi) * 12) * 3072 + jb * 64 + lane;
#pragma unroll
        for (int b = 0; b < 12; ++b) o[(size_t)b * 3072] = acc[b];
    }
    for (int i = gw * 64 + lane; i < 8192 * 48; i += NGW * 64) {
        const int pos = i / 48, j = i % 48; const float inv = j < 16 ? INV_R[j] : INV_H[j - 16];
        const float ang = (float)pos * inv; double rev = (double)ang * 0.15915494309189535; rev -= floor(rev);
        const float rf = (float)rev; float2 cs; cs.x = __builtin_amdgcn_cosf(rf); cs.y = __builtin_amdgcn_sinf(rf);
        if (j < 16) ((float2*)(p->ws + WS_ROPE_R))[pos * 16 + j] = cs; else ((float2*)(p->ws + WS_ROPE_H))[pos * 32 + (j - 16)] = cs;
    }
    { const v4u z = {0u, 0u, 0u, 0u};
      for (int i = gw * 64 + lane; i < 12288 + 12288 + 32768; i += NGW * 64) {
        if (i < 12288) ((GAS v4u*)(p->ws + WS_WIN0 + (size_t)1952 * DM * 2))[i] = z;
        else if (i < 24576) { const int q = i - 12288, row = q >> 4, c = q & 15; *(GAS v4u*)(p->ws + WS_WUP + ((size_t)row * K_UP + 256) * 2 + c * 16) = z; }
        else { const int q = i - 24576, row = 768 + (q >> 5), c = q & 31; *(GAS v4u*)(p->ws + WS_WUP + (size_t)row * K_UP * 2 + c * 16) = z; } } }
    constexpr int I0 = 16 * 61, I1 = 4 * 24, I2 = 2 * 32, I3 = 16 * 32, I4 = 16 * 144, I5 = 8 * 32;
    for (int it = gw; it < I0 + I1 + I2 + I3 + I4 + I5; it += NGW) {
        int r = it;
        if (r < I0) { const int kb = r / 61, nb = r % 61; cvt_item(p->in[4], 1952, kb * 64, nb * 32, (bf16*)(p->ws + WS_WIN0), DM, (size_t)nb * 32 * DM + kb * 64, scr, lane); continue; } r -= I0;
        if (r < I1) { const int kb = r / 24, nb = r % 24; cvt_item(p->in[7], 768, kb * 64, nb * 32, (bf16*)(p->ws + WS_WUP), K_UP, (size_t)nb * 32 * K_UP + kb * 64, scr, lane); continue; } r -= I1;
        if (r < I2) { const int kb = r / 32, nb = r % 32; cvt_item(p->in[9], 1024, kb * 64, nb * 32, (bf16*)(p->ws + WS_WUP), K_UP, (size_t)(768 + nb * 32) * K_UP + 256 + kb * 64, scr, lane); continue; } r -= I2;
        if (r < I3) { const int kb = r / 32, nb = r % 32; cvt_item(p->in[10], 1024, kb * 64, nb * 32, (bf16*)(p->ws + WS_WOUT0), DM, (size_t)nb * 32 * DM + kb * 64, scr, lane); continue; } r -= I3;
        if (r < I4) { const int kb = r / 144, nb = r % 144; cvt_item(p->in[11], N_DIL, kb * 64, nb * 32, (bf16*)(p->ws + WS_WDIL), DM, (size_t)nb * 32 * DM + kb * 64, scr, lane); continue; } r -= I4;
        { const int kb = r / 32, nb = r % 32; cvt_item(p->in[12], 1024, kb * 64, nb * 32, (bf16*)(p->ws + WS_WOUT1), 512, (size_t)nb * 32 * 512 + kb * 64, scr, lane); }
    }
    for (int it = gw; it < MOE_CVT_ITEMS; it += NGW) cvt_moe_item(p, 0, it, scr, lane);
}

__device__ __forceinline__ void load_mod_vec(PP p, LAS float* dst, int mi, int b, int part, int tid) {
    const float* bias = (mi & 1 ? p->in[18] : p->in[14]) + (size_t)(mi >> 1) * 3072 + part * DM;
    const float* mp = (const float*)(p->ws + WS_MODP) + ((size_t)mi * 12 + b) * 3072 + part * DM;
    for (int j = tid; j < DM; j += NTHREADS) { float s = bias[j];
#pragma unroll
        for (int kc = 0; kc < KSPLIT; ++kc) s += mp[(size_t)kc * 4 * 12 * 3072 + j];
        dst[j] = s; }
}
__device__ __forceinline__ void store_row_bf16(bf16* orow, const f32x4 (&v)[4], int lane) {
    GAS unsigned long long* o8 = (GAS unsigned long long*)orow + lane;
#pragma unroll
    for (int j = 0; j < 4; ++j) o8[64 * j] = (unsigned long long)pk2(v[j].x, v[j].y) | ((unsigned long long)pk2(v[j].z, v[j].w) << 32);
}

__device__ __forceinline__ void p1_modulate(PP p, LAS unsigned char* lds, int vcu, int G, int tid, int lane, int wave) {
    LAS float* vsh = (LAS float*)lds; LAS float* vsc = vsh + DM;
    for (int ch = vcu; ch < NTOK / 256; ch += G) {
        const int t0 = ch * 256, b = tok_bidx(t0);
        __syncthreads();
        load_mod_vec(p, vsh, 0, b, 0, tid); load_mod_vec(p, vsc, 0, b, 1, tid);
        __syncthreads();
        _Pragma("unroll 1") for (int i = 0; i < 32; ++i) { const int t = t0 + wave * 32 + i;
            const GAS f32x4* xr = (const GAS f32x4*)x_in_row(p, t) + lane; f32x4 v[4];
#pragma unroll
            for (int j = 0; j < 4; ++j) { const f32x4 x = xr[64 * j]; const f32x4 sh = *(const LAS f32x4*)(vsh + 4 * lane + 256 * j), sc = *(const LAS f32x4*)(vsc + 4 * lane + 256 * j); v[j] = x * (1.0f + sc) + sh; }
            store_row_bf16((bf16*)(p->ws + WS_H) + (size_t)t * DM, v, lane); }
    }
}

__device__ __forceinline__ void p3_mla_prep(PP p, int vcu, int G, int lane, int wave) {
    const int gw = vcu * NWAVES + wave, NGW = G * NWAVES;
    const bf16* proj = (const bf16*)(p->ws + WS_PROJ); bf16* a2 = (bf16*)(p->ws + WS_A2); bf16* kpe = (bf16*)(p->ws + WS_KPE);
    const f32x4 qn = *((const f32x4*)p->in[6] + lane); const float2 kn = *((const float2*)p->in[8] + lane);
    for (int t = gw; t < NTOK; t += NGW) {
        const bf16* row = proj + (size_t)t * N_IN0;
        const v2u ql = *(const v2u*)(row + 1536 + 4 * lane); const unsigned kl = *(const unsigned*)(row + 1792 + 2 * lane);
        const float q0 = bflo(ql.x), q1 = bfhi(ql.x), q2 = bflo(ql.y), q3 = bfhi(ql.y), k0 = bflo(kl), k1 = bfhi(kl);
        const float qs = wave_sum(q0 * q0 + q1 * q1 + q2 * q2 + q3 * q3), ks = wave_sum(k0 * k0 + k1 * k1);
        const float qr = 1.0f / sqrtf(qs * (1.0f / 256.0f) + RMS_EPS), kr = 1.0f / sqrtf(ks * (1.0f / 128.0f) + RMS_EPS);
        v2u qo; qo.x = pk2(q0 * qr * qn.x, q1 * qr * qn.y); qo.y = pk2(q2 * qr * qn.z, q3 * qr * qn.w);
        *(v2u*)(a2 + (size_t)t * K_UP + 4 * lane) = qo;
        *(unsigned*)(a2 + (size_t)t * K_UP + 256 + 2 * lane) = pk2(k0 * kr * kn.x, k1 * kr * kn.y);
        if (lane < 16) { const float x1 = bflo((unsigned)row[1920 + lane]), x2 = bflo((unsigned)row[1936 + lane]);
            const float2 cs = ((const float2*)(p->ws + WS_ROPE_R))[tok_pos(t) * 16 + lane];
            kpe[(size_t)t * 32 + lane] = (bf16)f2bf(x1 * cs.x - x2 * cs.y); kpe[(size_t)t * 32 + 16 + lane] = (bf16)f2bf(x1 * cs.y + x2 * cs.x); }
    }
}

__device__ __forceinline__ void decode_unit(int r, int& S, int& tok0, int& h, int& within) {
    if (r < 1024) { const int bh = r >> 4; within = r & 15; S = 4096; tok0 = (bh >> 3) * 4096; h = bh & 7; }
    else { const int r2 = r - 1024, bh = r2 >> 5; within = r2 & 31; S = 8192; tok0 = GTOK + (bh >> 3) * 8192; h = bh & 7; }
}
__device__ __forceinline__ int clampi(int v, int lo, int hi) { return v < lo ? lo : (v > hi ? hi : v); }
using att::bf16x8; using att::f32x16;
__device__ __forceinline__ void rope8(bf16x8& a, bf16x8& b, const float2* cs) {
#pragma unroll
    for (int j = 0; j < 8; ++j) { const float x1 = att::bf2f(a[j]), x2 = att::bf2f(b[j]); const float2 c = cs[j];
        a[j] = (short)f2bf(x1 * c.x - x2 * c.y); b[j] = (short)f2bf(x1 * c.y + x2 * c.x); }
}

struct PolNA {
    static constexpr int ND0 = 4;
    const att::bf16* proj; att::bf16* out; const LAS float* tab; int tok0, h, R4, rows, kr_lo, nt;
    __device__ __forceinline__ void init(int r, const unsigned char* ws, const LAS float* tab_all) {
        int S, within; decode_unit(r, S, tok0, h, within); R4 = within; rows = S >> 6;
        kr_lo = clampi(4 * R4 - 4, 0, rows - 8); nt = clampi(4 * R4 - 1, 0, rows - 8) + 8 - kr_lo;
        proj = (const att::bf16*)(ws + WS_PROJ); out = (att::bf16*)(ws + WS_ATT); tab = tab_all + h * 465; }
    __device__ __forceinline__ int ntiles() const { return nt; }
    __device__ __forceinline__ const att::bf16* q_ptr(int wid, int r32) const { return proj + (size_t)(tok0 + (4 * R4 + (wid >> 1)) * 64 + (wid & 1) * 32 + r32) * N_IN0 + h * 64; }
    __device__ __forceinline__ void q_fix(bf16x8 (&)[ND0], int, int, int) const {}
    __device__ __forceinline__ const void* k_src(int t, int wid, int lane) const { return proj + (size_t)(tok0 + (kr_lo + t) * 64 + lane) * N_IN0 + 512 + h * 64 + wid * 8; }
    __device__ __forceinline__ const void* k2_src(int, int, int) const { return nullptr; }
    __device__ __forceinline__ const void* v_src(int t, int wid, int lane) const { return proj + (size_t)(tok0 + (kr_lo + t) * 64 + 16 * (wid & 3) + (lane >> 2)) * N_IN0 + 1024 + h * 64 + (wid >> 2) * 32 + (lane & 3) * 8; }
    __device__ __forceinline__ bool needs(int t, int wid) const { const int r = 4 * R4 + (wid >> 1), r0 = clampi(r - 4, 0, rows - 8), kr = kr_lo + t; return kr >= r0 && kr < r0 + 8; }
    __device__ __forceinline__ void transform(f32x16& p0, f32x16& p1, int t, int wid, int r32, int hi) const {
        const int r = 4 * R4 + (wid >> 1), qc = (wid & 1) * 32 + r32, c0 = clampi(qc - 8, 0, 48);
        const LAS float* trow = tab + (kr_lo + t - r + 7) * 31 + (15 - qc);
#pragma unroll
        for (int i = 0; i < 16; ++i) { const int kc = att::crow(i, hi);
            { const bool ok = (kc >= c0) && (kc < c0 + 16); const float b = trow[ok ? kc : qc]; p0[i] = ok ? (p0[i] * 0.125f + b) * att::LOG2E : -INFINITY; }
            { const int k2 = kc + 32; const bool ok = (k2 >= c0) && (k2 < c0 + 16); const float b = trow[ok ? k2 : qc]; p1[i] = ok ? (p1[i] * 0.125f + b) * att::LOG2E : -INFINITY; } }
    }
    __device__ __forceinline__ att::bf16* o_ptr(int wid, int row) const { return out + (size_t)(tok0 + (4 * R4 + (wid >> 1)) * 64 + (wid & 1) * 32 + row) * DM + h * 64; }
    __device__ __forceinline__ void lse_out(int, int, float) const {}
};
struct PolMLA {
    static constexpr int ND0 = 6;
    const att::bf16* qkv2; const att::bf16* kpe; att::bf16* out; const float2* rope; int tok0, h, qt, S;
    __device__ __forceinline__ void init(int r, const unsigned char* ws) { int within; decode_unit(r, S, tok0, h, within); qt = within;
        qkv2 = (const att::bf16*)(ws + WS_QKV2); kpe = (const att::bf16*)(ws + WS_KPE); out = (att::bf16*)(ws + WS_ATT); rope = (const float2*)(ws + WS_ROPE_R); }
    __device__ __forceinline__ int ntiles() const { return S >> 6; }
    __device__ __forceinline__ const att::bf16* q_ptr(int wid, int r32) const { return qkv2 + (size_t)(tok0 + qt * 256 + wid * 32 + r32) * N_UP + h * 96; }
    __device__ __forceinline__ void q_fix(bf16x8 (&qr)[ND0], int wid, int r32, int hi) const { rope8(qr[4], qr[5], rope + (size_t)(qt * 256 + wid * 32 + r32) * 16 + 8 * hi); }
    __device__ __forceinline__ const void* k_src(int t, int wid, int lane) const { return qkv2 + (size_t)(tok0 + t * 64 + lane) * N_UP + 768 + h * 128 + wid * 8; }
    __device__ __forceinline__ const void* k2_src(int t, int wid, int lane) const { return kpe + (size_t)(tok0 + t * 64 + lane) * 32 + wid * 8; }
    __device__ __forceinline__ const void* v_src(int t, int wid, int lane) const { return qkv2 + (size_t)(tok0 + t * 64 + 16 * (wid & 3) + (lane >> 2)) * N_UP + 768 + h * 128 + 64 + (wid >> 2) * 32 + (lane & 3) * 8; }
    __device__ __forceinline__ bool needs(int, int) const { return true; }
    __device__ __forceinline__ void transform(f32x16& p0, f32x16& p1, int, int, int, int) const { constexpr float SC = 0.10206207261596577f * att::LOG2E;
#pragma unroll
        for (int i = 0; i < 16; ++i) { p0[i] *= SC; p1[i] *= SC; } }
    __device__ __forceinline__ att::bf16* o_ptr(int wid, int row) const { return out + (size_t)(tok0 + qt * 256 + wid * 32 + row) * DM + 512 + h * 64; }
    __device__ __forceinline__ void lse_out(int, int, float) const {}
};
struct PolDil {
    static constexpr int ND0 = 4;
    const att::bf16* qkv; att::bf16* og; float* lse; const float2* rope; int gi, d, tok0, h, rho, blk, ks, t_lo, nt;
    __device__ __forceinline__ void init(int r, int gi_, const unsigned char* ws) { int S, within; decode_unit(r, S, tok0, h, within); gi = gi_; d = 1 << (2 * gi);
        const int Ssub = S / d, nblk = Ssub >> 8; rho = within / nblk; blk = within % nblk; ks = 256 * blk - 64; t_lo = ks < 0 ? 1 : 0;
        int t_hi = (Ssub - ks) >> 6; if (t_hi > 6) t_hi = 6; nt = t_hi - t_lo;
        qkv = (const att::bf16*)(ws + WS_QKV); og = (att::bf16*)(ws + WS_OG) + (size_t)gi * NTOK * 512; lse = (float*)(ws + WS_LSE) + (size_t)gi * NTOK * 8; rope = (const float2*)(ws + WS_ROPE_H); }
    __device__ __forceinline__ int ntiles() const { return nt; }
    __device__ __forceinline__ int qtok(int wid, int row) const { return tok0 + (256 * blk + 32 * wid + row) * d + rho; }
    __device__ __forceinline__ const att::bf16* q_ptr(int wid, int r32) const { return qkv + (size_t)qtok(wid, r32) * N_DIL + gi * 1536 + h * 64; }
    __device__ __forceinline__ void q_fix(bf16x8 (&qr)[ND0], int wid, int r32, int hi) const { const float2* cs = rope + (size_t)((256 * blk + 32 * wid + r32) * d + rho) * 32 + 8 * hi;
        rope8(qr[0], qr[2], cs); rope8(qr[1], qr[3], cs + 16); }
    __device__ __forceinline__ const void* k_src(int t, int wid, int lane) const { return qkv + (size_t)(tok0 + (ks + 64 * (t + t_lo) + lane) * d + rho) * N_DIL + gi * 1536 + 512 + h * 64 + wid * 8; }
    __device__ __forceinline__ const void* k2_src(int, int, int) const { return nullptr; }
    __device__ __forceinline__ const void* v_src(int t, int wid, int lane) const { return qkv + (size_t)(tok0 + (ks + 64 * (t + t_lo) + 16 * (wid & 3) + (lane >> 2)) * d + rho) * N_DIL + gi * 1536 + 1024 + h * 64 + (wid >> 2) * 32 + (lane & 3) * 8; }
    __device__ __forceinline__ bool needs(int t, int wid) const { const int kt0 = ks + 64 * (t + t_lo), q0 = 256 * blk + 32 * wid; return kt0 + 63 >= q0 - 64 && kt0 <= q0 + 95; }
    __device__ __forceinline__ void transform(f32x16& p0, f32x16& p1, int t, int wid, int r32, int hi) const {
        const int rel = ks + 64 * (t + t_lo) - (256 * blk + 32 * wid + r32);
        constexpr float SC = 0.125f * att::LOG2E;
#pragma unroll
        for (int i = 0; i < 16; ++i) { const int dk = rel + att::crow(i, hi);
            p0[i] = (dk >= -64 && dk <= 64) ? p0[i] * SC : -INFINITY; p1[i] = (dk + 32 >= -64 && dk + 32 <= 64) ? p1[i] * SC : -INFINITY; }
    }
    __device__ __forceinline__ att::bf16* o_ptr(int wid, int row) const { return og + (size_t)qtok(wid, row) * 512 + h * 64; }
    __device__ __forceinline__ void lse_out(int wid, int r32, float v) const { lse[(size_t)qtok(wid, r32) * 8 + h] = v; }
};

__device__ __forceinline__ void pc_post_mixer(PP p, int layer, LAS unsigned char* lds, int vcu, int G, int tid, int lane, int wave) {
    LAS float* wr = (LAS float*)lds; LAS float* vec = (LAS float*)(lds + 65536);
    const float* wrg = p->in[21] + (size_t)layer * DM * NEXP;
    __syncthreads();
    for (int i = tid; i < DM * NEXP; i += NTHREADS) { const int k = i >> 4, e = i & 15; wr[e * DM + k] = wrg[i]; }
    for (int i = tid; i < DM; i += NTHREADS) { vec[3 * DM + i] = p->in[15][layer * DM + i]; vec[4 * DM + i] = p->in[16][layer * DM + i]; }
    const bf16* mix = (const bf16*)(p->ws + WS_MIX);
    for (int ch = vcu; ch < NTOK / 256; ch += G) {
        const int t0 = ch * 256, b = tok_bidx(t0);
        __syncthreads();
        load_mod_vec(p, vec, 2 * layer, b, 2, tid); load_mod_vec(p, vec + DM, 2 * layer + 1, b, 0, tid); load_mod_vec(p, vec + 2 * DM, 2 * layer + 1, b, 1, tid);
        __syncthreads();
        _Pragma("unroll 1") for (int i = 0; i < 32; ++i) { const int t = t0 + wave * 32 + i;
            const GAS f32x4* xr = (const GAS f32x4*)(layer == 0 ? x_in_row(p, t) : p->out + (size_t)t * DM) + lane;
            const GAS v2u* mr = (const GAS v2u*)(mix + (size_t)t * DM) + lane;
            f32x4 v[4]; float s = 0.f;
#pragma unroll
            for (int j = 0; j < 4; ++j) { const f32x4 x = xr[64 * j]; const v2u m2 = mr[64 * j]; const f32x4 gt = *(const LAS f32x4*)(vec + 4 * lane + 256 * j);
                const f32x4 o = {bflo(m2.x), bfhi(m2.x), bflo(m2.y), bfhi(m2.y)}; v[j] = x * DN_ALPHA + gt * o; s += (v[j].x + v[j].y) + (v[j].z + v[j].w); }
            const float mean = wave_sum(s) * (1.f / DM); float s2 = 0.f;
#pragma unroll
            for (int j = 0; j < 4; ++j) { v[j] = v[j] - mean; s2 += (v[j].x * v[j].x + v[j].y * v[j].y) + (v[j].z * v[j].z + v[j].w * v[j].w); }
            const float rstd = 1.f / sqrtf(wave_sum(s2) * (1.f / DM) + LN_EPS);
            GAS f32x4* orow = (GAS f32x4*)(p->out + (size_t)t * DM) + lane;
            float acc[NEXP];
#pragma unroll
            for (int e = 0; e < NEXP; ++e) acc[e] = 0.f;
#pragma unroll
            for (int j = 0; j < 4; ++j) { const int c = 4 * lane + 256 * j;
                const f32x4 g = *(const LAS f32x4*)(vec + 3 * DM + c), bb = *(const LAS f32x4*)(vec + 4 * DM + c), sh = *(const LAS f32x4*)(vec + DM + c), sc = *(const LAS f32x4*)(vec + 2 * DM + c);
                const f32x4 x1 = v[j] * rstd * g + bb; orow[64 * j] = x1; const f32x4 hh = x1 * (1.0f + sc) + sh; v[j] = hh;
#pragma unroll
                for (int eg = 0; eg < NEXP; eg += 4) {
#pragma unroll
                    for (int e = eg; e < eg + 4; ++e) { const f32x4 w = *(const LAS f32x4*)(wr + e * DM + c); acc[e] += (hh.x * w.x + hh.y * w.y) + (hh.z * w.z + hh.w * w.w); }
                    __builtin_amdgcn_sched_barrier(0); } }
            store_row_bf16((bf16*)(p->ws + WS_H) + (size_t)t * DM, v, lane);
            float mx = -INFINITY;
#pragma unroll
            for (int e = 0; e < NEXP; ++e) { acc[e] = wave_sum(acc[e]); mx = fmaxf(mx, acc[e]); }
            float den = 0.f;
#pragma unroll
            for (int e = 0; e < NEXP; ++e) { acc[e] = __expf(acc[e] - mx); den += acc[e]; }
            float mine = 0.f;
#pragma unroll
            for (int e = 0; e < NEXP; ++e) mine = (lane == e) ? acc[e] : mine;
            if (lane < NEXP) ((float*)(p->ws + WS_AFF))[((size_t)(t >> 15) * NEXP + lane) * GTOK + (t & (GTOK - 1))] = mine / den;
        }
    }
}

__device__ __forceinline__ void topk_phase(PP p, LAS unsigned char* lds, int tid, int lane, int wave) {
    LAS int* red = (LAS int*)lds;
    for (int prob = blockIdx.x; prob < 2 * NEXP; prob += gridDim.x) {
        const float* a = (const float*)(p->ws + WS_AFF) + (size_t)prob * GTOK + tid * 64;
        unsigned v[64];
#pragma unroll
        for (int i = 0; i < 16; ++i) { const v4u x = ((const GAS v4u*)a)[i]; v[4 * i] = x.x; v[4 * i + 1] = x.y; v[4 * i + 2] = x.z; v[4 * i + 3] = x.w; }
        unsigned prefix = 0u;
        __syncthreads();
#pragma unroll 1
        for (int bit = 30; bit >= 0; --bit) {
            const unsigned cand = prefix | (1u << bit); int c = 0;
#pragma unroll
            for (int i = 0; i < 64; ++i) c += (int)((cand - 1u - v[i]) >> 31);
            c = wave_sum_i(c);
            if (lane == 0) red[(bit & 1) * 8 + wave] = c;
            __syncthreads();
            int tot = 0;
#pragma unroll
            for (int w = 0; w < 8; ++w) tot += red[(bit & 1) * 8 + w];
            if (tot >= CAP) prefix = cand;
        }
        const unsigned T = prefix;
        unsigned cg = 0u, ce = 0u;
#pragma unroll
        for (int i = 0; i < 64; ++i) { cg += (v[i] > T) ? 1u : 0u; ce += (v[i] == T) ? 1u : 0u; if ((i & 7) == 7) __builtin_amdgcn_sched_barrier(0); }
        const unsigned pack = cg | (ce << 16); unsigned x = pack;
#pragma unroll
        for (int o = 1; o < 64; o <<= 1) { const unsigned y = __shfl_up(x, o); if (lane >= o) x += y; }
        if (lane == 63) red[32 + wave] = (int)x;
        __syncthreads();
        unsigned off = 0u, tot = 0u;
#pragma unroll
        for (int w = 0; w < 8; ++w) { const unsigned tw = (unsigned)red[32 + w]; tot += tw; off += (w < wave) ? tw : 0u; }
        const unsigned excl = x - pack + off;
        unsigned gt_before = excl & 0xffffu, eq_before = excl >> 16; const unsigned need_eq = (unsigned)CAP - (tot & 0xffffu);
        int* idx = (int*)(p->ws + WS_IDX) + (size_t)prob * CAP; float* gv = (float*)(p->ws + WS_GATEV) + (size_t)prob * CAP;
        int so[64];
#pragma unroll
        for (int i = 0; i < 64; ++i) {
            const bool isg = v[i] > T, ise = v[i] == T; const bool sel = isg || (ise && eq_before < need_eq);
            const unsigned slot = gt_before + (eq_before < need_eq ? eq_before : need_eq);
            if (sel) { idx[slot] = tid * 64 + i; gv[slot] = __uint_as_float(v[i]); }
            so[i] = sel ? (int)slot : -1; gt_before += isg ? 1u : 0u; eq_before += ise ? 1u : 0u; if ((i & 7) == 7) __builtin_amdgcn_sched_barrier(0); }
        GAS v4u* sp = (GAS v4u*)((int*)(p->ws + WS_SLOTOF) + (size_t)prob * GTOK + tid * 64);
#pragma unroll
        for (int i = 0; i < 16; ++i) { v4u w; w.x = (unsigned)so[4 * i]; w.y = (unsigned)so[4 * i + 1]; w.z = (unsigned)so[4 * i + 2]; w.w = (unsigned)so[4 * i + 3]; sp[i] = w; }
        __syncthreads();
    }
}

__device__ __forceinline__ void gather_phase(PP p, int g, int vcu, int G, int lane, int wave) {
    const int gw = vcu * NWAVES + wave, NGW = G * NWAVES;
    const int* idx = (const int*)(p->ws + WS_IDX) + (size_t)g * NEXP * CAP;
    for (int r = gw; r < NEXP * CAP; r += NGW) {
        const int tok = g * GTOK + idx[r];
        const GAS v4u* src = (const GAS v4u*)((const bf16*)(p->ws + WS_H) + (size_t)tok * DM) + lane; GAS v4u* dst = (GAS v4u*)((bf16*)(p->ws + WS_XE) + (size_t)r * DM) + lane;
        const v4u a = src[0], b = src[64]; dst[0] = a; dst[64] = b;
    }
}

__device__ __forceinline__ void pd_post_moe(PP p, int layer, LAS unsigned char* lds, int vcu, int G, int tid, int lane, int wave) {
    LAS float* vec = (LAS float*)lds;
    __syncthreads();
    for (int i = tid; i < DM; i += NTHREADS) { vec[DM + i] = p->in[19][layer * DM + i]; vec[2 * DM + i] = p->in[20][layer * DM + i]; }
    const bf16* ye = (const bf16*)(p->ws + WS_YE);
    for (int ch = vcu; ch < NTOK / 256; ch += G) {
        const int t0 = ch * 256, b = tok_bidx(t0);
        __syncthreads();
        load_mod_vec(p, vec, 2 * layer + 1, b, 2, tid);
        if (layer == 0) { load_mod_vec(p, vec + 3 * DM, 2, b, 0, tid); load_mod_vec(p, vec + 4 * DM, 2, b, 1, tid); }
        __syncthreads();
        _Pragma("unroll 1") for (int i = 0; i < 32; ++i) { const int t = t0 + wave * 32 + i, g = t >> 15, lt = t & (GTOK - 1);
            int slot = -1; float gval = 0.f;
            if (lane < NEXP) { slot = ((const int*)(p->ws + WS_SLOTOF))[((size_t)g * NEXP + lane) * GTOK + lt];
                if (slot >= 0) gval = ((const float*)(p->ws + WS_GATEV))[((size_t)g * NEXP + lane) * CAP + slot]; }
            f32x4 y[4];
#pragma unroll
            for (int j = 0; j < 4; ++j) y[j] = (f32x4){0.f, 0.f, 0.f, 0.f};
            unsigned long long mask = __ballot(slot >= 0);
            while (mask) { const int e = __builtin_ctzll(mask); mask &= mask - 1;
                const int s = __shfl(slot, e); const float gv = __shfl(gval, e);
                const GAS v2u* yr = (const GAS v2u*)(ye + ((size_t)(g * NEXP + e) * CAP + s) * DM) + lane;
#pragma unroll
                for (int j = 0; j < 4; ++j) { const v2u w = yr[64 * j]; y[j] += (f32x4){bflo(w.x), bfhi(w.x), bflo(w.y), bfhi(w.y)} * gv; } }
            GAS f32x4* xr = (GAS f32x4*)(p->out + (size_t)t * DM) + lane;
            f32x4 v[4]; float s = 0.f;
#pragma unroll
            for (int j = 0; j < 4; ++j) { const f32x4 x = xr[64 * j]; const f32x4 gt = *(const LAS f32x4*)(vec + 4 * lane + 256 * j); v[j] = x * DN_ALPHA + gt * y[j]; s += (v[j].x + v[j].y) + (v[j].z + v[j].w); }
            const float mean = wave_sum(s) * (1.f / DM); float s2 = 0.f;
#pragma unroll
            for (int j = 0; j < 4; ++j) { v[j] = v[j] - mean; s2 += (v[j].x * v[j].x + v[j].y * v[j].y) + (v[j].z * v[j].z + v[j].w * v[j].w); }
            const float rstd = 1.f / sqrtf(wave_sum(s2) * (1.f / DM) + LN_EPS);
#pragma unroll
            for (int j = 0; j < 4; ++j) { const int c = 4 * lane + 256 * j; const f32x4 gg = *(const LAS f32x4*)(vec + DM + c), bb = *(const LAS f32x4*)(vec + 2 * DM + c);
                const f32x4 x2 = v[j] * rstd * gg + bb; xr[64 * j] = x2;
                if (layer == 0) { const f32x4 sh = *(const LAS f32x4*)(vec + 3 * DM + c), sc = *(const LAS f32x4*)(vec + 4 * DM + c); v[j] = x2 * (1.0f + sc) + sh; } }
            if (layer == 0) store_row_bf16((bf16*)(p->ws + WS_H) + (size_t)t * DM, v, lane);
        }
    }
}

__device__ __forceinline__ void ropek_phase(PP p, int vcu, int G, int lane, int wave) {
    const int gw = vcu * NWAVES + wave, NGW = G * NWAVES;
    bf16* qkv = (bf16*)(p->ws + WS_QKV);
    for (int t = gw; t < NTOK; t += NGW) {
        const float2* cs0 = (const float2*)(p->ws + WS_ROPE_H) + (size_t)tok_pos(t) * 32;
#pragma unroll
        for (int i = 0; i < 2; ++i) { const int q = lane + 64 * i;
            if (q < 96) { const int gi = q >> 5, head = (q & 31) >> 2, ch = q & 3;
                bf16* base = qkv + (size_t)t * N_DIL + gi * 1536 + 512 + head * 64 + ch * 8;
                bf16x8 a = *(const bf16x8*)base, b = *(const bf16x8*)(base + 32);
                rope8(a, b, cs0 + ch * 8);
                *(bf16x8*)base = a; *(bf16x8*)(base + 32) = b; } }
    }
}
__device__ __forceinline__ void merge_phase(PP p, int vcu, int G, int lane, int wave) {
    const int gw = vcu * NWAVES + wave, NGW = G * NWAVES;
    const bf16* og = (const bf16*)(p->ws + WS_OG); const float* lse = (const float*)(p->ws + WS_LSE); bf16* mrg = (bf16*)(p->ws + WS_MRG);
    for (int t = gw; t < NTOK; t += NGW) {
        const int h = lane >> 3;
        const float l0 = lse[(size_t)t * 8 + h], l1 = lse[(size_t)NTOK * 8 + (size_t)t * 8 + h], l2 = lse[(size_t)2 * NTOK * 8 + (size_t)t * 8 + h];
        const float mx = fmaxf(l0, fmaxf(l1, l2)); float w0 = __expf(l0 - mx), w1 = __expf(l1 - mx), w2 = __expf(l2 - mx); const float inv = 1.0f / (w0 + w1 + w2); w0 *= inv; w1 *= inv; w2 *= inv;
        const v4u a = *((const GAS v4u*)(og + (size_t)t * 512) + lane), b = *((const GAS v4u*)(og + (size_t)NTOK * 512 + (size_t)t * 512) + lane), c = *((const GAS v4u*)(og + (size_t)2 * NTOK * 512 + (size_t)t * 512) + lane);
        v4u o;
#define MRG1(f) o.f = pk2(w0 * bflo(a.f) + w1 * bflo(b.f) + w2 * bflo(c.f), w0 * bfhi(a.f) + w1 * bfhi(b.f) + w2 * bfhi(c.f))
        MRG1(x); MRG1(y); MRG1(z); MRG1(w);
#undef MRG1
        *((GAS v4u*)(mrg + (size_t)t * 512) + lane) = o;
    }
}

__global__ void __launch_bounds__(NTHREADS, 2) fwd_kernel(Params p_unused) {
    extern __shared__ __attribute__((aligned(16))) unsigned char lds_raw[];
    LAS unsigned char* lds = (LAS unsigned char*)lds_raw;
    const int G = gridDim.x; const int bx = blockIdx.x; const int vcu = (G % 8 == 0) ? (bx % 8) * (G / 8) + bx / 8 : bx;
    { const int tid = opaque_tid(); for (int u = tid; u < (LDS_BYTES - LDSCTL_OFF) / 4; u += NTHREADS) ((LAS unsigned*)(lds + LDSCTL_OFF))[u] = 0u; }
    __syncthreads();
    XcdBarrier bar = xcd_barrier_post((unsigned*)(params_ptr()->ws + WS_CTL) + CW_BAR, (volatile LAS unsigned*)(lds + MISC_OFF) + 8);
    int ph = 0;
#define SEAM() do { if (++ph >= params_ptr()->ph_hi) return; xcd_barrier(bar); } while (0)
#define TL() const PP p = params_ptr(); unsigned char* ws = p->ws; (void)ws; const int tid = opaque_tid(), lane = tid & 63, wave = __builtin_amdgcn_readfirstlane(tid >> 6); (void)lane; (void)wave

    { TL(); p0_prologue(p, lds, vcu, G, tid, lane, wave); } SEAM();
    { TL(); p1_modulate(p, lds, vcu, G, tid, lane, wave); } SEAM();

    for (int layer = 0; layer < 2; ++layer) {
        if (layer == 0) {
            { const PP p = params_ptr(); unsigned char* ws = p->ws; pg8::Gemm g{(const bf16*)(ws + WS_H), (const bf16*)(ws + WS_WIN0), NTOK, N_IN0, DM}; pg8::StaticOrder S; S.init(NTOK, N_IN0, G, bx, 0);
              pg8::EpiBf16 E{(bf16*)(ws + WS_PROJ), N_IN0}; pg8::gemm_phase(lds, g, S, E); } SEAM();
            { TL(); p3_mla_prep(p, vcu, G, lane, wave); } SEAM();
            { const PP p = params_ptr(); unsigned char* ws = p->ws; pg8::Gemm g{(const bf16*)(ws + WS_A2), (const bf16*)(ws + WS_WUP), NTOK, N_UP, K_UP}; pg8::StaticOrder S; S.init(NTOK, N_UP, G, bx, 0);
              pg8::EpiBf16 E{(bf16*)(ws + WS_QKV2), N_UP}; pg8::gemm_phase(lds, g, S, E); } SEAM();
            { TL(); LAS float* tab = (LAS float*)(lds + att::L_TAB);
              __syncthreads();
              for (int i = tid; i < 8 * 465; i += NTHREADS) tab[i] = p->in[5][i];
              __syncthreads();
              for (int r = vcu; r < 2048; r += G) { PolNA pol; pol.init(r, ws, tab); att::attn_unit(pol, lds); }
              for (int r = vcu; r < 2048; r += G) { PolMLA pol; pol.init(r, ws); att::attn_unit(pol, lds); } } SEAM();
            { const PP p = params_ptr(); unsigned char* ws = p->ws; pg8::Gemm g{(const bf16*)(ws + WS_ATT), (const bf16*)(ws + WS_WOUT0), NTOK, DM, DM}; pg8::StaticOrder S; S.init(NTOK, DM, G, bx, 0);
              pg8::EpiBf16 E{(bf16*)(ws + WS_MIX), DM}; pg8::gemm_phase(lds, g, S, E); } SEAM();
        } else {
            { const PP p = params_ptr(); unsigned char* ws = p->ws; pg8::Gemm g{(const bf16*)(ws + WS_H), (const bf16*)(ws + WS_WDIL), NTOK, N_DIL, DM}; pg8::StaticOrder S; S.init(NTOK, N_DIL, G, bx, 0);
              pg8::EpiBf16 E{(bf16*)(ws + WS_QKV), N_DIL}; pg8::gemm_phase(lds, g, S, E); } SEAM();
            { TL(); ropek_phase(p, vcu, G, lane, wave); } SEAM();
            { const PP p = params_ptr(); unsigned char* ws = p->ws; __syncthreads();
              for (int u = vcu; u < 3 * 2048; u += G) { PolDil pol; pol.init(u & 2047, u >> 11, ws); att::attn_unit(pol, lds); } } SEAM();
            { TL(); merge_phase(p, vcu, G, lane, wave); } SEAM();
            { const PP p = params_ptr(); unsigned char* ws = p->ws; pg8::Gemm g{(const bf16*)(ws + WS_MRG), (const bf16*)(ws + WS_WOUT1), NTOK, DM, 512}; pg8::StaticOrder S; S.init(NTOK, DM, G, bx, 0);
              pg8::EpiBf16 E{(bf16*)(ws + WS_MIX), DM}; pg8::gemm_phase(lds, g, S, E); } SEAM();
        }
        { TL(); pc_post_mixer(p, layer, lds, vcu, G, tid, lane, wave); } SEAM();
        { TL(); topk_phase(p, lds, tid, lane, wave); } SEAM();
        for (int g2 = 0; g2 < 2; ++g2) {
            { TL(); gather_phase(p, g2, vcu, G, lane, wave); } SEAM();
            { const PP p = params_ptr(); unsigned char* ws = p->ws; pg8::Gemm g{(const bf16*)(ws + WS_XE), (const bf16*)(ws + WS_W13), NEXP * CAP, 2 * FF, DM}; pg8::StaticOrder S; S.init(NEXP * CAP, 2 * FF, G, bx, 1);
              pg8::EpiSwiGlu E{(bf16*)(ws + WS_HH), FF}; pg8::gemm_phase(lds, g, S, E); } SEAM();
            { const PP p = params_ptr(); unsigned char* ws = p->ws; pg8::Gemm g{(const bf16*)(ws + WS_HH), (const bf16*)(ws + WS_W2), NEXP * CAP, DM, FF}; pg8::StaticOrder S; S.init(NEXP * CAP, DM, G, bx, 1);
              pg8::EpiBf16 E{(bf16*)(ws + WS_YE) + (size_t)g2 * NEXP * CAP * DM, DM}; pg8::gemm_phase(lds, g, S, E); } SEAM();
        }
        { TL(); pd_post_moe(p, layer, lds, vcu, G, tid, lane, wave);
          if (layer == 0) {
            LAS float* scr = (LAS float*)(lds + 32768 + wave * 8448);
            __syncthreads();
            for (int it = vcu * NWAVES + wave; it < MOE_CVT_ITEMS; it += G * NWAVES) cvt_moe_item(p, 1, it, scr, lane);
          } }
        if (layer == 0) SEAM();
    }
#undef TL
#undef SEAM
}

extern "C" void kernel_launch(void* const* d_in, const int* in_sizes, int n_in, void* d_out, int out_size, void* d_ws, size_t ws_size, hipStream_t stream) {
    static int grid = 0;
    if (grid == 0) {
        if (n_in != 25 || out_size != NTOK * DM || ws_size < WS_END) { fprintf(stderr, "kernel_launch: unexpected shapes (n_in %d, out %d, ws %zu, need %zu); nothing launched\n", n_in, out_size, ws_size, (size_t)WS_END); grid = -1; return; }
        int dev = 0, cus = 0, per_cu = 0;
        if (hipGetDevice(&dev) != hipSuccess || hipDeviceGetAttribute(&cus, hipDeviceAttributeMultiprocessorCount, dev) != hipSuccess) { grid = -1; return; }
        if (hipFuncSetAttribute((const void*)fwd_kernel, hipFuncAttributeMaxDynamicSharedMemorySize, LDS_BYTES) != hipSuccess) { fprintf(stderr, "kernel_launch: hipFuncSetAttribute failed\n"); grid = -1; return; }
        if (hipOccupancyMaxActiveBlocksPerMultiprocessor(&per_cu, (const void*)fwd_kernel, NTHREADS, LDS_BYTES) != hipSuccess || per_cu < 1) fprintf(stderr, "kernel_launch: occupancy query reports %d\n", per_cu);
        (void)hipGetLastError();
        grid = cus;
    }
    if (grid < 0) return;
    if (hipMemsetAsync((char*)d_ws + WS_CTL, 0, CTL_ZERO_BYTES, stream) != hipSuccess) return;
    Params p{};
    for (int i = 0; i < 25; ++i) p.in[i] = (const float*)d_in[i];
    p.out = (float*)d_out; p.ws = (unsigned char*)d_ws;
#ifndef PH_HI
#define PH_HI 1000
#endif
    p.ph_hi = PH_HI; p.pad = 0;
    hipLaunchKernelGGL(fwd_kernel, dim3(grid), dim3(NTHREADS), LDS_BYTES, stream, p);
    const hipError_t le = hipPeekAtLastError();
    if (le != hipSuccess) fprintf(stderr, "kernel_launch: launch failed: %s\n", hipGetErrorName(le));
}
```

```cpp
#include <hip/hip_runtime.h>
#include <hip/hip_bf16.h>
#include <cstdio>
#include <cstdint>
#include <cmath>

#define LAS __attribute__((address_space(3)))
#define GAS __attribute__((address_space(1)))
__device__ __forceinline__ int opaque_tid(int wv) { unsigned z = 0u; asm volatile("" : "+v"(z)); return wv * 64 + (int)__builtin_amdgcn_mbcnt_hi(~0u, __builtin_amdgcn_mbcnt_lo(~0u, z)); }

namespace pg8 {
typedef unsigned short bf16_t;
typedef short bf16x8 __attribute__((ext_vector_type(8)));
typedef float f32x4 __attribute__((ext_vector_type(4)));
typedef unsigned u32x4 __attribute__((ext_vector_type(4)));
typedef int i32x4 __attribute__((ext_vector_type(4)));
typedef int i32x8 __attribute__((ext_vector_type(8)));
typedef unsigned u32x2 __attribute__((ext_vector_type(2)));
constexpr int BM = 256, BK = 64, HALF = 128, HTB = HALF * BK * 2, STAGE_BYTES = 8 * HTB, NXCD = 8, WGM = 8;

__host__ __device__ __forceinline__ int lds_byte(int r, int c) { const int st = (r >> 4) * 2 + (c >> 5), rr = r & 15, cc = c & 31, ob = rr * 64 + cc * 2; return st * 1024 + (ob ^ (((ob >> 9) & 1) << 5)); }
__host__ __device__ __forceinline__ void stage_rc(int b, int& R, int& C) { const int st = b / 1024, sb = b % 1024, swz = sb ^ (((sb >> 9) & 1) << 5); R = (st >> 1) * 16 + swz / 64; C = (st & 1) * 32 + (swz % 64) / 2; }
__host__ __device__ __forceinline__ int perm32(int rho) { const int n = rho >> 4, i = rho & 15; return 8 * (i >> 2) + 4 * n + (i & 3); }

struct Unit { int pm, pn, pb; };
struct Gemm { const bf16_t* A; const bf16_t* Bt; int M, N, K; };

struct StaticOrder {
    int nM, nN, nwg, G, c, ne;
    __device__ void init(int M, int N, int G_, int c_, int ne_) { nM = M / BM; nN = N / BM; nwg = nM * nN; G = G_; c = c_; ne = ne_; }
    __device__ bool next(int i, Unit& u) const {
        const long L = (long)i * G + c; if (L >= nwg) return false;
        int wgid = (int)L; { const int q = nwg / NXCD, r = nwg % NXCD, xcd = wgid % NXCD, off = wgid / NXCD; wgid = (xcd < r ? xcd * (q + 1) : r * (q + 1) + (xcd - r) * q) + off; }
        const int nig = WGM * nN, gid = wgid / nig, fm = gid * WGM, gsz = (nM - fm) < WGM ? (nM - fm) : WGM;
        u.pm = fm + ((wgid % nig) % gsz); u.pn = (wgid % nig) / gsz; u.pb = ne ? ((u.pm >> 4) & 15) * nN + u.pn : u.pn; return true;
    }
};

__device__ __forceinline__ unsigned cvt_pk_bf16(float lo, float hi) { unsigned r; asm volatile("v_cvt_pk_bf16_f32 %0, %1, %2" : "=v"(r) : "v"(lo), "v"(hi)); return r; }

struct EpiBf16 {
    static constexpr bool PERM = true;
    bf16_t* O; int ldc;
    __device__ __forceinline__ void operator()(const f32x4 (&acc)[2][2][4][2], const Unit& u, int wr, int wc, int fr, int fq) const {
        const int row0 = u.pm * BM + wr * 64 + fr; const int col0 = u.pn * BM + wc * 32 + 8 * fq;
#pragma unroll
        for (int ai = 0; ai < 2; ++ai)
#pragma unroll
            for (int m = 0; m < 4; ++m) { bf16_t* rowp = O + (size_t)(row0 + ai * HALF + m * 16) * ldc + col0;
#pragma unroll
                for (int bj = 0; bj < 2; ++bj) { const f32x4 v0 = acc[ai][bj][m][0], v1 = acc[ai][bj][m][1];
                    u32x4 w; w.x = cvt_pk_bf16(v0[0], v0[1]); w.y = cvt_pk_bf16(v0[2], v0[3]); w.z = cvt_pk_bf16(v1[0], v1[1]); w.w = cvt_pk_bf16(v1[2], v1[3]);
                    *(u32x4*)(rowp + bj * HALF) = w; } }
    }
};
__device__ __forceinline__ unsigned pk4_fp8(float a, float b, float c, float d) { int w = __builtin_amdgcn_cvt_pk_fp8_f32(a, b, 0, false); w = __builtin_amdgcn_cvt_pk_fp8_f32(c, d, w, true); return (unsigned)w; }
struct EpiBf16S {
    static constexpr bool PERM = true;
    bf16_t* O; int ldc; float sc;
    __device__ __forceinline__ void operator()(const f32x4 (&acc)[2][2][4][2], const Unit& u, int wr, int wc, int fr, int fq) const {
        const int row0 = u.pm * BM + wr * 64 + fr; const int col0 = u.pn * BM + wc * 32 + 8 * fq;
#pragma unroll
        for (int ai = 0; ai < 2; ++ai)
#pragma unroll
            for (int m = 0; m < 4; ++m) { bf16_t* rowp = O + (size_t)(row0 + ai * HALF + m * 16) * ldc + col0;
#pragma unroll
                for (int bj = 0; bj < 2; ++bj) { const f32x4 v0 = acc[ai][bj][m][0] * sc, v1 = acc[ai][bj][m][1] * sc;
                    u32x4 w; w.x = cvt_pk_bf16(v0[0], v0[1]); w.y = cvt_pk_bf16(v0[2], v0[3]); w.z = cvt_pk_bf16(v1[0], v1[1]); w.w = cvt_pk_bf16(v1[2], v1[3]);
                    *(u32x4*)(rowp + bj * HALF) = w; } }
    }
};
__device__ __forceinline__ int dil_row(int t, int gi) { const int lg = t < 32768 ? 12 : 13, S1 = (1 << lg) - 1, pos = t & S1, d2 = 2 * gi; return (t & ~S1) + ((pos & ((1 << d2) - 1)) << (lg - d2)) + (pos >> d2); }
struct EpiBf16Dil {
    static constexpr bool PERM = true;
    bf16_t* O; int ldc; const float2* rope;
    __device__ __forceinline__ void operator()(const f32x4 (&acc)[2][2][4][2], const Unit& u, int wr, int wc, int fr, int fq) const {
        const int row0 = u.pm * BM + wr * 64 + fr; const int col0 = u.pn * BM + wc * 32 + 8 * fq; const int gi = u.pn / 6; const bool qk = (u.pn % 6) < 4;
#pragma unroll
        for (int ai = 0; ai < 2; ++ai)
#pragma unroll
            for (int m = 0; m < 4; ++m) { const int t = row0 + ai * HALF + m * 16; bf16_t* rowp = O + (size_t)dil_row(t, gi) * ldc + col0;
                const float2* cs = rope + (size_t)(t < 32768 ? (t & 4095) : (t & 8191)) * 32;
#pragma unroll
                for (int bj = 0; bj < 2; ++bj) { f32x4 v0 = acc[ai][bj][m][0], v1 = acc[ai][bj][m][1];
                    if (qk) { const int i0 = ((col0 + bj * HALF) & 63) >> 1;
                        const f32x4 c01 = *(const f32x4*)(cs + i0), c23 = *(const f32x4*)(cs + i0 + 2);
                        const f32x4 r0 = {v0[0] * c01[0] - v0[1] * c01[1], v0[0] * c01[1] + v0[1] * c01[0], v0[2] * c01[2] - v0[3] * c01[3], v0[2] * c01[3] + v0[3] * c01[2]};
                        const f32x4 r1 = {v1[0] * c23[0] - v1[1] * c23[1], v1[0] * c23[1] + v1[1] * c23[0], v1[2] * c23[2] - v1[3] * c23[3], v1[2] * c23[3] + v1[3] * c23[2]};
                        v0 = r0; v1 = r1; }
                    u32x4 w; w.x = cvt_pk_bf16(v0[0], v0[1]); w.y = cvt_pk_bf16(v0[2], v0[3]); w.z = cvt_pk_bf16(v1[0], v1[1]); w.w = cvt_pk_bf16(v1[2], v1[3]);
                    *(u32x4*)(rowp + bj * HALF) = w; } }
    }
};
__device__ __forceinline__ float silu_f(float g) { return g * __builtin_amdgcn_rcpf(1.0f + __builtin_amdgcn_exp2f(-1.4426950408889634f * g)); }
struct EpiSwiGlu {
    static constexpr bool PERM = true;
    bf16_t* O; int ldc;
    __device__ __forceinline__ void operator()(const f32x4 (&acc)[2][2][4][2], const Unit& u, int wr, int wc, int fr, int fq) const {
        const int row0 = u.pm * BM + wr * 64 + fr; const int col0 = u.pn * HALF + wc * 32 + 8 * fq;
#pragma unroll
        for (int ai = 0; ai < 2; ++ai)
#pragma unroll
            for (int m = 0; m < 4; ++m) { bf16_t* rowp = O + (size_t)(row0 + ai * HALF + m * 16) * ldc + col0;
                const f32x4 g0 = acc[ai][0][m][0], g1 = acc[ai][0][m][1], u0 = acc[ai][1][m][0], u1 = acc[ai][1][m][1];
                u32x4 w; w.x = cvt_pk_bf16(silu_f(g0[0]) * u0[0], silu_f(g0[1]) * u0[1]); w.y = cvt_pk_bf16(silu_f(g0[2]) * u0[2], silu_f(g0[3]) * u0[3]);
                w.z = cvt_pk_bf16(silu_f(g1[0]) * u1[0], silu_f(g1[1]) * u1[1]); w.w = cvt_pk_bf16(silu_f(g1[2]) * u1[2], silu_f(g1[3]) * u1[3]);
                *(u32x4*)rowp = w; }
    }
};

struct EpiSwiGluF8 {
    static constexpr bool PERM = true;
    unsigned char* O; int ldc; float sc;
    __device__ __forceinline__ void operator()(const f32x4 (&acc)[2][2][4][2], const Unit& u, int wr, int wc, int fr, int fq) const {
        const int row0 = u.pm * BM + wr * 64 + fr; const int col0 = u.pn * HALF + wc * 32 + 8 * fq;
#pragma unroll
        for (int ai = 0; ai < 2; ++ai)
#pragma unroll
            for (int m = 0; m < 4; ++m) { unsigned char* rowp = O + (size_t)(row0 + ai * HALF + m * 16) * ldc + col0;
                const f32x4 g0 = acc[ai][0][m][0] * sc, g1 = acc[ai][0][m][1] * sc, u0 = acc[ai][1][m][0] * sc, u1 = acc[ai][1][m][1] * sc;
                u32x2 w; w.x = pk4_fp8(silu_f(g0[0]) * u0[0], silu_f(g0[1]) * u0[1], silu_f(g0[2]) * u0[2], silu_f(g0[3]) * u0[3]);
                w.y = pk4_fp8(silu_f(g1[0]) * u1[0], silu_f(g1[1]) * u1[1], silu_f(g1[2]) * u1[2], silu_f(g1[3]) * u1[3]);
                *(u32x2*)rowp = w; }
    }
};

template <class Epi, class Sched, bool GATHER = false, bool F8 = false>
__device__ __forceinline__ void gemm_phase(int wv, LAS unsigned char* lds, const Gemm g, const Sched& S, const Epi& E, const int* aidx = nullptr) {
    const int tid = opaque_tid(wv), wid = __builtin_amdgcn_readfirstlane(tid >> 6), lane = tid & 63, wr = wid >> 2, wc = wid & 3, fr = lane & 15, fq = lane >> 4;
    const int K = g.K; const unsigned RB = F8 ? (unsigned)K : 2u * (unsigned)K;
    const int nt = (int)(RB / 128u);
    const size_t kstep = (size_t)(BK * 2);
    const size_t hstep = (size_t)HALF * RB;
    const size_t tstep = 2 * hstep;
    unsigned vG[2][2], voffB[2];
#pragma unroll
    for (int i = 0; i < 2; ++i) { int R, C; stage_rc(tid * 16 + i * 8192, R, C); const int Rb = Epi::PERM ? ((R & ~31) + perm32(R & 31)) : R;
        vG[0][i] = (unsigned)R * RB + (unsigned)C * 2u; vG[1][i] = vG[0][i] + (unsigned)hstep; voffB[i] = (unsigned)Rb * RB + (unsigned)C * 2u; }
    const unsigned ldsw = (unsigned)wid * 1024u;
    const int aoff = lds_byte(wr * 64 + fr, fq * 8), boff = lds_byte(wc * 32 + fr, fq * 8);
    LAS int* itab = (LAS int*)(lds + STAGE_BYTES + 1024);
#define PG8_SA(b, h) (((b) * 2 + (h)) * HTB)
#define PG8_SB(b, h) ((4 + (b) * 2 + (h)) * HTB)
#define PG8_STAGE2(bufoff, gbase, o0, o1) do { \
        __builtin_amdgcn_global_load_lds((const unsigned*)((const char*)(gbase) + (o0)), (LAS unsigned*)(lds + (bufoff) + ldsw), 16, 0, 0); \
        __builtin_amdgcn_global_load_lds((const unsigned*)((const char*)(gbase) + (o1)), (LAS unsigned*)(lds + (bufoff) + ldsw + 8192), 16, 0, 0); } while (0)
#define PG8_STAGE(bufoff, gbase, voff) PG8_STAGE2(bufoff, gbase, (voff)[0], (voff)[1])
#define PG8_LD8(p_) __builtin_shufflevector(*(const LAS i32x4*)(p_), *(const LAS i32x4*)((p_) + 1024), 0, 1, 2, 3, 4, 5, 6, 7)
#define PG8_LDA(dst, b, h) do { if constexpr (F8) { _Pragma("unroll") for (int m = 0; m < 4; ++m) dst##8[m] = PG8_LD8(lds + PG8_SA(b, h) + aoff + m * 2048); } \
        else { _Pragma("unroll") for (int m = 0; m < 4; ++m) _Pragma("unroll") for (int k = 0; k < 2; ++k) dst[m][k] = *(const LAS bf16x8*)(lds + PG8_SA(b, h) + aoff + m * 2048 + k * 1024); } } while (0)
#define PG8_LDB(dst, b, h) do { if constexpr (F8) { _Pragma("unroll") for (int n = 0; n < 2; ++n) dst##8[n] = PG8_LD8(lds + PG8_SB(b, h) + boff + n * 2048); } \
        else { _Pragma("unroll") for (int n = 0; n < 2; ++n) _Pragma("unroll") for (int k = 0; k < 2; ++k) dst[n][k] = *(const LAS bf16x8*)(lds + PG8_SB(b, h) + boff + n * 2048 + k * 1024); } } while (0)
#define PG8_MMA(ai, bj, At, Bt) do { __builtin_amdgcn_s_setprio(1); \
        if constexpr (F8) { _Pragma("unroll") for (int m = 0; m < 4; ++m) _Pragma("unroll") for (int n = 0; n < 2; ++n) \
            asm volatile("v_mfma_f32_16x16x128_f8f6f4 %0, %1, %2, %0" : "+v"(acc[ai][bj][m][n]) : "v"(Bt##8[n]), "v"(At##8[m])); } \
        else { _Pragma("unroll") for (int m = 0; m < 4; ++m) _Pragma("unroll") for (int n = 0; n < 2; ++n) _Pragma("unroll") for (int k = 0; k < 2; ++k) \
            acc[ai][bj][m][n] = __builtin_amdgcn_mfma_f32_16x16x32_bf16(Bt[n][k], At[m][k], acc[ai][bj][m][n], 0, 0, 0); } __builtin_amdgcn_s_setprio(0); } while (0)
#define PG8_WAIT_V(n) asm volatile("s_waitcnt vmcnt(" #n ")" ::: "memory")
#define PG8_WAIT_L(n) asm volatile("s_waitcnt lgkmcnt(" #n ")" ::: "memory")
#define PG8_BAR __builtin_amdgcn_s_barrier()
#define PG8_SCHED __builtin_amdgcn_sched_barrier(0)
    Unit cur, nxt; int ui = 0; int sl_nx = 1, sl_n2 = 2;
    if (!S.next(0, cur)) return;
    if constexpr (GATHER) {
        Unit u1; const bool h1 = S.next(1, u1);
        if (tid < 256) { itab[tid] = aidx[cur.pm * BM + tid]; if (h1) itab[256 + tid] = aidx[u1.pm * BM + tid]; }
        __syncthreads();
#pragma unroll
        for (int h = 0; h < 2; ++h)
#pragma unroll
            for (int i = 0; i < 2; ++i) { int R, C; stage_rc(tid * 16 + i * 8192, R, C); vG[h][i] = (unsigned)itab[h * HALF + R] * RB + (unsigned)C * 2u; }
    }
    f32x4 acc[2][2][4][2];
#pragma unroll
    for (int a = 0; a < 2; ++a)
#pragma unroll
        for (int b = 0; b < 2; ++b)
#pragma unroll
            for (int m = 0; m < 4; ++m)
#pragma unroll
                for (int n = 0; n < 2; ++n) acc[a][b][m][n] = (f32x4){0.f, 0.f, 0.f, 0.f};
    bf16x8 At[4][2], B0[2][2], B1[2][2]; i32x8 At8[4], B08[2], B18[2];
    const char* cA = GATHER ? (const char*)g.A : (const char*)g.A + (size_t)cur.pm * tstep; const char* cB = (const char*)g.Bt + (size_t)cur.pb * tstep;
    PG8_STAGE(PG8_SB(0, 0), cB, voffB); PG8_STAGE(PG8_SB(0, 1), cB + hstep, voffB); PG8_STAGE(PG8_SA(0, 0), cA, vG[0]); PG8_STAGE(PG8_SA(0, 1), cA, vG[1]);
    if (wr == 1) PG8_BAR;
    PG8_WAIT_V(2); PG8_BAR;
    PG8_STAGE(PG8_SB(1, 0), cB + kstep, voffB); PG8_STAGE(PG8_SA(1, 0), cA + kstep, vG[0]); PG8_STAGE(PG8_SB(1, 1), cB + hstep + kstep, voffB);
    PG8_WAIT_V(6); PG8_BAR;
    for (;;) {
        const bool has_next = S.next(ui + 1, nxt);
        const char* nA = GATHER ? cA : (has_next ? (const char*)g.A + (size_t)nxt.pm * tstep : cA); const char* nB = has_next ? (const char*)g.Bt + (size_t)nxt.pb * tstep : cB;
        if constexpr (GATHER) { Unit u2;
            if (wid == 0 && S.next(ui + 2, u2)) {
                int lo_ = lane; asm volatile("" : "+v"(lo_));
                const int* src = aidx + (size_t)u2.pm * BM + lo_; LAS int* dst = itab + sl_n2 * 256;
#pragma unroll
                for (int q = 0; q < 4; ++q) __builtin_amdgcn_global_load_lds((const unsigned*)(src + q * 64), (LAS unsigned*)(dst + q * 64), 4, 0, 0); } }
        for (int t = 0; t < nt; t += 2) {
            const bool last = (t == nt - 2);
            const char* a1 = cA + (size_t)(t + 1) * kstep;
            const char* a2 = last ? nA : cA + (size_t)(t + 2) * kstep; const char* b2 = last ? nB : cB + (size_t)(t + 2) * kstep;
            const char* a3 = a2 + kstep; const char* b3 = b2 + kstep;
            unsigned o00 = vG[0][0], o01 = vG[0][1], o10 = vG[1][0], o11 = vG[1][1];
            if constexpr (GATHER) { if (last && has_next) { const LAS int* tb = itab + sl_nx * 256; int R0, C0, R1, C1; stage_rc((lane + wid * 64) * 16, R0, C0); stage_rc((lane + wid * 64) * 16 + 8192, R1, C1);
                o00 = (unsigned)tb[R0] * RB + (unsigned)C0 * 2u; o01 = (unsigned)tb[R1] * RB + (unsigned)C1 * 2u; o10 = (unsigned)tb[HALF + R0] * RB + (unsigned)C0 * 2u; o11 = (unsigned)tb[HALF + R1] * RB + (unsigned)C1 * 2u; } }
            PG8_LDB(B0, 0, 0); PG8_LDB(B1, 0, 1); PG8_SCHED; PG8_LDA(At, 0, 0); PG8_STAGE(PG8_SA(1, 1), a1, vG[1]);
            PG8_WAIT_V(8); PG8_WAIT_L(0); PG8_BAR; PG8_MMA(0, 0, At, B0); PG8_MMA(0, 1, At, B1); PG8_BAR; PG8_SCHED;
            PG8_LDA(At, 0, 1); PG8_STAGE(PG8_SB(0, 0), b2, voffB); PG8_STAGE(PG8_SB(0, 1), b2 + hstep, voffB); PG8_STAGE2(PG8_SA(0, 0), a2, o00, o01);
            PG8_WAIT_V(8); PG8_WAIT_L(0); PG8_BAR; PG8_MMA(1, 0, At, B0); PG8_MMA(1, 1, At, B1); PG8_BAR; PG8_SCHED;
            PG8_LDB(B0, 1, 0); PG8_LDB(B1, 1, 1); PG8_SCHED; PG8_LDA(At, 1, 0); PG8_STAGE2(PG8_SA(0, 1), a2, o10, o11);
            PG8_WAIT_V(8); PG8_WAIT_L(0); PG8_BAR; PG8_MMA(0, 0, At, B0); PG8_MMA(0, 1, At, B1); PG8_BAR; PG8_SCHED;
            PG8_LDA(At, 1, 1); PG8_STAGE(PG8_SB(1, 0), b3, voffB); PG8_STAGE(PG8_SB(1, 1), b3 + hstep, voffB); PG8_STAGE2(PG8_SA(1, 0), a3, o00, o01);
            PG8_WAIT_V(8); PG8_WAIT_L(0); PG8_BAR; PG8_MMA(1, 0, At, B0); PG8_MMA(1, 1, At, B1); PG8_BAR; PG8_SCHED;
        }
        if (wr == 0) PG8_BAR;
        if constexpr (F8) asm volatile("s_nop 15\n\ts_nop 15" ::: "memory");
        E(acc, cur, wr, wc, fr, fq);
        if (!has_next) break;
#pragma unroll
        for (int a = 0; a < 2; ++a)
#pragma unroll
            for (int b = 0; b < 2; ++b)
#pragma unroll
                for (int m = 0; m < 4; ++m)
#pragma unroll
                    for (int n = 0; n < 2; ++n) acc[a][b][m][n] = (f32x4){0.f, 0.f, 0.f, 0.f};
        cur = nxt; cA = nA; cB = nB; ++ui;
        { const int t3 = sl_nx; sl_nx = sl_n2; sl_n2 = (sl_n2 == 2) ? 0 : sl_n2 + 1; (void)t3; }
        if constexpr (GATHER) { const LAS int* tb = itab + ((sl_nx == 0) ? 2 : sl_nx - 1) * 256;
#pragma unroll
            for (int h = 0; h < 2; ++h)
#pragma unroll
                for (int i = 0; i < 2; ++i) { int R, C; stage_rc((lane + wid * 64) * 16 + i * 8192, R, C); vG[h][i] = (unsigned)tb[h * HALF + R] * RB + (unsigned)C * 2u; } }
        if (wr == 1) PG8_BAR;
    }
    PG8_WAIT_V(0);
    PG8_BAR;
#undef PG8_SA
#undef PG8_SB
#undef PG8_STAGE
#undef PG8_STAGE2
#undef PG8_LDA
#undef PG8_LDB
#undef PG8_MMA
#undef PG8_LD8
#undef PG8_WAIT_V
#undef PG8_WAIT_L
#undef PG8_BAR
#undef PG8_SCHED
}
}

namespace att {
typedef unsigned short bf16;
typedef short bf16x8 __attribute__((ext_vector_type(8)));
typedef short s16x4 __attribute__((ext_vector_type(4)));
typedef float f32x16 __attribute__((ext_vector_type(16)));
typedef unsigned u32x4 __attribute__((ext_vector_type(4)));
typedef float f32x4 __attribute__((ext_vector_type(4)));
typedef float f32x2_t __attribute__((ext_vector_type(2)));
typedef __bf16 bf16x2_t __attribute__((ext_vector_type(2)));
constexpr int NSLOT = 3, KSLOT = 12288, VSLOT = 8192;
constexpr int L_K = 0, L_V = NSLOT * KSLOT, L_WS = L_V + NSLOT * VSLOT, L_OST = L_WS + 8 * 64 * 4, L_TAB = 114688, L_END = L_TAB + 8 * 465 * 4;
static_assert(L_OST + 8 * 4096 <= L_TAB, "attention LDS");
static_assert(L_END <= 131072, "attention LDS");
constexpr int N_KSL = 8192, N_V = 4 * N_KSL, N_WS = N_V + 4 * VSLOT, N_OST = N_WS + 8 * 64 * 4;
static_assert(N_OST + 8 * 4096 <= L_TAB, "neighbourhood attention LDS");
constexpr float LOG2E = 1.4426950408889634f, LN2 = 0.6931471805599453f;
constexpr float THR = 8.0f;
__device__ __forceinline__ int crow(int r, int hi) { return (r & 3) + 8 * (r >> 2) + 4 * hi; }
#define ATT_SBAR() __builtin_amdgcn_sched_barrier(0)
__device__ __forceinline__ void glds16(const void* gsrc, unsigned lds_dst) { unsigned keep;
  asm volatile("s_mov_b32 %0, m0\n\ts_mov_b32 m0, %2\n\ts_nop 0\n\tglobal_load_lds_dwordx4 %1, off\n\ts_mov_b32 m0, %0" : "=&s"(keep) : "v"(gsrc), "s"(lds_dst) : "memory"); }
__device__ __forceinline__ void glds16s(unsigned vofs, const void* sbase, unsigned lds_dst) { unsigned keep;
  asm volatile("s_mov_b32 %0, m0\n\ts_mov_b32 m0, %3\n\ts_nop 0\n\tglobal_load_lds_dwordx4 %1, %2\n\ts_mov_b32 m0, %0" : "=&s"(keep) : "v"(vofs), "s"(sbase), "s"(lds_dst) : "memory"); }
__device__ __forceinline__ float max3f(float a, float b, float c) { float r; asm("v_max3_f32 %0, %1, %2, %3" : "=v"(r) : "v"(a), "v"(b), "v"(c)); return r; }
__device__ __forceinline__ unsigned cvtpk_s(float lo, float hi) { f32x2_t v = {lo, hi}; bf16x2_t b = __builtin_convertvector(v, bf16x2_t); return __builtin_bit_cast(unsigned, b); }
__device__ __forceinline__ float bf2f(short s) { return __uint_as_float(((unsigned)(unsigned short)s) << 16); }
#define ATT_WAIT_BAR(N) asm volatile("s_waitcnt vmcnt(" #N ") lgkmcnt(0)\n\ts_barrier" ::: "memory")

template <int ND0> __device__ __forceinline__ void qkt(f32x16& p0, f32x16& p1, const LAS unsigned char* Kslot, const bf16x8* qr, int r32, int hi) {
  const LAS unsigned char* kb = Kslot + hi * 1024 + r32 * 16;
#pragma unroll
  for (int d0 = 0; d0 < ND0; ++d0) {
    const bf16x8 b0 = *(const LAS bf16x8*)(kb + d0 * 2048);
    const bf16x8 b1 = *(const LAS bf16x8*)(kb + d0 * 2048 + 512);
    p0 = __builtin_amdgcn_mfma_f32_32x32x16_bf16(b0, qr[d0], p0, 0, 0, 0); p1 = __builtin_amdgcn_mfma_f32_32x32x16_bf16(b1, qr[d0], p1, 0, 0, 0); }
}
__device__ __forceinline__ float rowmax(const f32x16& p0, const f32x16& p1) {
  float a = max3f(p0[0], p0[1], p1[0]), b = max3f(p0[2], p0[3], p1[1]); a = max3f(a, p1[2], p1[3]);
#pragma unroll
  for (int r = 4; r < 16; r += 4) { a = max3f(a, p0[r], p0[r + 1]); b = max3f(b, p0[r + 2], p0[r + 3]); a = max3f(a, p1[r], p1[r + 1]); b = max3f(b, p1[r + 2], p1[r + 3]); }
  const float m = fmaxf(a, b);
  auto rr = __builtin_amdgcn_permlane32_swap(__float_as_uint(m), __float_as_uint(m), false, false);
  return fmaxf(__uint_as_float(rr[0]), __uint_as_float(rr[1]));
}
__device__ __forceinline__ void pv(f32x16* o, int vb, bf16x8 pa0, bf16x8 pa1, bf16x8 pa2, bf16x8 pa3) {
#pragma unroll
  for (int d0 = 0; d0 < 2; ++d0) { s16x4 lo[4], hi[4];
#pragma unroll
    for (int ks = 0; ks < 4; ++ks) {
      asm volatile("ds_read_b64_tr_b16 %0,%1 offset:%c2" : "=&v"(lo[ks]) : "v"(vb), "i"(d0 * 4096 + ks * 1024) : "memory");
      asm volatile("ds_read_b64_tr_b16 %0,%1 offset:%c2" : "=&v"(hi[ks]) : "v"(vb), "i"(d0 * 4096 + ks * 1024 + 512) : "memory"); }
    asm volatile("s_waitcnt lgkmcnt(0)" ::: "memory"); ATT_SBAR();
#define ATT_PK(k) (bf16x8){lo[k][0], lo[k][1], lo[k][2], lo[k][3], hi[k][0], hi[k][1], hi[k][2], hi[k][3]}
    o[d0] = __builtin_amdgcn_mfma_f32_32x32x16_bf16(pa0, ATT_PK(0), o[d0], 0, 0, 0);
    o[d0] = __builtin_amdgcn_mfma_f32_32x32x16_bf16(pa1, ATT_PK(1), o[d0], 0, 0, 0);
    o[d0] = __builtin_amdgcn_mfma_f32_32x32x16_bf16(pa2, ATT_PK(2), o[d0], 0, 0, 0);
    o[d0] = __builtin_amdgcn_mfma_f32_32x32x16_bf16(pa3, ATT_PK(3), o[d0], 0, 0, 0);
#undef ATT_PK
  }
}

template <int KLO, int KHI> __device__ __forceinline__ void pv_r(f32x16* o, int vb, bf16x8 pa0, bf16x8 pa1, bf16x8 pa2, bf16x8 pa3) {
#pragma unroll
  for (int d0 = 0; d0 < 2; ++d0) { s16x4 lo[4], hi[4];
#pragma unroll
    for (int ks = KLO; ks < KHI; ++ks) {
      asm volatile("ds_read_b64_tr_b16 %0,%1 offset:%c2" : "=&v"(lo[ks]) : "v"(vb), "i"(d0 * 4096 + ks * 1024) : "memory");
      asm volatile("ds_read_b64_tr_b16 %0,%1 offset:%c2" : "=&v"(hi[ks]) : "v"(vb), "i"(d0 * 4096 + ks * 1024 + 512) : "memory"); }
    asm volatile("s_waitcnt lgkmcnt(0)" ::: "memory"); ATT_SBAR();
#define ATT_PK(k) (bf16x8){lo[k][0], lo[k][1], lo[k][2], lo[k][3], hi[k][0], hi[k][1], hi[k][2], hi[k][3]}
    if (KLO <= 0 && 0 < KHI) o[d0] = __builtin_amdgcn_mfma_f32_32x32x16_bf16(pa0, ATT_PK(0), o[d0], 0, 0, 0);
    if (KLO <= 1 && 1 < KHI) o[d0] = __builtin_amdgcn_mfma_f32_32x32x16_bf16(pa1, ATT_PK(1), o[d0], 0, 0, 0);
    if (KLO <= 2 && 2 < KHI) o[d0] = __builtin_amdgcn_mfma_f32_32x32x16_bf16(pa2, ATT_PK(2), o[d0], 0, 0, 0);
    if (KLO <= 3 && 3 < KHI) o[d0] = __builtin_amdgcn_mfma_f32_32x32x16_bf16(pa3, ATT_PK(3), o[d0], 0, 0, 0);
#undef ATT_PK
  }
}
template <class P, int VAR> __device__ __forceinline__ float rowmax_v(const f32x16& p0, const f32x16& p1) {
  const f32x16& F = (VAR == 0) ? p0 : p1; const f32x16& H = (VAR == 0) ? p1 : p0; constexpr int o = P::live4(VAR);
  float a = max3f(F[0], F[1], F[2]), b = max3f(F[3], F[4], F[5]); a = max3f(a, F[6], F[7]); b = max3f(b, F[8], F[9]); a = max3f(a, F[10], F[11]); b = max3f(b, F[12], F[13]); a = max3f(a, F[14], F[15]);
  b = max3f(b, H[o], H[o + 1]); a = max3f(a, H[o + 2], H[o + 3]);
  const float m = fmaxf(a, b);
  auto rr = __builtin_amdgcn_permlane32_swap(__float_as_uint(m), __float_as_uint(m), false, false);
  return fmaxf(__uint_as_float(rr[0]), __uint_as_float(rr[1]));
}
template <class P, class R> __device__ __forceinline__ void attn_unit(int wv, const P& pol, LAS unsigned char* shm, R& rider, const P& nxt, bool has_nxt, bool pre) {
  constexpr int ND0 = P::ND0;
  const int tid = opaque_tid(wv), lane = tid & 63, r32 = lane & 31, hi = lane >> 5; const int wid = __builtin_amdgcn_readfirstlane(tid >> 6);
  const unsigned lds0 = (unsigned)(uintptr_t)shm;
  static_assert(ND0 == 4, "this unit's ring is laid out for qk dim 64 (8 KiB K tiles): four slots, requests three tiles ahead");
  LAS float* wsf = (LAS float*)(shm + N_WS) + wid * 64;
  const int NT = pol.ntiles();
  const bool three = (ND0 == 6) && (wid < 4);
#define ATT_DMA_P(PL, t, slot) do { \
    glds16((PL).k_src((t), wid, lane), (unsigned)__builtin_amdgcn_readfirstlane(lds0 + (slot) * N_KSL + wid * 1024)); \
    glds16((PL).v_src((t), wid, lane), (unsigned)__builtin_amdgcn_readfirstlane(lds0 + N_V + (slot) * VSLOT + wid * 1024)); } while (0)
#define ATT_DMA(t, slot) ATT_DMA_P(pol, t, slot)
  if (!pre) { ATT_DMA(0, 0); ATT_DMA(1, 1); ATT_DMA(2, 2); }
  bf16x8 qr[ND0];
  { const bf16* qp = pol.q_ptr(wid, r32);
#pragma unroll
    for (int d0 = 0; d0 < ND0; ++d0) qr[d0] = *reinterpret_cast<const bf16x8*>(qp + d0 * 16 + hi * 8); }
  pol.q_fix(qr, wid, r32, hi);
  float m = -1e30f, lsum = 0.f; f32x16 o[2]; o[0] = f32x16{}; o[1] = f32x16{};
  const int vb0 = (int)(lds0 + N_V) + ((lane >> 4) & 1) * 32 + (lane & 3) * 8 + (4 * hi + ((lane & 15) >> 2)) * 64;
  ATT_WAIT_BAR(0);
  f32x4 rw[R::NW]; rider.begin(lane, rw);
  int s_cur = 0, s_n3 = 3;
  for (int t = 0; t < NT; ++t) {
    if (t + 3 < NT) ATT_DMA(t + 3, s_n3);
    const int xr = rider.mid(t, NT, lane, rw);
    if (pol.needs(t, wid)) {
#define ATT_BODY(VAR) do { \
      f32x16 p0 = f32x16{}, p1 = f32x16{}; \
      qkt<ND0>(p0, p1, shm + s_cur * N_KSL, qr, r32, hi); \
      pol.template transform_v<VAR>(p0, p1, t, wid, r32, hi); \
      const float rm = rowmax_v<P, VAR>(p0, p1); \
      const bool grow = rm > m + THR; \
      if (__any(grow)) { \
        const float mn = grow ? rm : m; const float f = __builtin_amdgcn_exp2f(m - mn); m = mn; lsum *= f; \
        if (hi == 0) wsf[r32] = f; \
        asm volatile("s_waitcnt lgkmcnt(0)" ::: "memory"); \
        _Pragma("unroll") for (int r = 0; r < 16; ++r) { const float ff = wsf[crow(r, hi)]; o[0][r] *= ff; o[1][r] *= ff; } } \
      float sacc = 0.f; \
      _Pragma("unroll") for (int r = 0; r < 16; ++r) { \
        if (!P::dead(VAR, 0, r)) { p0[r] = __builtin_amdgcn_exp2f(p0[r] - m); sacc += p0[r]; } else p0[r] = 0.f; \
        if (!P::dead(VAR, 1, r)) { p1[r] = __builtin_amdgcn_exp2f(p1[r] - m); sacc += p1[r]; } else p1[r] = 0.f; } \
      lsum += sacc; \
      u32x4 pw0, pw1, pw2, pw3; \
      pw0 = (u32x4){cvtpk_s(p0[0], p0[1]), cvtpk_s(p0[2], p0[3]), cvtpk_s(p0[4], p0[5]), cvtpk_s(p0[6], p0[7])}; \
      pw1 = (u32x4){cvtpk_s(p0[8], p0[9]), cvtpk_s(p0[10], p0[11]), cvtpk_s(p0[12], p0[13]), cvtpk_s(p0[14], p0[15])}; \
      pw2 = (u32x4){cvtpk_s(p1[0], p1[1]), cvtpk_s(p1[2], p1[3]), cvtpk_s(p1[4], p1[5]), cvtpk_s(p1[6], p1[7])}; \
      pw3 = (u32x4){cvtpk_s(p1[8], p1[9]), cvtpk_s(p1[10], p1[11]), cvtpk_s(p1[12], p1[13]), cvtpk_s(p1[14], p1[15])}; \
      ATT_SBAR(); \
      pv_r<P::kslo(VAR), P::kshi(VAR)>(o, vb0 + s_cur * VSLOT, __builtin_bit_cast(bf16x8, pw0), __builtin_bit_cast(bf16x8, pw1), __builtin_bit_cast(bf16x8, pw2), __builtin_bit_cast(bf16x8, pw3)); \
      } while (0)
      if (pol.variant(wid)) ATT_BODY(1); else ATT_BODY(0);
#undef ATT_BODY
    }
    if (xr == 16 && t + 3 < NT) ATT_WAIT_BAR(20); else if (xr == 20 && t + 3 < NT) ATT_WAIT_BAR(24);
    else if (t + 3 < NT) ATT_WAIT_BAR(4); else if (t + 2 < NT) ATT_WAIT_BAR(2); else ATT_WAIT_BAR(0);
    s_cur = (s_cur + 1) & 3; s_n3 = (s_n3 + 1) & 3;
  }
  rider.end(lane, rw);
  if (has_nxt) { ATT_DMA_P(nxt, 0, 0); ATT_DMA_P(nxt, 1, 1); ATT_DMA_P(nxt, 2, 2); }
  { auto rr = __builtin_amdgcn_permlane32_swap(__float_as_uint(lsum), __float_as_uint(lsum), false, false); lsum = __uint_as_float(rr[0]) + __uint_as_float(rr[1]); }
  if (hi == 0) { wsf[32 + r32] = lsum; pol.lse_out(wid, r32, (m + __builtin_amdgcn_logf(lsum)) * LN2); }
  asm volatile("s_waitcnt lgkmcnt(0)" ::: "memory");
  float rli[16];
#pragma unroll
  for (int r = 0; r < 16; ++r) rli[r] = __builtin_amdgcn_rcpf(wsf[32 + crow(r, hi)]);
  { LAS bf16* stg = (LAS bf16*)(shm + N_OST) + wid * 2048;
#pragma unroll
    for (int r = 0; r < 16; ++r) { const int orow = crow(r, hi);
#pragma unroll
      for (int d0 = 0; d0 < 2; ++d0) stg[orow * 64 + d0 * 32 + r32] = (bf16)(cvtpk_s(o[d0][r] * rli[r], 0.f) & 0xffffu); }
    asm volatile("s_waitcnt lgkmcnt(0)" ::: "memory");
#pragma unroll
    for (int i = 0; i < 4; ++i) { const int row = i * 8 + (lane >> 3), ch = lane & 7; const u32x4 v = *(const LAS u32x4*)(stg + row * 64 + ch * 8); *(u32x4*)(pol.o_ptr(wid, row) + ch * 8) = v; } }
  asm volatile("s_waitcnt lgkmcnt(0)\n\ts_barrier" ::: "memory");
#undef ATT_DMA
#undef ATT_DMA_P
}

typedef short v4i16_t __attribute__((ext_vector_type(4)));
__device__ __forceinline__ s16x4 vtr(const LAS unsigned char* p) { return __builtin_bit_cast(s16x4, __builtin_amdgcn_ds_read_tr16_b64_v4i16((LAS v4i16_t*)p)); }
#define ATT_PIN(x) asm volatile("" : "+v"(x))
#define ATT_MFMA(a, b, c) __builtin_amdgcn_mfma_f32_32x32x16_bf16(a, b, c, 0, 0, 0)
template <class P, class R> __device__ __forceinline__ void attn_unit_pipe(int wv, const P& pol, LAS unsigned char* shm, R& rider, const P& nxt, bool has_nxt, bool pre) {
  static_assert(P::ND0 == 6 && P::FUSED, "dense pipelined unit: qk dim 96, scale folded into the exponent");
  const int tid = opaque_tid(wv), lane = tid & 63, r32 = lane & 31, hi = lane >> 5; const int wid = __builtin_amdgcn_readfirstlane(tid >> 6);
  const unsigned lds0 = (unsigned)(uintptr_t)shm;
  LAS float* wsf = (LAS float*)(shm + L_WS) + wid * 64;
  const int NT = pol.ntiles();
  const bool three = wid < 4;
  const unsigned kofs = P::k_lofs(wid, lane), k2ofs = P::k2_lofs(wid, lane), vofs = P::v_lofs(wid, lane);
  const unsigned kdst = (unsigned)__builtin_amdgcn_readfirstlane(lds0 + L_K + wid * 1024), vdst = (unsigned)__builtin_amdgcn_readfirstlane(lds0 + L_V + wid * 1024);
#define ATT_DMAK(PL, t, slot) do { glds16s(kofs, (PL).k_base() + (size_t)(t) * P::KSTRIDE, kdst + (slot) * KSLOT); \
    if (three) glds16s(k2ofs, (PL).k2_base() + (size_t)(t) * P::K2STRIDE, kdst + 8192 + (slot) * KSLOT); } while (0)
#define ATT_DMAV(PL, t, slot) glds16s(vofs, (PL).k_base() + (size_t)(t) * P::KSTRIDE, vdst + (slot) * VSLOT)
  if (!pre) { ATT_DMAK(pol, 0, 0); ATT_DMAK(pol, 1, 1); }
  bf16x8 qr[6];
  { const bf16* qp = pol.q_ptr(wid, r32);
#pragma unroll
    for (int d0 = 0; d0 < 6; ++d0) qr[d0] = *reinterpret_cast<const bf16x8*>(qp + d0 * 16 + hi * 8); }
  pol.q_fix(qr, wid, r32, hi);
  ATT_DMAV(pol, 0, 0);
  float mhat = 0.f, lsum = 0.f; f32x16 o[2]; o[0] = f32x16{}; o[1] = f32x16{};
  const LAS unsigned char* vp0 = shm + L_V + ((lane >> 4) & 1) * 32 + (lane & 3) * 8 + (4 * hi + ((lane & 15) >> 2)) * 64;
  const LAS unsigned char* kp0 = shm + L_K + hi * 1024 + r32 * 16;
  f32x16 pA0, pA1, pB0, pB1; u32x4 pw0, pw1, pw2, pw3; bool resc = false, rl = false;
  asm volatile("s_waitcnt vmcnt(1) lgkmcnt(0)\n\ts_barrier" ::: "memory");
  f32x4 rw[R::NW]; rider.begin(lane, rw);
  int sl_prev = 2, sl_cur = 0, sl_next = 1;
#define ATT_ROT() do { const int t_ = sl_prev; sl_prev = sl_cur; sl_cur = sl_next; sl_next = t_; } while (0)
#define ATT_KF(i) (*(const LAS bf16x8*)(kp_ + ((i) >> 1) * 2048 + ((i) & 1) * 512))
#define ATT_EX(v) __builtin_amdgcn_exp2f(__builtin_fmaf((v), P::SC, nmh))
#define ATT_RESC() do { if (resc) { _Pragma("unroll") for (int d_ = 0; d_ < 2; ++d_) _Pragma("unroll") for (int r = 0; r < 16; ++r) o[d_][r] *= wsf[crow(r, hi)]; } } while (0)
  ATT_DMAK(pol, 2, 2); ATT_DMAV(pol, 1, 1);
  { const LAS unsigned char* kp_ = kp0; pA0 = f32x16{}; pA1 = f32x16{};
#pragma unroll
    for (int d0 = 0; d0 < 6; ++d0) { const bf16x8 b0 = ATT_KF(2 * d0), b1 = ATT_KF(2 * d0 + 1); pA0 = ATT_MFMA(b0, qr[d0], pA0); pA1 = ATT_MFMA(b1, qr[d0], pA1); }
    const float rm = rowmax(pA0, pA1); mhat = rm * P::SC; const float nmh = -mhat;
#pragma unroll
    for (int r = 0; r < 16; ++r) pA0[r] = ATT_EX(pA0[r]);
#pragma unroll
    for (int r = 0; r < 8; ++r) pA1[r] = ATT_EX(pA1[r]); }
  if (three) ATT_WAIT_BAR(3); else ATT_WAIT_BAR(2);
  ATT_ROT();
#define ATT_PKW(X, i) cvtpk_s(X[i], X[(i) + 1])
#define ATT_PAF(k) __builtin_bit_cast(bf16x8, pw##k)
#define ATT_VFR(v) (bf16x8){v##l[0], v##l[1], v##l[2], v##l[3], v##h[0], v##h[1], v##h[2], v##h[3]}
#define ATT_VRD(v, f) do { v##l = vtr(vp_ + ((f) >> 2) * 4096 + ((f) & 3) * 1024); v##h = vtr(vp_ + ((f) >> 2) * 4096 + ((f) & 3) * 1024 + 512); } while (0)
#define ATT_GAPE(LD, MF, X, i) do { LD; MF; X[i] = ATT_EX0(X[i]); X[(i) + 1] = ATT_EX0(X[(i) + 1]); ATT_PIN(X); ATT_SBAR(); } while (0)
#define ATT_GAPA(LD, MF, a0, a1, a2, a3, W0, W1, PW) do { LD; MF; sacc += a0; sacc += a1; sacc += a2; sacc += a3; W0; W1; ATT_PIN(PW); ATT_PIN(sacc); ATT_SBAR(); } while (0)
#define ATT_GAPB(LD, MF, X, a, Y, b, Z, c) do { LD; MF; X[a] = ATT_EX(X[a]); Y[b] = ATT_EX(Y[b]); Z[c] = ATT_EX(Z[c]); ATT_PIN(X); ATT_PIN(Z); ATT_SBAR(); } while (0)
#define ATT_EX0(v) __builtin_amdgcn_exp2f(__builtin_fmaf((v), P::SC, nmh0))
#define ATT_STEP(C0, C1, P0, P1, s, GK, GV) do { ATT_SBAR(); \
    rl = rider.pre((s), lane, rw);                                  \
    if (GK) ATT_DMAK(pol, (s) + 2, sl_prev); if (GV) ATT_DMAV(pol, (s) + 1, sl_next); \
    if (rl) rider.post(lane, rw);                                   \
    const LAS unsigned char* kp_ = kp0 + sl_cur * KSLOT; const LAS unsigned char* vp_ = vp0 + sl_prev * VSLOT; const float nmh0 = -mhat; \
    bf16x8 k0 = ATT_KF(0), k1 = ATT_KF(1), k2; s16x4 vAl, vAh, vBl, vBh, vCl, vCh; ATT_SBAR(); \
    ATT_GAPE(k2 = ATT_KF(2),  C0 = ATT_MFMA(k0, qr[0], f32x16{}), P1, 8); \
    ATT_GAPE(k0 = ATT_KF(3),  C1 = ATT_MFMA(k1, qr[0], f32x16{}), P1, 10); \
    ATT_GAPE(k1 = ATT_KF(4),  C0 = ATT_MFMA(k2, qr[1], C0),       P1, 12); \
    ATT_GAPE(k2 = ATT_KF(5),  C1 = ATT_MFMA(k0, qr[1], C1),       P1, 14); \
    float sacc = P0[0] + P0[1]; \
    ATT_GAPA(k0 = ATT_KF(6),  C0 = ATT_MFMA(k1, qr[2], C0),       P0[2], P0[3], P0[4], P0[5],     pw0[0] = ATT_PKW(P0, 0),  pw0[1] = ATT_PKW(P0, 2),  pw0); \
    ATT_GAPA(k1 = ATT_KF(7),  C1 = ATT_MFMA(k2, qr[2], C1),       P0[6], P0[7], P0[8], P0[9],     pw0[2] = ATT_PKW(P0, 4),  pw0[3] = ATT_PKW(P0, 6),  pw0); \
    ATT_GAPA(k2 = ATT_KF(8),  C0 = ATT_MFMA(k0, qr[3], C0),       P0[10], P0[11], P0[12], P0[13], pw1[0] = ATT_PKW(P0, 8),  pw1[1] = ATT_PKW(P0, 10), pw1); \
    ATT_GAPA(k0 = ATT_KF(9),  C1 = ATT_MFMA(k1, qr[3], C1),       P0[14], P0[15], P1[0], P1[1],   pw1[2] = ATT_PKW(P0, 12), pw1[3] = ATT_PKW(P0, 14), pw1); \
    ATT_GAPA(k1 = ATT_KF(10), C0 = ATT_MFMA(k2, qr[4], C0),       P1[2], P1[3], P1[4], P1[5],     pw2[0] = ATT_PKW(P1, 0),  pw2[1] = ATT_PKW(P1, 2),  pw2); \
    ATT_GAPA(k2 = ATT_KF(11), C1 = ATT_MFMA(k0, qr[4], C1),       P1[6], P1[7], P1[8], P1[9],     pw2[2] = ATT_PKW(P1, 4),  pw2[3] = ATT_PKW(P1, 6),  pw2); \
    ATT_GAPA(ATT_VRD(vA, 0),  C0 = ATT_MFMA(k1, qr[5], C0),       P1[10], P1[11], P1[12], P1[13], pw3[0] = ATT_PKW(P1, 8),  pw3[1] = ATT_PKW(P1, 10), pw3); \
    ATT_GAPA(ATT_VRD(vB, 4),  C1 = ATT_MFMA(k2, qr[5], C1),       P1[14], P1[15], 0.f, 0.f,       pw3[2] = ATT_PKW(P1, 12), pw3[3] = ATT_PKW(P1, 14), pw3); \
    lsum += sacc; \
    { const float rm = __builtin_fmaf(rowmax(C0, C1), P::SC, -mhat); resc = false;                                        \
      if (__builtin_expect(__any(rm > THR), 0)) { const float dl = __builtin_fmaxf(rm, 0.f); mhat += dl;                   \
          const float f = __builtin_amdgcn_exp2f(-dl); lsum *= f; if (hi == 0) wsf[r32] = f; resc = true; } } \
    const float nmh = -mhat; ATT_SBAR(); \
    ATT_GAPB(ATT_VRD(vC, 1), o[0] = ATT_MFMA(ATT_PAF(0), ATT_VFR(vA), o[0]), C0, 0,  C0, 1,  C0, 2); \
    ATT_GAPB(ATT_VRD(vA, 5), o[1] = ATT_MFMA(ATT_PAF(0), ATT_VFR(vB), o[1]), C0, 3,  C0, 4,  C0, 5); \
    ATT_GAPB(ATT_VRD(vB, 2), o[0] = ATT_MFMA(ATT_PAF(1), ATT_VFR(vC), o[0]), C0, 6,  C0, 7,  C0, 8); \
    ATT_GAPB(ATT_VRD(vC, 6), o[1] = ATT_MFMA(ATT_PAF(1), ATT_VFR(vA), o[1]), C0, 9,  C0, 10, C0, 11); \
    ATT_GAPB(ATT_VRD(vA, 3), o[0] = ATT_MFMA(ATT_PAF(2), ATT_VFR(vB), o[0]), C0, 12, C0, 13, C0, 14); \
    ATT_GAPB(ATT_VRD(vB, 7), o[1] = ATT_MFMA(ATT_PAF(2), ATT_VFR(vC), o[1]), C0, 15, C1, 0,  C1, 1); \
    ATT_GAPB((void)0,        o[0] = ATT_MFMA(ATT_PAF(3), ATT_VFR(vA), o[0]), C1, 2,  C1, 3,  C1, 4); \
    ATT_GAPB((void)0,        o[1] = ATT_MFMA(ATT_PAF(3), ATT_VFR(vB), o[1]), C1, 5,  C1, 6,  C1, 7); \
    } while (0)
#define ATT_WAIT23() do { if (rl) { if (three) ATT_WAIT_BAR(7); else ATT_WAIT_BAR(6); } else { if (three) ATT_WAIT_BAR(3); else ATT_WAIT_BAR(2); } } while (0)
  int t = 1;
  for (; t + 3 < NT; t += 2) {
    ATT_STEP(pB0, pB1, pA0, pA1, t, true, true);      ATT_WAIT23(); ATT_RESC(); ATT_ROT();
    ATT_STEP(pA0, pA1, pB0, pB1, t + 1, true, true);  ATT_WAIT23(); ATT_RESC(); ATT_ROT();
  }
  ATT_STEP(pB0, pB1, pA0, pA1, t, true, true);        ATT_WAIT23();    ATT_RESC(); ATT_ROT();
  ATT_STEP(pA0, pA1, pB0, pB1, t + 1, false, true);   ATT_WAIT_BAR(1); ATT_RESC(); ATT_ROT();
  ATT_STEP(pB0, pB1, pA0, pA1, t + 2, false, false);  ATT_WAIT_BAR(0); ATT_RESC(); ATT_ROT();
  rider.end(lane, rw);
  if (has_nxt) { ATT_DMAK(nxt, 0, 0); ATT_DMAK(nxt, 1, 1); }
  { { const float nmh0 = -mhat;
#pragma unroll
      for (int r = 8; r < 16; ++r) pB1[r] = ATT_EX0(pB1[r]); }
    float sacc = pB0[0] + pB0[1];
#pragma unroll
    for (int r = 2; r < 16; ++r) sacc += pB0[r];
#pragma unroll
    for (int r = 0; r < 16; ++r) sacc += pB1[r];
    lsum += sacc;
    pw0 = (u32x4){ATT_PKW(pB0, 0), ATT_PKW(pB0, 2), ATT_PKW(pB0, 4), ATT_PKW(pB0, 6)}; pw1 = (u32x4){ATT_PKW(pB0, 8), ATT_PKW(pB0, 10), ATT_PKW(pB0, 12), ATT_PKW(pB0, 14)};
    pw2 = (u32x4){ATT_PKW(pB1, 0), ATT_PKW(pB1, 2), ATT_PKW(pB1, 4), ATT_PKW(pB1, 6)}; pw3 = (u32x4){ATT_PKW(pB1, 8), ATT_PKW(pB1, 10), ATT_PKW(pB1, 12), ATT_PKW(pB1, 14)};
    pv(o, (int)(lds0 + L_V) + ((lane >> 4) & 1) * 32 + (lane & 3) * 8 + (4 * hi + ((lane & 15) >> 2)) * 64 + sl_prev * VSLOT, ATT_PAF(0), ATT_PAF(1), ATT_PAF(2), ATT_PAF(3)); }
  { auto rr = __builtin_amdgcn_permlane32_swap(__float_as_uint(lsum), __float_as_uint(lsum), false, false); lsum = __uint_as_float(rr[0]) + __uint_as_float(rr[1]); }
  if (hi == 0) { wsf[32 + r32] = lsum; pol.lse_out(wid, r32, (mhat + __builtin_amdgcn_logf(lsum)) * LN2); }
  asm volatile("s_waitcnt lgkmcnt(0)" ::: "memory");
  float rli[16];
#pragma unroll
  for (int r = 0; r < 16; ++r) rli[r] = __builtin_amdgcn_rcpf(wsf[32 + crow(r, hi)]);
  { LAS bf16* stg = (LAS bf16*)(shm + L_OST) + wid * 2048;
#pragma unroll
    for (int r = 0; r < 16; ++r) { const int orow = crow(r, hi);
#pragma unroll
      for (int d0 = 0; d0 < 2; ++d0) stg[orow * 64 + d0 * 32 + r32] = (bf16)(cvtpk_s(o[d0][r] * rli[r], 0.f) & 0xffffu); }
    asm volatile("s_waitcnt lgkmcnt(0)" ::: "memory");
#pragma unroll
    for (int i = 0; i < 4; ++i) { const int row = i * 8 + (lane >> 3), ch = lane & 7; const u32x4 v = *(const LAS u32x4*)(stg + row * 64 + ch * 8); *(u32x4*)(pol.o_ptr(wid, row) + ch * 8) = v; } }
  asm volatile("s_waitcnt lgkmcnt(0)\n\ts_barrier" ::: "memory");
#undef ATT_DMAK
#undef ATT_DMAV
}
}

constexpr int NWAVES = 8, NTHREADS = NWAVES * 64;
constexpr int DM = 1024, NTOK = 65536, GTOK = 32768;
constexpr int NEXP = 16, CAP = 4096, FF = 2816;
constexpr int N_IN0 = 2048  , N_UP = 1792, K_UP = 384, N_DIL = 4608;
constexpr float LN_EPS = 1e-5f, RMS_EPS = 1e-6f, DN_ALPHA = 1.4142135623730951f;
constexpr int KSPLIT = 8;

constexpr size_t MiB = 1u << 20;
constexpr size_t WS_CTL = 0, CTL_ZERO_BYTES = 1 * MiB;
constexpr size_t WS_MODP = 1 * MiB;
constexpr size_t WS_MODF = 14 * MiB + 384 * 1024;
constexpr size_t WS_ROPE_R = 6 * MiB;
constexpr size_t WS_ROPE_H = 7 * MiB;
static_assert(13 * MiB + (size_t)N_UP * K_UP * 2 <= WS_MODF && WS_MODF + 4 * 12 * 3072 * 4 <= 15 * MiB, "adaLN table fits behind the up-projection weights");
constexpr size_t WS_WIN0 = 9 * MiB, WS_WUP = 13 * MiB, WS_WOUT0 = 15 * MiB, WS_WDIL = 17 * MiB, WS_WOUT1 = 26 * MiB;
constexpr size_t WS_AFF = 27 * MiB, WS_SLOTOF = 31 * MiB, WS_IDX = 35 * MiB, WS_GATEV = 35 * MiB + 512 * 1024;
constexpr size_t WS_W13 = 36 * MiB, WS_W2 = 212 * MiB, WS_H = 300 * MiB, WS_R = 428 * MiB;
constexpr size_t W13_L1OFF = 88 * MiB, W2_L1OFF = 44 * MiB;
constexpr size_t WS_PROJ = WS_R, WS_A2 = WS_R + 256 * MiB, WS_KPE = WS_R + 304 * MiB, WS_QKV2 = WS_R + 308 * MiB, WS_ATT = WS_R + 532 * MiB, WS_MIX = WS_R;
constexpr size_t WS_HH = WS_R, WS_YE = WS_R + 704 * MiB;
constexpr size_t WS_QKV = WS_R, WS_OG = WS_R + 576 * MiB, WS_LSE = WS_R + 768 * MiB, WS_MRG = WS_R + 774 * MiB;
constexpr size_t WS_END = WS_R + 960 * MiB;
constexpr int CW_BAR = 4096;

constexpr int RING_BYTES = 131072, LDSCTL_OFF = RING_BYTES, MISC_OFF = LDSCTL_OFF + 320, LDS_BYTES = 147456;

typedef unsigned short bf16;
typedef unsigned v4u __attribute__((ext_vector_type(4)));
typedef unsigned v2u __attribute__((ext_vector_type(2)));
typedef unsigned v2u __attribute__((ext_vector_type(2)));
typedef float f32x4 __attribute__((ext_vector_type(4)));
typedef GAS unsigned gu32;
#define RLX_AGENT __ATOMIC_RELAXED, __HIP_MEMORY_SCOPE_AGENT
#define LDS_WAIT() asm volatile("s_waitcnt lgkmcnt(0)" ::: "memory")
__device__ __forceinline__ unsigned f2bf(float f) { return att::cvtpk_s(f, 0.f) & 0xffffu; }
__device__ __forceinline__ unsigned pk2(float lo, float hi) { return att::cvtpk_s(lo, hi); }
__device__ __forceinline__ float bflo(unsigned w) { return __uint_as_float(w << 16); }
__device__ __forceinline__ float bfhi(unsigned w) { return __uint_as_float(w & 0xffff0000u); }

#define XB_TMO      128
#define XB_XCNT(j)  (256  + 64 * (j))
#define XB_XSUB(j)  (1280 + 64 * (j))
#define XB_XGEN(j)  (2304 + 64 * (j))
#define XB_TOP      3328
#define XB_TOPGEN   3392
#define XCD_BAR_WORDS 3456
#define XB_SPIN_CAP (1u << 18)
__device__ __forceinline__ unsigned xb_ld(unsigned* p)              { return __hip_atomic_load(p, __ATOMIC_RELAXED, __HIP_MEMORY_SCOPE_AGENT); }
__device__ __forceinline__ unsigned xb_add(unsigned* p, unsigned v) { return __hip_atomic_fetch_add(p, v, __ATOMIC_RELAXED, __HIP_MEMORY_SCOPE_AGENT); }
__device__ __forceinline__ unsigned xb_xcc_id() { return (unsigned)__builtin_amdgcn_s_getreg((3 << 11) | 20) & 0xFu; }
#define XB_SPIN(cond, bar) do { unsigned _sp = 0; while (cond) { __builtin_amdgcn_s_sleep(1); \
    if ((++_sp & 255u) == 0u) { if (xb_ld(&(bar)[XB_TMO])) break; if (_sp > XB_SPIN_CAP) { atomicAdd(&(bar)[XB_TMO], 1u); break; } } } } while (0)
struct XcdBarrier { unsigned* bar; unsigned x; volatile LAS unsigned* st; };
__device__ __forceinline__ XcdBarrier xcd_barrier_post(unsigned* bar, volatile LAS unsigned* st) {
    XcdBarrier b; b.bar = bar; b.x = xb_xcc_id(); b.st = st;
    if (threadIdx.x == 0) (void)xb_add(&bar[XB_XCNT(b.x)], 1u);
    return b;
}
__device__ __forceinline__ void xcd_barrier_complete(unsigned* bar, unsigned x, unsigned& nloc, unsigned& nx) {
    const unsigned G = gridDim.x * gridDim.y * gridDim.z;
    unsigned sum, cnt, mine, sp = 0u;
    for (;;) {
        sum = 0u; cnt = 0u; mine = 0u;
#pragma unroll
        for (unsigned j = 0; j < 16; ++j) { const unsigned c = xb_ld(&bar[XB_XCNT(j)]); sum += c; cnt += (c > 0u) ? 1u : 0u; mine = (j == x) ? c : mine; }
        if (sum == G) break;
        __builtin_amdgcn_s_sleep(1);
        if ((++sp & 255u) == 0u) { if (xb_ld(&bar[XB_TMO])) break; if (sp > XB_SPIN_CAP) { atomicAdd(&bar[XB_TMO], 1u); break; } }
    }
    nloc = mine > 0u ? mine : 1u; nx = cnt > 0u ? cnt : 1u;
}
__device__ __forceinline__ void xcd_barrier(const XcdBarrier& b, int wv) {
    asm volatile("s_waitcnt vmcnt(0)" ::: "memory");
    __syncthreads();
    if (opaque_tid(wv) == 0) {
        unsigned* bar = b.bar;
        __builtin_amdgcn_s_waitcnt(0);
        unsigned nloc = b.st[0], nx = b.st[1];
        if (nloc == 0u) { xcd_barrier_complete(bar, b.x, nloc, nx); b.st[0] = nloc; b.st[1] = nx; }
        const unsigned old = xb_add(&bar[XB_XSUB(b.x)], 1u);
        const unsigned gen = old / nloc;
        if (old + 1u == (gen + 1u) * nloc) {
            __builtin_amdgcn_fence(__ATOMIC_RELEASE, "agent");
            asm volatile("s_waitcnt vmcnt(0)" ::: "memory");
            const unsigned og = xb_add(&bar[XB_TOP], 1u);
            const unsigned tg = og / nx;
            if (og + 1u == (tg + 1u) * nx) xb_add(&bar[XB_TOPGEN], 1u);
            else XB_SPIN(xb_ld(&bar[XB_TOPGEN]) == tg, bar);
            __builtin_amdgcn_fence(__ATOMIC_ACQUIRE, "agent");
            xb_add(&bar[XB_XGEN(b.x)], 1u);
            asm volatile("s_waitcnt vmcnt(0)" ::: "memory");
        } else {
            XB_SPIN(xb_ld(&bar[XB_XGEN(b.x)]) == gen, bar);
            __builtin_amdgcn_fence(__ATOMIC_ACQUIRE, "agent");
            asm volatile("s_waitcnt vmcnt(0)" ::: "memory");
        }
    }
    __syncthreads();
}

struct Params {
    const float* in[25];
    float* out; unsigned char* ws;
    int ph_lo, ph_hi;
};
typedef const __attribute__((address_space(4))) Params* PP;
__device__ __forceinline__ PP params_ptr() { PP q = (PP)__builtin_amdgcn_kernarg_segment_ptr(); asm volatile("" : "+s"(q)); return q; }
__device__ __forceinline__ int tok_bidx(int t) { return t < GTOK ? (t >> 12) : 8 + ((t - GTOK) >> 13); }
__device__ __forceinline__ int tok_pos(int t) { return t < GTOK ? (t & 4095) : (t & 8191); }
__device__ __forceinline__ const float* x_in_row(PP p, int t) { return t < GTOK ? p->in[0] + (size_t)t * DM : p->in[1] + (size_t)(t - GTOK) * DM; }

template <int CTRL> __device__ __forceinline__ float dpp_f(float v) { return __int_as_float(__builtin_amdgcn_update_dpp(0, __float_as_int(v), CTRL, 0xf, 0xf, true)); }
template <int CTRL> __device__ __forceinline__ int dpp_i(int v) { return __builtin_amdgcn_update_dpp(0, v, CTRL, 0xf, 0xf, true); }
__device__ __forceinline__ float wave_sum(float v) {
    v += dpp_f<0xB1>(v); v += dpp_f<0x4E>(v); v += dpp_f<0x141>(v); v += dpp_f<0x140>(v);
    { auto rr = __builtin_amdgcn_permlane16_swap(__float_as_uint(v), __float_as_uint(v), false, false); v = __uint_as_float(rr[0]) + __uint_as_float(rr[1]); }
    { auto rr = __builtin_amdgcn_permlane32_swap(__float_as_uint(v), __float_as_uint(v), false, false); v = __uint_as_float(rr[0]) + __uint_as_float(rr[1]); }
    return v;
}
__device__ __forceinline__ int wave_sum_i(int v) {
    v += dpp_i<0xB1>(v); v += dpp_i<0x4E>(v); v += dpp_i<0x141>(v); v += dpp_i<0x140>(v);
    { auto rr = __builtin_amdgcn_permlane16_swap((unsigned)v, (unsigned)v, false, false); v = (int)(rr[0] + rr[1]); }
    { auto rr = __builtin_amdgcn_permlane32_swap((unsigned)v, (unsigned)v, false, false); v = (int)(rr[0] + rr[1]); }
    return v;
}

__device__ const float INV_R[16] = {1.0f, 0.562341332f, 0.316227764f, 0.177827939f, 0.100000001f, 0.0562341325f, 0.0316227749f, 0.0177827943f, 0.00999999978f, 0.00562341325f, 0.00316227763f, 0.00177827943f, 0.00100000005f, 0.000562341302f, 0.000316227757f, 0.00017782794f};
__device__ const float INV_H[32] = {1.0f, 0.749894202f, 0.562341332f, 0.421696514f, 0.316227764f, 0.237137377f, 0.177827939f, 0.133352146f, 0.100000001f, 0.0749894232f, 0.0562341325f, 0.0421696492f, 0.0316227749f, 0.0237137377f, 0.0177827943f, 0.013335214f, 0.00999999978f, 0.00749894232f, 0.00562341325f, 0.00421696482f, 0.00316227763f, 0.00237137382f, 0.00177827943f, 0.00133352145f, 0.00100000005f, 0.000749894185f, 0.000562341302f, 0.000421696517f, 0.000316227757f, 0.00023713737f, 0.00017782794f, 0.00013335215f};
__device__ __forceinline__ void cvt_item(const float* __restrict__ W, int ldw, int k0, int n0, bf16* WT, size_t ldk, size_t wt0, LAS float* scr, int lane, int rs = 1) {
#pragma unroll 8
    for (int i = 0; i < 32; ++i) { const int kk = 2 * i + (lane >> 5); scr[kk * 33 + (lane & 31)] = W[(size_t)(k0 + kk) * ldw + n0 + (lane & 31)]; }
    LDS_WAIT(); asm volatile("" ::: "memory");
    const int c = lane & 7;
#pragma unroll
    for (int j = 0; j < 4; ++j) { const int n = (lane >> 3) + 8 * j; const LAS float* s = scr + (8 * c) * 33 + n;
        v4u o; o.x = pk2(s[0 * 33], s[1 * 33]); o.y = pk2(s[2 * 33], s[3 * 33]); o.z = pk2(s[4 * 33], s[5 * 33]); o.w = pk2(s[6 * 33], s[7 * 33]);
        *(GAS v4u*)(WT + wt0 + (size_t)(n * rs) * ldk + 8 * c) = o; }
    LDS_WAIT(); asm volatile("" ::: "memory");
}
constexpr float W13_QS = 64.0f, W2_QS = 256.0f;
struct CvtTile { const float* W; int ldw, k0, n0; unsigned char* WT; size_t ldkb; size_t off0; float sc; bool f8; };
__device__ __forceinline__ void cvt_tile_load(const CvtTile& T, int lane, f32x4 (&w)[16]) {
    const float* src = T.W + (size_t)(T.k0 + 16 * (lane >> 4)) * T.ldw + T.n0 + 4 * (lane & 15);
#pragma unroll
    for (int i = 0; i < 16; ++i) w[i] = *(const GAS f32x4*)(src + (size_t)i * T.ldw);
}
template <bool F8> __device__ __forceinline__ void cvt_tile_store(const CvtTile& T, int lane, const f32x4 (&w)[16]) {
    const int q = lane >> 4, c = lane & 15;
#pragma unroll
    for (int j = 0; j < 4; ++j) { unsigned char* dst = T.WT + T.off0 + (size_t)(4 * c + j) * T.ldkb + (F8 ? 16 : 32) * q;
        if constexpr (F8) { v4u o; o.x = pg8::pk4_fp8(w[0][j] * T.sc, w[1][j] * T.sc, w[2][j] * T.sc, w[3][j] * T.sc); o.y = pg8::pk4_fp8(w[4][j] * T.sc, w[5][j] * T.sc, w[6][j] * T.sc, w[7][j] * T.sc);
            o.z = pg8::pk4_fp8(w[8][j] * T.sc, w[9][j] * T.sc, w[10][j] * T.sc, w[11][j] * T.sc); o.w = pg8::pk4_fp8(w[12][j] * T.sc, w[13][j] * T.sc, w[14][j] * T.sc, w[15][j] * T.sc); *(GAS v4u*)dst = o; }
        else { v4u o0, o1; o0.x = pk2(w[0][j], w[1][j]); o0.y = pk2(w[2][j], w[3][j]); o0.z = pk2(w[4][j], w[5][j]); o0.w = pk2(w[6][j], w[7][j]);
            o1.x = pk2(w[8][j], w[9][j]); o1.y = pk2(w[10][j], w[11][j]); o1.z = pk2(w[12][j], w[13][j]); o1.w = pk2(w[14][j], w[15][j]); *(GAS v4u*)dst = o0; *(GAS v4u*)(dst + 16) = o1; } }
}
__device__ __forceinline__ void cvt_tile_store_any(const CvtTile& T, int lane, const f32x4 (&w)[16]) { if (T.f8) cvt_tile_store<true>(T, lane, w); else cvt_tile_store<false>(T, lane, w); }
constexpr int MOE_TILES = NEXP * 2112;
__device__ __forceinline__ CvtTile moe_tile(PP p, int layer, int it, int ES) {
    CvtTile T; const int e = it / 2112, r = it % 2112, which = r / 704, q = r % 704;
    if (which < 2) { const int kb = q / 44, nb = q % 44; T.k0 = kb * 64; T.n0 = nb * 64; T.W = p->in[22 + which] + ((size_t)layer * NEXP + e) * (size_t)DM * FF; T.ldw = FF;
        const size_t row0 = (size_t)e * 5632 + (size_t)(T.n0 >> 7) * 256 + which * 128 + (T.n0 & 127);
        T.WT = p->ws + WS_W13 + (layer ? W13_L1OFF : 0); T.ldkb = (size_t)DM * ES; T.off0 = (row0 * DM + T.k0) * ES; T.sc = W13_QS; T.f8 = ES == 1;
    } else { const int kb = q / 16, nb = q % 16; T.k0 = kb * 64; T.n0 = nb * 64; T.W = p->in[24] + ((size_t)layer * NEXP + e) * (size_t)FF * DM; T.ldw = DM;
        T.WT = p->ws + WS_W2 + (layer ? W2_L1OFF : 0); T.ldkb = (size_t)FF; T.off0 = ((size_t)e * DM + T.n0) * FF + T.k0; T.sc = W2_QS; T.f8 = true; }
    return T;
}

__device__ __forceinline__ void p0_prologue(PP p, LAS unsigned char* lds, int vcu, int G, int tid, int lane, int wave) {
    LAS float* scr = (LAS float*)(lds + wave * 8448);
    LAS float* sc = (LAS float*)(lds + 69632);
    for (int i = tid; i < 12 * DM; i += NTHREADS) { const int b = i >> 10, k = i & 1023; const float c = b < 8 ? p->in[2][b * DM + k] : p->in[3][(b - 8) * DM + k];
        sc[i] = c / (1.0f + __expf(-c)); }
    __syncthreads();
    const int gw = vcu * NWAVES + wave, NGW = G * NWAVES;
    for (int it = gw; it < 4 * 48 * KSPLIT; it += NGW) {
        const int kc = it % KSPLIT, jb = (it / KSPLIT) % 48, mi = it / (KSPLIT * 48);
        const float* W = (mi & 1 ? p->in[17] : p->in[13]) + (size_t)(mi >> 1) * DM * 3072 + jb * 64 + lane;
        float acc[12];
#pragma unroll
        for (int b = 0; b < 12; ++b) acc[b] = 0.f;
        for (int k0 = kc * 128; k0 < kc * 128 + 128; k0 += 8) {
            float w[8];
#pragma unroll
            for (int i = 0; i < 8; ++i) w[i] = W[(size_t)(k0 + i) * 3072];
#pragma unroll
            for (int b = 0; b < 12; ++b) { const f32x4 s0 = *(const LAS f32x4*)(sc + b * DM + k0), s1 = *(const LAS f32x4*)(sc + b * DM + k0 + 4);
                acc[b] += w[0] * s0[0] + w[1] * s0[1] + w[2] * s0[2] + w[3] * s0[3] + w[4] * s1[0] + w[5] * s1[1] + w[6] * s1[2] + w[7] * s1[3]; }
        }
        float* o = (float*)(p->ws + WS_MODP) + ((size_t)(kc * 4 + mi) * 12) * 3072 + jb * 64 + lane;
#pragma unroll
        for (int b = 0; b < 12; ++b) o[(size_t)b * 3072] = acc[b];
    }
    for (int i = gw * 64 + lane; i < 8192 * 48; i += NGW * 64) {
        const int pos = i / 48, j = i % 48; const float inv = j < 16 ? INV_R[j] : INV_H[j - 16];
        const float ang = (float)pos * inv; double rev = (double)ang * 0.15915494309189535; rev -= floor(rev);
        const float rf = (float)rev; float2 cs; cs.x = __builtin_amdgcn_cosf(rf); cs.y = __builtin_amdgcn_sinf(rf);
        if (j < 16) ((float2*)(p->ws + WS_ROPE_R))[pos * 16 + j] = cs; else ((float2*)(p->ws + WS_ROPE_H))[pos * 32 + (j - 16)] = cs;
    }
    { const v4u z = {0u, 0u, 0u, 0u};
      for (int i = gw * 64 + lane; i < 12288 + 12288 + 32768; i += NGW * 64) {
        if (i < 12288) ((GAS v4u*)(p->ws + WS_WIN0 + (size_t)1952 * DM * 2))[i] = z;
        else if (i < 24576) { const int q = i - 12288, row = q >> 4, c = q & 15; *(GAS v4u*)(p->ws + WS_WUP + ((size_t)row * K_UP + 256) * 2 + c * 16) = z; }
        else { const int q = i - 24576, row = 768 + (q >> 5), c = q & 31; *(GAS v4u*)(p->ws + WS_WUP + (size_t)row * K_UP * 2 + c * 16) = z; } } }
    constexpr int I0 = 16 * 61, I1 = 4 * 24, I2 = 2 * 32, I3 = 16 * 32, I4 = 16 * 144, I5 = 8 * 32;
    for (int it = gw; it < I0 + I1 + I2 + I3 + I4 + I5; it += NGW) {
        int r = it;
        if (r < I0) { const int kb = r / 61, nb = r % 61; cvt_item(p->in[4], 1952, kb * 64, nb * 32, (bf16*)(p->ws + WS_WIN0), DM, (size_t)nb * 32 * DM + kb * 64, scr, lane); continue; } r -= I0;
        if (r < I1) { const int kb = r / 24, nb = r % 24; cvt_item(p->in[7], 768, kb * 64, nb * 32, (bf16*)(p->ws + WS_WUP), K_UP, (size_t)nb * 32 * K_UP + kb * 64, scr, lane); continue; } r -= I1;
        if (r < I2) { const int kb = r / 32, nb = r % 32; cvt_item(p->in[9], 1024, kb * 64, nb * 32, (bf16*)(p->ws + WS_WUP), K_UP, (size_t)(768 + nb * 32) * K_UP + 256 + kb * 64, scr, lane); continue; } r -= I2;
        if (r < I3) { const int kb = r / 32, nb = r % 32; cvt_item(p->in[10], 1024, kb * 64, nb * 32, (bf16*)(p->ws + WS_WOUT0), DM, (size_t)nb * 32 * DM + kb * 64, scr, lane); continue; } r -= I3;
        if (r < I4) { const int kb = r / 144, nb = r % 144, c0 = nb * 32;
            const bool qk = (c0 % 1536) < 1024; const int row0 = qk ? (c0 & ~63) + ((c0 >> 5) & 1) : c0;
            cvt_item(p->in[11], N_DIL, kb * 64, c0, (bf16*)(p->ws + WS_WDIL), DM, (size_t)row0 * DM + kb * 64, scr, lane, qk ? 2 : 1); continue; } r -= I4;
        { const int kb = r / 32, nb = r % 32; cvt_item(p->in[12], 1024, kb * 64, nb * 32, (bf16*)(p->ws + WS_WOUT1), 512, (size_t)nb * 32 * 512 + kb * 64, scr, lane); }
    }
}

__device__ __forceinline__ float mod_reduce(PP p, int mi, int b, int j) {
    float s = (mi & 1 ? p->in[18] : p->in[14])[(size_t)(mi >> 1) * 3072 + j];
    const float* mp = (const float*)(p->ws + WS_MODP) + ((size_t)mi * 12 + b) * 3072 + j;
#pragma unroll
    for (int kc = 0; kc < KSPLIT; ++kc) s += mp[(size_t)kc * 4 * 12 * 3072];
    return s;
}
template <bool FINAL> __device__ __forceinline__ void load_mod_vec(PP p, LAS float* dst, int mi, int b, int part, int tid) {
    if constexpr (FINAL) { const float* mf = (const float*)(p->ws + WS_MODF) + ((size_t)mi * 12 + b) * 3072 + part * DM; for (int j = tid; j < DM; j += NTHREADS) dst[j] = mf[j]; }
    else { for (int j = tid; j < DM; j += NTHREADS) dst[j] = mod_reduce(p, mi, b, part * DM + j); }
}
__device__ __forceinline__ void store_row_bf16(bf16* orow, const f32x4 (&v)[4], int lane) {
    GAS unsigned long long* o8 = (GAS unsigned long long*)orow + lane;
#pragma unroll
    for (int j = 0; j < 4; ++j) o8[64 * j] = (unsigned long long)pk2(v[j].x, v[j].y) | ((unsigned long long)pk2(v[j].z, v[j].w) << 32);
}

__device__ __forceinline__ void p1_modulate(PP p, LAS unsigned char* lds, int vcu, int G, int tid, int lane, int wave) {
    LAS float* vsh = (LAS float*)lds; LAS float* vsc = vsh + DM;
    for (int i = vcu * NTHREADS + tid; i < 4 * 12 * 3072; i += G * NTHREADS) ((float*)(p->ws + WS_MODF))[i] = mod_reduce(p, i / (12 * 3072), (i / 3072) % 12, i % 3072);
    for (int ch = vcu; ch < NTOK / 256; ch += G) {
        const int t0 = ch * 256, b = tok_bidx(t0);
        __syncthreads();
        load_mod_vec<false>(p, vsh, 0, b, 0, tid); load_mod_vec<false>(p, vsc, 0, b, 1, tid);
        __syncthreads();
        _Pragma("unroll 1") for (int i = 0; i < 32; ++i) { const int t = t0 + wave * 32 + i;
            const GAS f32x4* xr = (const GAS f32x4*)x_in_row(p, t) + lane; f32x4 v[4];
#pragma unroll
            for (int j = 0; j < 4; ++j) { const f32x4 x = xr[64 * j]; const f32x4 sh = *(const LAS f32x4*)(vsh + 4 * lane + 256 * j), sc = *(const LAS f32x4*)(vsc + 4 * lane + 256 * j); v[j] = x * (1.0f + sc) + sh; }
            store_row_bf16((bf16*)(p->ws + WS_H) + (size_t)t * DM, v, lane); }
    }
}

__device__ __forceinline__ void p3_mla_prep(PP p, int vcu, int G, int lane, int wave) {
    const int gw = vcu * NWAVES + wave, NGW = G * NWAVES;
    const bf16* proj = (const bf16*)(p->ws + WS_PROJ); bf16* a2 = (bf16*)(p->ws + WS_A2); bf16* kpe = (bf16*)(p->ws + WS_KPE);
    const f32x4 qn = *((const f32x4*)p->in[6] + lane); const float2 kn = *((const float2*)p->in[8] + lane);
    for (int t = gw; t < NTOK; t += NGW) {
        const bf16* row = proj + (size_t)t * N_IN0;
        const v2u ql = *(const v2u*)(row + 1536 + 4 * lane); const unsigned kl = *(const unsigned*)(row + 1792 + 2 * lane);
        const float q0 = bflo(ql.x), q1 = bfhi(ql.x), q2 = bflo(ql.y), q3 = bfhi(ql.y), k0 = bflo(kl), k1 = bfhi(kl);
        const float qs = wave_sum(q0 * q0 + q1 * q1 + q2 * q2 + q3 * q3), ks = wave_sum(k0 * k0 + k1 * k1);
        const float qr = 1.0f / sqrtf(qs * (1.0f / 256.0f) + RMS_EPS), kr = 1.0f / sqrtf(ks * (1.0f / 128.0f) + RMS_EPS);
        v2u qo; qo.x = pk2(q0 * qr * qn.x, q1 * qr * qn.y); qo.y = pk2(q2 * qr * qn.z, q3 * qr * qn.w);
        *(v2u*)(a2 + (size_t)t * K_UP + 4 * lane) = qo;
        *(unsigned*)(a2 + (size_t)t * K_UP + 256 + 2 * lane) = pk2(k0 * kr * kn.x, k1 * kr * kn.y);
        if (lane < 16) { const float x1 = bflo((unsigned)row[1920 + lane]), x2 = bflo((unsigned)row[1936 + lane]);
            const float2 cs = ((const float2*)(p->ws + WS_ROPE_R))[tok_pos(t) * 16 + lane];
            kpe[(size_t)t * 32 + lane] = (bf16)f2bf(x1 * cs.x - x2 * cs.y); kpe[(size_t)t * 32 + 16 + lane] = (bf16)f2bf(x1 * cs.y + x2 * cs.x); }
    }
}

__device__ __forceinline__ int moe1_split(int G) { return G >= 4 * NEXP ? MOE_TILES / 2 : MOE_TILES; }
__device__ __forceinline__ int moe1_split2(int G) { return G >= 4 * NEXP ? MOE_TILES - MOE_TILES / 4 : MOE_TILES; }
struct NoRider { static constexpr int NW = 1; __device__ __forceinline__ void begin(int, f32x4 (&)[1]) {} __device__ __forceinline__ int mid(int, int, int, f32x4 (&)[1]) { return 0; } __device__ __forceinline__ void end(int, f32x4 (&)[1]) {} };
template <bool F8> struct CvtRider {
    static constexpr int NW = 16;
    PP p; int layer, layer_b, ka, kb; CvtTile T; bool live;
    __device__ __forceinline__ void init(PP p_, int layer_, int ka_, int kb_, int layer_b_ = -1) { p = p_; layer = layer_; layer_b = layer_b_ < 0 ? layer_ : layer_b_; ka = ka_; kb = kb_; live = false; }
    __device__ __forceinline__ void begin(int lane, f32x4 (&w)[16]) { if (ka >= 0) { T = moe_tile(p, layer, ka, F8 ? 1 : 2); cvt_tile_load(T, lane, w); live = true; } }
    __device__ __forceinline__ int mid(int t, int NT, int lane, f32x4 (&w)[16]) { if (t == (NT >> 1) && kb >= 0) { int n = 16; if (live) { cvt_tile_store_any(T, lane, w); n += T.f8 ? 4 : 8; } T = moe_tile(p, layer_b, kb, F8 ? 1 : 2); cvt_tile_load(T, lane, w); live = true; return n; } return 0; }
    __device__ __forceinline__ void end(int lane, f32x4 (&w)[16]) { if (live) { cvt_tile_store_any(T, lane, w); live = false; } }
};
struct CvtStream {
    static constexpr int NW = 4;
    PP p; int ka, kb, nb; CvtTile T; bool live;
    __device__ __forceinline__ void init(PP p_, int ka_, int kb_) { p = p_; ka = ka_; kb = kb_; nb = 0; live = false; }
    __device__ __forceinline__ void begin(int, f32x4 (&)[4]) {}
    __device__ __forceinline__ void store(int lane, const f32x4 (&w)[4]) { const int r = lane >> 2, c4 = lane & 3, q4 = (nb - 1) & 3;
#pragma unroll
        for (int j = 0; j < 4; ++j) { unsigned char* dst = T.WT + T.off0 + (size_t)(16 * q4 + 4 * c4 + j) * T.ldkb;
            if (T.f8) *(GAS unsigned*)(dst + 4 * r) = pg8::pk4_fp8(w[0][j] * T.sc, w[1][j] * T.sc, w[2][j] * T.sc, w[3][j] * T.sc);
            else { v2u o; o.x = pk2(w[0][j], w[1][j]); o.y = pk2(w[2][j], w[3][j]); *(GAS v2u*)(dst + 8 * r) = o; } }
        live = false; }
    __device__ __forceinline__ bool pre(int s, int lane, f32x4 (&w)[4]) { if ((s & 3) != 0) return false; if (live) store(lane, w); return (nb < 4 ? ka : (nb < 8 ? kb : -1)) >= 0; }
    __device__ __forceinline__ void post(int lane, f32x4 (&w)[4]) { if ((nb & 3) == 0) T = moe_tile(p, 0, nb < 4 ? ka : kb, 1);
        const float* src = T.W + (size_t)(T.k0 + 4 * (lane >> 2)) * T.ldw + T.n0 + 16 * (nb & 3) + 4 * (lane & 3);
#pragma unroll
        for (int i = 0; i < 4; ++i) w[i] = *(const GAS f32x4*)(src + (size_t)i * T.ldw);
        ++nb; live = true; }
    __device__ __forceinline__ void end(int lane, f32x4 (&w)[4]) { if (live) store(lane, w); }
};
__device__ __forceinline__ void decode_unit(int r, int& S, int& tok0, int& h, int& within) {
    if (r < 1024) { const int bh = r >> 4; within = r & 15; S = 4096; tok0 = (bh >> 3) * 4096; h = bh & 7; }
    else { const int r2 = r - 1024, bh = r2 >> 5; within = r2 & 31; S = 8192; tok0 = GTOK + (bh >> 3) * 8192; h = bh & 7; }
}
__device__ __forceinline__ int clampi(int v, int lo, int hi) { return v < lo ? lo : (v > hi ? hi : v); }
using att::bf16x8; using att::f32x16;
__device__ __forceinline__ void rope8(bf16x8& a, bf16x8& b, const float2* cs) {
#pragma unroll
    for (int j = 0; j < 8; ++j) { const float x1 = att::bf2f(a[j]), x2 = att::bf2f(b[j]); const float2 c = cs[j];
        a[j] = (short)f2bf(x1 * c.x - x2 * c.y); b[j] = (short)f2bf(x1 * c.y + x2 * c.x); }
}

struct PolNA {
    static constexpr int NLSE = 0; static constexpr int ND0 = 4; static constexpr bool FUSED = false; static constexpr float SC = 1.0f;
    __device__ __forceinline__ void mask(f32x16&, f32x16&, int, int, int, int) const {}
    const att::bf16* proj; att::bf16* out; const LAS float* tab; int tok0, h, R4, rows, kr_lo, nt;
    __device__ __forceinline__ void init(int r, const unsigned char* ws, const LAS float* tab_all) {
        int S, within; decode_unit(r, S, tok0, h, within); R4 = within; rows = S >> 6;
        kr_lo = clampi(4 * R4 - 4, 0, rows - 8); nt = clampi(4 * R4 - 1, 0, rows - 8) + 8 - kr_lo;
        proj = (const att::bf16*)(ws + WS_PROJ); out = (att::bf16*)(ws + WS_ATT); tab = tab_all + h * 465; }
    __device__ __forceinline__ int ntiles() const { return nt; }
    __device__ __forceinline__ const att::bf16* q_ptr(int wid, int r32) const { return proj + (size_t)(tok0 + (4 * R4 + (wid >> 1)) * 64 + (wid & 1) * 32 + r32) * N_IN0 + h * 64; }
    __device__ __forceinline__ void q_fix(bf16x8 (&)[ND0], int, int, int) const {}
    __device__ __forceinline__ const void* k_src(int t, int wid, int lane) const { return proj + (size_t)(tok0 + (kr_lo + t) * 64 + lane) * N_IN0 + 512 + h * 64 + wid * 8; }
    __device__ __forceinline__ const void* k2_src(int, int, int) const { return nullptr; }
    __device__ __forceinline__ const void* v_src(int t, int wid, int lane) const { return proj + (size_t)(tok0 + (kr_lo + t) * 64 + 16 * (wid & 3) + (lane >> 2)) * N_IN0 + 1024 + h * 64 + (wid >> 2) * 32 + (lane & 3) * 8; }
    __device__ __forceinline__ bool needs(int t, int wid) const { const int r = 4 * R4 + (wid >> 1), r0 = clampi(r - 4, 0, rows - 8), kr = kr_lo + t; return kr >= r0 && kr < r0 + 8; }
    __device__ __forceinline__ bool variant(int wid) const { return (wid & 1) != 0; }
    static constexpr __device__ bool dead(int var, int half, int i) { return var == 0 ? (half == 1 && i >= 4) : (half == 0 && i < 12); }
    static constexpr __device__ int live4(int var) { return var == 0 ? 0 : 12; }
    static constexpr __device__ int kslo(int var) { return var == 0 ? 0 : 1; }
    static constexpr __device__ int kshi(int var) { return var == 0 ? 3 : 4; }
    template <int VAR> __device__ __forceinline__ void transform_v(f32x16& p0, f32x16& p1, int t, int wid, int r32, int hi) const {
        const int r = 4 * R4 + (wid >> 1), qc = (wid & 1) * 32 + r32, c0 = clampi(qc - 8, 0, 48);
        const LAS float* trow = tab + (kr_lo + t - r + 7) * 31 + (15 - qc);
        const LAS float* th = trow + 4 * hi; const unsigned u0 = (unsigned)(4 * hi - c0);
#pragma unroll
        for (int i = 0; i < 16; ++i) { const int kq = (i & 3) + 8 * (i >> 2);
            if (!dead(VAR, 0, i)) { const float b_ = th[kq]; const float f_ = __builtin_fmaf(p0[i], 0.125f * att::LOG2E, b_); p0[i] = (u0 + (unsigned)kq < 16u) ? f_ : -INFINITY; }
            if (!dead(VAR, 1, i)) { const float b_ = th[kq + 32]; const float f_ = __builtin_fmaf(p1[i], 0.125f * att::LOG2E, b_); p1[i] = (u0 + (unsigned)(kq + 32) < 16u) ? f_ : -INFINITY; } }
    }
    __device__ __forceinline__ att::bf16* o_ptr(int wid, int row) const { return out + (size_t)(tok0 + (4 * R4 + (wid >> 1)) * 64 + (wid & 1) * 32 + row) * DM + h * 64; }
    __device__ __forceinline__ void lse_out(int, int, float) const {}
};
struct PolMLA {
    static constexpr int NLSE = 0; static constexpr int ND0 = 6; static constexpr bool FUSED = true; static constexpr float SC = 0.10206207261596577f * att::LOG2E;
    __device__ __forceinline__ void mask(f32x16&, f32x16&, int, int, int, int) const {}
    const att::bf16* qkv2; const att::bf16* kpe; att::bf16* out; const float2* rope; int tok0, h, qt, S;
    __device__ __forceinline__ void init(int r, const unsigned char* ws) { int within; decode_unit(r, S, tok0, h, within); qt = within;
        qkv2 = (const att::bf16*)(ws + WS_QKV2); kpe = (const att::bf16*)(ws + WS_KPE); out = (att::bf16*)(ws + WS_ATT); rope = (const float2*)(ws + WS_ROPE_R); }
    __device__ __forceinline__ int ntiles() const { return S >> 6; }
    __device__ __forceinline__ const att::bf16* q_ptr(int wid, int r32) const { return qkv2 + (size_t)(tok0 + qt * 256 + wid * 32 + r32) * N_UP + h * 96; }
    __device__ __forceinline__ void q_fix(bf16x8 (&qr)[ND0], int wid, int r32, int hi) const { rope8(qr[4], qr[5], rope + (size_t)(qt * 256 + wid * 32 + r32) * 16 + 8 * hi); }
    __device__ __forceinline__ const void* k_src(int t, int wid, int lane) const { return qkv2 + (size_t)(tok0 + t * 64 + lane) * N_UP + 768 + h * 128 + wid * 8; }
    static constexpr int KSTRIDE = 64 * N_UP * 2, K2STRIDE = 64 * 32 * 2;
    __device__ __forceinline__ const unsigned char* k_base() const { return (const unsigned char*)(qkv2 + (size_t)tok0 * N_UP + 768 + h * 128); }
    __device__ __forceinline__ const unsigned char* k2_base() const { return (const unsigned char*)(kpe + (size_t)tok0 * 32); }
    static __device__ __forceinline__ unsigned k_lofs(int wid, int lane) { return (unsigned)(lane * N_UP + wid * 8) * 2u; }
    static __device__ __forceinline__ unsigned k2_lofs(int wid, int lane) { return (unsigned)(lane * 32 + wid * 8) * 2u; }
    static __device__ __forceinline__ unsigned v_lofs(int wid, int lane) { return (unsigned)((16 * (wid & 3) + (lane >> 2)) * N_UP + 64 + (wid >> 2) * 32 + (lane & 3) * 8) * 2u; }
    __device__ __forceinline__ const void* k2_src(int t, int wid, int lane) const { return kpe + (size_t)(tok0 + t * 64 + lane) * 32 + wid * 8; }
    __device__ __forceinline__ const void* v_src(int t, int wid, int lane) const { return qkv2 + (size_t)(tok0 + t * 64 + 16 * (wid & 3) + (lane >> 2)) * N_UP + 768 + h * 128 + 64 + (wid >> 2) * 32 + (lane & 3) * 8; }
    __device__ __forceinline__ bool needs(int, int) const { return true; }
    __device__ __forceinline__ void transform(f32x16&, f32x16&, int, int, int, int) const {}
    __device__ __forceinline__ att::bf16* o_ptr(int wid, int row) const { return out + (size_t)(tok0 + qt * 256 + wid * 32 + row) * DM + 512 + h * 64; }
    __device__ __forceinline__ void lse_out(int, int, float) const {}
};
struct PolDil {
    static constexpr int NLSE = 1;   static constexpr int ND0 = 4; static constexpr bool FUSED = true; static constexpr float SC = 0.125f * att::LOG2E;
    const att::bf16* qkv; att::bf16* og; float* lse; const float2* rope; int gi, d, tok0, h, rho, blk, ks, t_lo, nt, rbase;
    __device__ __forceinline__ void init(int r, int gi_, const unsigned char* ws) { int S, within; decode_unit(r, S, tok0, h, within); gi = gi_; d = 1 << (2 * gi);
        const int Ssub = S / d, nblk = Ssub >> 8; rho = within / nblk; blk = within % nblk; ks = 256 * blk - 64; t_lo = ks < 0 ? 1 : 0; rbase = tok0 + rho * Ssub;
        int t_hi = (Ssub - ks) >> 6; if (t_hi > 6) t_hi = 6; nt = t_hi - t_lo;
        qkv = (const att::bf16*)(ws + WS_QKV); og = (att::bf16*)(ws + WS_OG) + (size_t)gi * NTOK * 512; lse = (float*)(ws + WS_LSE) + (size_t)gi * NTOK * 8; rope = (const float2*)(ws + WS_ROPE_H); }
    __device__ __forceinline__ int ntiles() const { return nt; }
    __device__ __forceinline__ int qtok(int wid, int row) const { return tok0 + (256 * blk + 32 * wid + row) * d + rho; }
    __device__ __forceinline__ const att::bf16* q_ptr(int wid, int r32) const { return qkv + (size_t)(rbase + 256 * blk + 32 * wid + r32) * N_DIL + gi * 1536 + h * 64; }
    __device__ __forceinline__ void q_fix(bf16x8 (&)[ND0], int, int, int) const {}
    __device__ __forceinline__ const void* k_src(int t, int wid, int lane) const { return qkv + (size_t)(rbase + ks + 64 * (t + t_lo) + lane) * N_DIL + gi * 1536 + 512 + h * 64 + wid * 8; }
    __device__ __forceinline__ const void* k2_src(int, int, int) const { return nullptr; }
    __device__ __forceinline__ const void* v_src(int t, int wid, int lane) const { return qkv + (size_t)(rbase + ks + 64 * (t + t_lo) + 16 * (wid & 3) + (lane >> 2)) * N_DIL + gi * 1536 + 1024 + h * 64 + (wid >> 2) * 32 + (lane & 3) * 8; }
    __device__ __forceinline__ bool needs(int t, int wid) const { const int kt0 = ks + 64 * (t + t_lo), q0 = 256 * blk + 32 * wid; return kt0 + 63 >= q0 - 64 && kt0 <= q0 + 95; }
    __device__ __forceinline__ void transform(f32x16&, f32x16&, int, int, int, int) const {}
    __device__ __forceinline__ void mask(f32x16& p0, f32x16& p1, int t, int wid, int r32, int hi) const {
        const int rel0 = ks + 64 * (t + t_lo) - (256 * blk + 32 * wid);
        if (rel0 == 0 || rel0 == -32) return;
        const unsigned base = (unsigned)(rel0 - r32 + 64 + 4 * hi);
#pragma unroll
        for (int i = 0; i < 16; ++i) { const unsigned c = (unsigned)((i & 3) + 8 * (i >> 2));
            p0[i] = (base + c <= 128u) ? p0[i] : -INFINITY; p1[i] = (base + c + 32u <= 128u) ? p1[i] : -INFINITY; }
    }
    __device__ __forceinline__ att::bf16* o_ptr(int wid, int row) const { return og + (size_t)qtok(wid, row) * 512 + h * 64; }
    __device__ __forceinline__ void lse_out(int wid, int r32, float v) const { lse[(size_t)qtok(wid, r32) * 8 + h] = v; }
};


constexpr int DS_SLOT = 32768, DS_KB = 16384, DS_OST = 3 * DS_SLOT;
static_assert(DS_OST + 8 * 4096 <= RING_BYTES, "dilated attention LDS");
__device__ __forceinline__ void dil_unit_init(PolDil& P_, int n, int NU, int vcu, int G, const unsigned char* ws) {
    const bool ok = n >= 0 && n < NU; const int u = ok ? vcu + n * G : vcu;
    P_.init(u & 2047, u >> 11, ws); if (!ok) P_.nt = 0;
}
__device__ __forceinline__ void dil_skew(int wv, PP p, LAS unsigned char* shm, int vcu, int G) {
    using namespace att;
    const unsigned char* ws = p->ws;
    const int tid = opaque_tid(wv), lane = tid & 63, r32 = lane & 31, hi = lane >> 5; const int wid = __builtin_amdgcn_readfirstlane(tid >> 6);
    const int j = wid >> 1;
    const unsigned lds0 = (unsigned)(uintptr_t)shm;
    LAS float* wsf = (LAS float*)(shm + DS_OST + wid * 4096);
    int NU = 0; for (int u = vcu; u < 3 * 2048; u += G) ++NU;
    PolDil pPrev, pCur, pNext; dil_unit_init(pPrev, -1, NU, vcu, G, ws); dil_unit_init(pCur, 0, NU, vcu, G, ws); dil_unit_init(pNext, 1, NU, vcu, G, ws);
#define DS_DMA(PL, i, sl) do { int t_ = (i) - (PL).t_lo; const int tm_ = (PL).nt > 0 ? (PL).nt - 1 : 0; t_ = t_ < 0 ? 0 : (t_ > tm_ ? tm_ : t_); \
      const unsigned b_ = (unsigned)__builtin_amdgcn_readfirstlane(lds0 + (sl) * DS_SLOT + ((i) >= 3 ? DS_KB : 0) + wid * 1024); \
      glds16((PL).k_src(t_, wid, lane), b_); glds16((PL).v_src(t_, wid, lane), b_ + 8192u); } while (0)
    bf16x8 qr[4], qn[4];
    { const bf16* qp = pCur.q_ptr(wid, r32);
#pragma unroll
      for (int d0 = 0; d0 < 4; ++d0) qr[d0] = *reinterpret_cast<const bf16x8*>(qp + d0 * 16 + hi * 8); }
#pragma unroll
    for (int d0 = 0; d0 < 4; ++d0) qn[d0] = qr[d0];
    DS_DMA(pCur, 0, 0); DS_DMA(pPrev, 3, 0); DS_DMA(pCur, 1, 1); DS_DMA(pPrev, 4, 1);
    float m = -1e30f, lsum = 0.f; f32x16 o[2]; o[0] = f32x16{}; o[1] = f32x16{};
    const int vlane = ((lane >> 4) & 1) * 32 + (lane & 3) * 8 + (4 * hi + ((lane & 15) >> 2)) * 64;
    ATT_WAIT_BAR(4);
    int s_cur = 0, x_prev = 0;
#define DS_STEP(r) do { \
    { const int sl2 = s_cur >= 1 ? s_cur - 1 : 2; \
      if ((r) == 0) { DS_DMA(pCur, 2, sl2); DS_DMA(pPrev, 5, sl2); } else if ((r) == 1) { DS_DMA(pNext, 0, sl2); DS_DMA(pCur, 3, sl2); } else { DS_DMA(pNext, 1, sl2); DS_DMA(pCur, 4, sl2); } } \
    const bool inA = j <= (r); const PolDil own = inA ? pCur : pPrev; const int i = inA ? (r) : 3 + (r); const int k = i - j; int x_cur = 0; \
    const bool live = own.nt > 0; \
    if (live && k == 0) { m = -1e30f; lsum = 0.f; o[0] = f32x16{}; o[1] = f32x16{}; \
      const PolDil suc = inA ? pNext : pCur; \
      if (suc.nt > 0) { const bf16* qp = suc.q_ptr(wid, r32); \
        _Pragma("unroll") for (int d0 = 0; d0 < 4; ++d0) qn[d0] = *reinterpret_cast<const bf16x8*>(qp + d0 * 16 + hi * 8); \
        x_cur = 4; } } \
    if (live && i >= own.t_lo && i < own.t_lo + own.nt) { \
      const LAS unsigned char* kt = shm + s_cur * DS_SLOT + (inA ? 0 : DS_KB); \
      f32x16 p0 = f32x16{}, p1 = f32x16{}; \
      qkt<4>(p0, p1, kt, qr, r32, hi); \
      { const int rel0 = own.ks + 64 * i - (256 * own.blk + 32 * wid);        \
        if (!(rel0 == 0 || rel0 == -32)) { const unsigned base = (unsigned)(rel0 - r32 + 64 + 4 * hi); \
          _Pragma("unroll") for (int ii = 0; ii < 16; ++ii) { const unsigned c = (unsigned)((ii & 3) + 8 * (ii >> 2)); \
            p0[ii] = (base + c <= 128u) ? p0[ii] : -INFINITY; p1[ii] = (base + c + 32u <= 128u) ? p1[ii] : -INFINITY; } } } \
      const float rm = rowmax(p0, p1) * PolDil::SC; \
      const bool grow = rm > m + THR; \
      if (__any(grow)) { const float mn = grow ? rm : m; const float f = __builtin_amdgcn_exp2f(m - mn); m = mn; lsum *= f; \
        if (hi == 0) wsf[r32] = f; \
        asm volatile("s_waitcnt lgkmcnt(0)" ::: "memory"); \
        _Pragma("unroll") for (int rr = 0; rr < 16; ++rr) { const float ff = wsf[crow(rr, hi)]; o[0][rr] *= ff; o[1][rr] *= ff; } } \
      float sacc = 0.f; \
      _Pragma("unroll") for (int rr = 0; rr < 16; ++rr) { p0[rr] = __builtin_amdgcn_exp2f(__builtin_fmaf(p0[rr], PolDil::SC, -m)); p1[rr] = __builtin_amdgcn_exp2f(__builtin_fmaf(p1[rr], PolDil::SC, -m)); sacc += p0[rr]; sacc += p1[rr]; } \
      lsum += sacc; \
      u32x4 pw0, pw1, pw2, pw3; \
      pw0 = (u32x4){cvtpk_s(p0[0], p0[1]), cvtpk_s(p0[2], p0[3]), cvtpk_s(p0[4], p0[5]), cvtpk_s(p0[6], p0[7])}; \
      pw1 = (u32x4){cvtpk_s(p0[8], p0[9]), cvtpk_s(p0[10], p0[11]), cvtpk_s(p0[12], p0[13]), cvtpk_s(p0[14], p0[15])}; \
      pw2 = (u32x4){cvtpk_s(p1[0], p1[1]), cvtpk_s(p1[2], p1[3]), cvtpk_s(p1[4], p1[5]), cvtpk_s(p1[6], p1[7])}; \
      pw3 = (u32x4){cvtpk_s(p1[8], p1[9]), cvtpk_s(p1[10], p1[11]), cvtpk_s(p1[12], p1[13]), cvtpk_s(p1[14], p1[15])}; \
      ATT_SBAR(); \
      pv(o, (int)lds0 + s_cur * DS_SLOT + (inA ? 0 : DS_KB) + 8192 + vlane, __builtin_bit_cast(bf16x8, pw0), __builtin_bit_cast(bf16x8, pw1), __builtin_bit_cast(bf16x8, pw2), __builtin_bit_cast(bf16x8, pw3)); } \
    if (live && k == 2) {                                             \
      float ls = lsum; { auto rr = __builtin_amdgcn_permlane32_swap(__float_as_uint(ls), __float_as_uint(ls), false, false); ls = __uint_as_float(rr[0]) + __uint_as_float(rr[1]); } \
      if (hi == 0) { wsf[32 + r32] = ls; own.lse_out(wid, r32, (m + __builtin_amdgcn_logf(ls)) * LN2); } \
      asm volatile("s_waitcnt lgkmcnt(0)" ::: "memory"); \
      float rli[16]; \
      _Pragma("unroll") for (int rr = 0; rr < 16; ++rr) rli[rr] = __builtin_amdgcn_rcpf(wsf[32 + crow(rr, hi)]); \
      asm volatile("s_waitcnt lgkmcnt(0)" ::: "memory"); \
      LAS bf16* stg = (LAS bf16*)(shm + DS_OST) + wid * 2048; \
      _Pragma("unroll") for (int rr = 0; rr < 16; ++rr) { const int orow = crow(rr, hi); \
        _Pragma("unroll") for (int d0 = 0; d0 < 2; ++d0) stg[orow * 64 + d0 * 32 + r32] = (bf16)(cvtpk_s(o[d0][rr] * rli[rr], 0.f) & 0xffffu); } \
      asm volatile("s_waitcnt lgkmcnt(0)" ::: "memory"); \
      _Pragma("unroll") for (int q4 = 0; q4 < 4; ++q4) { const int row = q4 * 8 + (lane >> 3), ch = lane & 7; const u32x4 v = *(const LAS u32x4*)(stg + row * 64 + ch * 8); *(u32x4*)(own.o_ptr(wid, row) + ch * 8) = v; } \
      x_cur = 5; \
      asm volatile("" : "+v"(qn[0]), "+v"(qn[1]), "+v"(qn[2]), "+v"(qn[3]));        \
      _Pragma("unroll") for (int d0 = 0; d0 < 4; ++d0) qr[d0] = qn[d0]; } \
    { const int xs = x_prev + x_cur;                                  \
      if (xs == 4) ATT_WAIT_BAR(8); else if (xs == 5) ATT_WAIT_BAR(9); else if (xs == 9) ATT_WAIT_BAR(13); else ATT_WAIT_BAR(4); }        \
    x_prev = x_cur; s_cur = (s_cur == 2) ? 0 : s_cur + 1; \
    } while (0)
#pragma unroll 1
    for (int a = 0; a <= NU; ++a) {
        DS_STEP(0); DS_STEP(1); DS_STEP(2);
        pPrev = pCur; pCur = pNext; dil_unit_init(pNext, a + 2, NU, vcu, G, ws);
    }
    ATT_WAIT_BAR(0);
#undef DS_STEP
#undef DS_DMA
}

__device__ __forceinline__ void pc_post_mixer(PP p, int layer, LAS unsigned char* lds, int vcu, int G, int tid, int lane, int wave) {
    constexpr int PST = 1028;
    LAS float* vec = (LAS float*)lds; LAS float* panel = (LAS float*)(lds + 20480); LAS float* part = panel + 16 * PST;
    static_assert(20480 + 16 * PST * 4 + 8 * 16 * 16 * 4 <= 131072, "post-mixer LDS map");
    const float* wrg = p->in[21] + (size_t)layer * DM * NEXP;
    float wreg[8][4];
#pragma unroll
    for (int s_ = 0; s_ < 8; ++s_)
#pragma unroll
        for (int jj = 0; jj < 4; ++jj) wreg[s_][jj] = wrg[(size_t)(128 * wave + 16 * s_ + 4 * (lane >> 4) + jj) * NEXP + (lane & 15)];
    __syncthreads();
    for (int i = tid; i < DM; i += NTHREADS) { vec[3 * DM + i] = p->in[15][layer * DM + i]; vec[4 * DM + i] = p->in[16][layer * DM + i]; }
    const bf16* mix = (const bf16*)(p->ws + WS_MIX);
    for (int ch = vcu; ch < NTOK / 256; ch += G) {
        const int t0 = ch * 256, b = tok_bidx(t0), tw = t0 + wave * 32;
        __syncthreads();
        load_mod_vec<true>(p, vec, 2 * layer, b, 2, tid); load_mod_vec<true>(p, vec + DM, 2 * layer + 1, b, 0, tid); load_mod_vec<true>(p, vec + 2 * DM, 2 * layer + 1, b, 1, tid);
        __syncthreads();
#define PC_LOAD(X, M, r_) do { const int t_ = tw + (r_); const GAS f32x4* xr_ = (const GAS f32x4*)(layer == 0 ? x_in_row(p, t_) : p->out + (size_t)t_ * DM) + lane; const GAS v2u* mr_ = (const GAS v2u*)(mix + (size_t)t_ * DM) + lane; \
            _Pragma("unroll") for (int j_ = 0; j_ < 4; ++j_) { X[j_] = xr_[64 * j_]; M[j_] = mr_[64 * j_]; } } while (0)
#define PC_PART1(X, M, r_, slot_) do { const int t = tw + (r_); \
            LAS float* vec_ = vec; asm volatile("" : "+v"(vec_));     \
            f32x4 v[4]; float s = 0.f; \
            _Pragma("unroll") for (int j = 0; j < 4; ++j) { const f32x4 x = X[j]; const v2u m2 = M[j]; const f32x4 gt = *(const LAS f32x4*)(vec_ + 4 * lane + 256 * j); \
                const f32x4 o = {bflo(m2.x), bfhi(m2.x), bflo(m2.y), bfhi(m2.y)}; v[j] = x * DN_ALPHA + gt * o; s += (v[j].x + v[j].y) + (v[j].z + v[j].w); } \
            if ((r_) + 2 < 32) PC_LOAD(X, M, (r_) + 2); \
            const float mean = wave_sum(s) * (1.f / DM); float s2 = 0.f; \
            _Pragma("unroll") for (int j = 0; j < 4; ++j) { v[j] = v[j] - mean; s2 += (v[j].x * v[j].x + v[j].y * v[j].y) + (v[j].z * v[j].z + v[j].w * v[j].w); } \
            const float rstd = 1.f / sqrtf(wave_sum(s2) * (1.f / DM) + LN_EPS); \
            GAS f32x4* orow = (GAS f32x4*)(p->out + (size_t)t * DM) + lane; \
            _Pragma("unroll") for (int j = 0; j < 4; ++j) { const int c = 4 * lane + 256 * j; \
                const f32x4 g = *(const LAS f32x4*)(vec_ + 3 * DM + c), bb = *(const LAS f32x4*)(vec_ + 4 * DM + c), sh = *(const LAS f32x4*)(vec_ + DM + c), sc = *(const LAS f32x4*)(vec_ + 2 * DM + c); \
                const f32x4 x1 = v[j] * rstd * g + bb; orow[64 * j] = x1; const f32x4 hh = x1 * (1.0f + sc) + sh; v[j] = hh; \
                *(LAS f32x4*)(panel + (slot_) * PST + c) = hh; } \
            { GAS unsigned* o4 = (GAS unsigned*)(p->ws + WS_H + (size_t)t * DM) + lane;        \
                _Pragma("unroll") for (int j = 0; j < 4; ++j) o4[64 * j] = pg8::pk4_fp8(v[j].x, v[j].y, v[j].z, v[j].w); } \
            } while (0)
#define PC_PART2(r_, slot_) do { const int t = tw + (r_); const int e_ = lane & 15, pg_ = lane >> 4; \
            float lg = part[((pg_) * 16 + (slot_)) * 16 + e_] + part[((pg_ + 4) * 16 + (slot_)) * 16 + e_]; \
            { auto rr = __builtin_amdgcn_permlane16_swap(__float_as_uint(lg), __float_as_uint(lg), false, false); lg = __uint_as_float(rr[0]) + __uint_as_float(rr[1]); } \
            { auto rr = __builtin_amdgcn_permlane32_swap(__float_as_uint(lg), __float_as_uint(lg), false, false); lg = __uint_as_float(rr[0]) + __uint_as_float(rr[1]); } \
            float mx = lg; mx = fmaxf(mx, dpp_f<0xB1>(mx)); mx = fmaxf(mx, dpp_f<0x4E>(mx)); mx = fmaxf(mx, dpp_f<0x141>(mx)); mx = fmaxf(mx, dpp_f<0x140>(mx)); \
            const float ex = __expf(lg - mx); float den = ex; den += dpp_f<0xB1>(den); den += dpp_f<0x4E>(den); den += dpp_f<0x141>(den); den += dpp_f<0x140>(den); \
            float af_ = ex / den; af_ = (af_ >= 0.f && af_ <= 1.f) ? af_ : 0.f;        \
            if (lane < NEXP) ((float*)(p->ws + WS_AFF))[((size_t)(t >> 15) * NEXP + lane) * GTOK + (t & (GTOK - 1))] = af_; } while (0)
        f32x4 xa[4], xb[4]; v2u ma[4], mb[4];
        PC_LOAD(xa, ma, 0); PC_LOAD(xb, mb, 1);
        _Pragma("unroll 1") for (int i = 0; i < 32; i += 2) {
            PC_PART1(xa, ma, i, 2 * wave); PC_PART1(xb, mb, i + 1, 2 * wave + 1);
            asm volatile("s_waitcnt lgkmcnt(0)\n\ts_barrier" ::: "memory");
            { pg8::f32x4 D = {0.f, 0.f, 0.f, 0.f}; const LAS float* brow = panel + (lane & 15) * PST + 128 * wave + 4 * (lane >> 4);
#pragma unroll
              for (int s_ = 0; s_ < 8; ++s_) { const f32x4 hv = *(const LAS f32x4*)(brow + 16 * s_);
                  D = __builtin_amdgcn_mfma_f32_16x16x4f32(wreg[s_][0], hv.x, D, 0, 0, 0); D = __builtin_amdgcn_mfma_f32_16x16x4f32(wreg[s_][1], hv.y, D, 0, 0, 0);
                  D = __builtin_amdgcn_mfma_f32_16x16x4f32(wreg[s_][2], hv.z, D, 0, 0, 0); D = __builtin_amdgcn_mfma_f32_16x16x4f32(wreg[s_][3], hv.w, D, 0, 0, 0); }
              *(LAS f32x4*)(part + ((wave * 16 + (lane & 15)) * 16 + 4 * (lane >> 4))) = (f32x4){D[0], D[1], D[2], D[3]}; }
            asm volatile("s_waitcnt lgkmcnt(0)\n\ts_barrier" ::: "memory");
            PC_PART2(i, 2 * wave); PC_PART2(i + 1, 2 * wave + 1);
        }
#undef PC_LOAD
#undef PC_PART1
#undef PC_PART2
    }
}

__device__ __forceinline__ void topk_phase(PP p, LAS unsigned char* lds, int tid, int lane, int wave) {
    LAS int* red = (LAS int*)lds;
    for (int prob = blockIdx.x; prob < 2 * NEXP; prob += gridDim.x) {
        const float* a = (const float*)(p->ws + WS_AFF) + (size_t)prob * GTOK + tid * 64;
        unsigned v[64];
#pragma unroll
        for (int i = 0; i < 16; ++i) { const v4u x = ((const GAS v4u*)a)[i]; v[4 * i] = x.x; v[4 * i + 1] = x.y; v[4 * i + 2] = x.z; v[4 * i + 3] = x.w; }
        unsigned prefix = 0u;
        __syncthreads();
#pragma unroll 1
        for (int bit = 30; bit >= 0; --bit) {
            const unsigned cand = prefix | (1u << bit); int c = 0;
#pragma unroll
            for (int i = 0; i < 64; ++i) c += (int)((cand - 1u - v[i]) >> 31);
            c = wave_sum_i(c);
            if (lane == 0) red[(bit & 1) * 8 + wave] = c;
            __syncthreads();
            int tot = 0;
#pragma unroll
            for (int w = 0; w < 8; ++w) tot += red[(bit & 1) * 8 + w];
            if (tot >= CAP) prefix = cand;
        }
        const unsigned T = prefix;
        unsigned cg = 0u, ce = 0u;
#pragma unroll
        for (int i = 0; i < 64; ++i) { cg += (v[i] > T) ? 1u : 0u; ce += (v[i] == T) ? 1u : 0u; if ((i & 7) == 7) __builtin_amdgcn_sched_barrier(0); }
        const unsigned pack = cg | (ce << 16); unsigned x = pack;
#pragma unroll
        for (int o = 1; o < 64; o <<= 1) { const unsigned y = (unsigned)__builtin_amdgcn_ds_bpermute(((lane - o) & 63) << 2, (int)x); if (lane >= o) x += y; }
        if (lane == 63) red[32 + wave] = (int)x;
        __syncthreads();
        unsigned off = 0u, tot = 0u;
#pragma unroll
        for (int w = 0; w < 8; ++w) { const unsigned tw = (unsigned)red[32 + w]; tot += tw; off += (w < wave) ? tw : 0u; }
        const unsigned excl = x - pack + off;
        unsigned gt_before = excl & 0xffffu, eq_before = excl >> 16; const unsigned need_eq = (unsigned)CAP - (tot & 0xffffu);
        int* idx = (int*)(p->ws + WS_IDX) + (size_t)prob * CAP; float* gv = (float*)(p->ws + WS_GATEV) + (size_t)prob * CAP;
        int so[64];
#pragma unroll
        for (int i = 0; i < 64; ++i) {
            const bool isg = v[i] > T, ise = v[i] == T; const bool sel = isg || (ise && eq_before < need_eq);
            const unsigned slot = gt_before + (eq_before < need_eq ? eq_before : need_eq);
            if (sel) { idx[slot] = (prob >> 4) * GTOK + tid * 64 + i; gv[slot] = __uint_as_float(v[i]); }
            so[i] = sel ? (int)slot : -1; gt_before += isg ? 1u : 0u; eq_before += ise ? 1u : 0u; if ((i & 7) == 7) __builtin_amdgcn_sched_barrier(0); }
        GAS v4u* sp = (GAS v4u*)((int*)(p->ws + WS_SLOTOF) + (size_t)prob * GTOK + tid * 64);
#pragma unroll
        for (int i = 0; i < 16; ++i) { v4u w; w.x = (unsigned)so[4 * i]; w.y = (unsigned)so[4 * i + 1]; w.z = (unsigned)so[4 * i + 2]; w.w = (unsigned)so[4 * i + 3]; sp[i] = w; }
        __syncthreads();
    }
}

__device__ __forceinline__ void pd_post_moe(PP p, int layer, LAS unsigned char* lds, int vcu, int G, int tid, int lane, int wave) {
    LAS float* vec = (LAS float*)lds;
    LAS int* st_slot = (LAS int*)(lds + 32768) + wave * 1024;
    LAS float* st_gate = (LAS float*)(st_slot + 512);
    __syncthreads();
    for (int i = tid; i < DM; i += NTHREADS) { vec[DM + i] = p->in[19][layer * DM + i]; vec[2 * DM + i] = p->in[20][layer * DM + i]; }
    const bf16* ye = (const bf16*)(p->ws + WS_YE);
    for (int ch = vcu; ch < NTOK / 256; ch += G) {
        const int t0 = ch * 256, b = tok_bidx(t0), g = t0 >> 15, tw = t0 + wave * 32;
        __syncthreads();
        load_mod_vec<true>(p, vec, 2 * layer + 1, b, 2, tid);
        if (layer == 0) { load_mod_vec<true>(p, vec + 3 * DM, 2, b, 0, tid); load_mod_vec<true>(p, vec + 4 * DM, 2, b, 1, tid); }
        { const int sub = lane >> 4, e = lane & 15;
          const int* so = (const int*)(p->ws + WS_SLOTOF) + ((size_t)g * NEXP + e) * GTOK + (tw & (GTOK - 1)); const float* gvp = (const float*)(p->ws + WS_GATEV) + ((size_t)g * NEXP + e) * CAP;
          int s8[8]; float g8[8];
#pragma unroll
          for (int j = 0; j < 8; ++j) s8[j] = so[4 * j + sub];
#pragma unroll
          for (int j = 0; j < 8; ++j) g8[j] = gvp[s8[j] < 0 ? 0 : s8[j]];
#pragma unroll
          for (int j = 0; j < 8; ++j) { const float gg = s8[j] >= 0 ? g8[j] : 0.f; st_slot[(4 * j + sub) * 16 + e] = s8[j]; st_gate[(4 * j + sub) * 16 + e] = gg; } }
        __syncthreads();
        const bf16* yeg = ye + (size_t)g * NEXP * CAP * DM;
#define PD_STAGE(S_, i_) do { const int t_ = tw + (i_); int sl_ = -1; float gv_ = 0.f; if (lane < NEXP) { sl_ = st_slot[(i_) * 16 + lane]; gv_ = st_gate[(i_) * 16 + lane]; } \
            unsigned mk_ = (unsigned)__ballot(sl_ >= 0); \
            _Pragma("unroll") for (int k_ = 0; k_ < 4; ++k_) { const bf16* rp_ = yeg; float g_ = 0.f; \
                if (mk_) { const int e_ = __builtin_ctz(mk_); mk_ &= mk_ - 1u; const int s_ = __builtin_amdgcn_readlane(sl_, e_); g_ = __int_as_float(__builtin_amdgcn_readlane(__float_as_int(gv_), e_)); rp_ = yeg + ((size_t)e_ * CAP + s_) * DM; } \
                g##S_[k_] = g_; const GAS v2u* yr_ = (const GAS v2u*)rp_ + lane; _Pragma("unroll") for (int j_ = 0; j_ < 4; ++j_) y##S_[k_][j_] = yr_[64 * j_]; } \
            slot##S_ = sl_; gval##S_ = gv_; rest##S_ = mk_; \
            const GAS f32x4* xr_ = (const GAS f32x4*)(p->out + (size_t)t_ * DM) + lane; _Pragma("unroll") for (int j_ = 0; j_ < 4; ++j_) x##S_[j_] = xr_[64 * j_]; } while (0)
#define PD_ROW(S_, i_) do { const int t = tw + (i_); \
            LAS float* vec_ = vec; asm volatile("" : "+v"(vec_)); \
            f32x4 y[4]; \
            _Pragma("unroll") for (int j = 0; j < 4; ++j) { y[j] = (f32x4){0.f, 0.f, 0.f, 0.f}; \
                _Pragma("unroll") for (int k = 0; k < 4; ++k) { const v2u w = y##S_[k][j]; y[j] += (f32x4){bflo(w.x), bfhi(w.x), bflo(w.y), bfhi(w.y)} * g##S_[k]; } } \
            { unsigned rest = rest##S_; while (rest) { const int e = __builtin_ctz(rest); rest &= rest - 1u;            \
                const int sl = __builtin_amdgcn_readlane(slot##S_, e); const float gv = __int_as_float(__builtin_amdgcn_readlane(__float_as_int(gval##S_), e)); \
                const GAS v2u* yr = (const GAS v2u*)(yeg + ((size_t)e * CAP + sl) * DM) + lane; \
                _Pragma("unroll") for (int j = 0; j < 4; ++j) { const v2u w = yr[64 * j]; y[j] += (f32x4){bflo(w.x), bfhi(w.x), bflo(w.y), bfhi(w.y)} * gv; } } } \
            GAS f32x4* xr = (GAS f32x4*)(p->out + (size_t)t * DM) + lane; \
            f32x4 v[4]; float s = 0.f; \
            _Pragma("unroll") for (int j = 0; j < 4; ++j) { const f32x4 gt = *(const LAS f32x4*)(vec_ + 4 * lane + 256 * j); v[j] = x##S_[j] * DN_ALPHA + gt * y[j]; s += (v[j].x + v[j].y) + (v[j].z + v[j].w); } \
            if ((i_) + 2 < 32) PD_STAGE(S_, (i_) + 2); \
            const float mean = wave_sum(s) * (1.f / DM); float s2 = 0.f; \
            _Pragma("unroll") for (int j = 0; j < 4; ++j) { v[j] = v[j] - mean; s2 += (v[j].x * v[j].x + v[j].y * v[j].y) + (v[j].z * v[j].z + v[j].w * v[j].w); } \
            const float rstd = 1.f / sqrtf(wave_sum(s2) * (1.f / DM) + LN_EPS); \
            _Pragma("unroll") for (int j = 0; j < 4; ++j) { const int c = 4 * lane + 256 * j; const f32x4 gg = *(const LAS f32x4*)(vec_ + DM + c), bb = *(const LAS f32x4*)(vec_ + 2 * DM + c); \
                const f32x4 x2 = v[j] * rstd * gg + bb; xr[64 * j] = x2; \
                if (layer == 0) { const f32x4 sh = *(const LAS f32x4*)(vec_ + 3 * DM + c), sc = *(const LAS f32x4*)(vec_ + 4 * DM + c); v[j] = x2 * (1.0f + sc) + sh; } } \
            if (layer == 0) store_row_bf16((bf16*)(p->ws + WS_H) + (size_t)t * DM, v, lane); } while (0)
        f32x4 xA[4], xB[4]; v2u yA[4][4], yB[4][4]; float gA[4], gB[4]; int slotA = -1, slotB = -1; float gvalA = 0.f, gvalB = 0.f; unsigned restA = 0u, restB = 0u;
        PD_STAGE(A, 0); PD_STAGE(B, 1);
        _Pragma("unroll 1") for (int i = 0; i < 32; i += 2) { PD_ROW(A, i); PD_ROW(B, i + 1); }
#undef PD_STAGE
#undef PD_ROW
    }
}

__device__ __forceinline__ void merge_phase(PP p, int vcu, int G, int lane, int wave) {
    const int gw = vcu * NWAVES + wave, NGW = G * NWAVES;
    const bf16* og = (const bf16*)(p->ws + WS_OG); const float* lse = (const float*)(p->ws + WS_LSE); bf16* mrg = (bf16*)(p->ws + WS_MRG);
    for (int t = gw; t < NTOK; t += NGW) {
        const int h = lane >> 3;
        const float l0 = lse[(size_t)t * 8 + h], l1 = lse[(size_t)NTOK * 8 + (size_t)t * 8 + h], l2 = lse[(size_t)2 * NTOK * 8 + (size_t)t * 8 + h];
        const float mx = fmaxf(l0, fmaxf(l1, l2)); float w0 = __expf(l0 - mx), w1 = __expf(l1 - mx), w2 = __expf(l2 - mx); const float inv = 1.0f / (w0 + w1 + w2); w0 *= inv; w1 *= inv; w2 *= inv;
        const v4u a = *((const GAS v4u*)(og + (size_t)t * 512) + lane), b = *((const GAS v4u*)(og + (size_t)NTOK * 512 + (size_t)t * 512) + lane), c = *((const GAS v4u*)(og + (size_t)2 * NTOK * 512 + (size_t)t * 512) + lane);
        v4u o;
#define MRG1(f) o.f = pk2(w0 * bflo(a.f) + w1 * bflo(b.f) + w2 * bflo(c.f), w0 * bfhi(a.f) + w1 * bfhi(b.f) + w2 * bfhi(c.f))
        MRG1(x); MRG1(y); MRG1(z); MRG1(w);
#undef MRG1
        *((GAS v4u*)(mrg + (size_t)t * 512) + lane) = o;
    }
}

__global__ void __launch_bounds__(NTHREADS, 2) fwd_kernel(Params p_unused) {
    extern __shared__ __attribute__((aligned(16))) unsigned char lds_raw[];
    LAS unsigned char* lds = (LAS unsigned char*)lds_raw;
    const int G = gridDim.x; const int bx = blockIdx.x; const int vcu = (G % 8 == 0) ? (bx % 8) * (G / 8) + bx / 8 : bx;
    int wv = __builtin_amdgcn_readfirstlane((int)threadIdx.x >> 6); asm volatile("" : "+s"(wv));
    { const int tid = opaque_tid(wv); for (int u = tid; u < (LDS_BYTES - LDSCTL_OFF) / 4; u += NTHREADS) ((LAS unsigned*)(lds + LDSCTL_OFF))[u] = 0u; }
    __syncthreads();
    XcdBarrier bar = xcd_barrier_post((unsigned*)(params_ptr()->ws + WS_CTL) + CW_BAR, (volatile LAS unsigned*)(lds + MISC_OFF) + 8);
    int ph = 0;
#ifdef TM_MASK
    unsigned long long tm_prev = __builtin_amdgcn_s_memrealtime(), tm_acc = 0ull;
#define TSTAMP(cls) do { const unsigned long long _n = __builtin_amdgcn_s_memrealtime(); if ((TM_MASK >> (cls)) & 1u) tm_acc += _n - tm_prev; tm_prev = _n; } while (0)
#else
#define TSTAMP(cls) do { } while (0)
#endif
#define SEAM() do { ++ph; if (ph >= params_ptr()->ph_hi) return; if (ph > params_ptr()->ph_lo) xcd_barrier(bar, wv); } while (0)
#define RUN (ph >= params_ptr()->ph_lo)
#define TL() const PP p = params_ptr(); unsigned char* ws = p->ws; (void)ws; const int tid = opaque_tid(wv), lane = tid & 63, wave = wv; (void)lane; (void)wave

    if (RUN) { TL(); p0_prologue(p, lds, vcu, G, tid, lane, wave); } SEAM(); TSTAMP(0);
    if (RUN) { TL(); p1_modulate(p, lds, vcu, G, tid, lane, wave); } SEAM(); TSTAMP(1);

    for (int layer = 0; layer < 2; ++layer) {
        if (layer == 0) {
            if (RUN) { const PP p = params_ptr(); unsigned char* ws = p->ws; pg8::Gemm g{(const bf16*)(ws + WS_H), (const bf16*)(ws + WS_WIN0), NTOK, N_IN0, DM}; pg8::StaticOrder S; S.init(NTOK, N_IN0, G, bx, 0);
              pg8::EpiBf16 E{(bf16*)(ws + WS_PROJ), N_IN0}; pg8::gemm_phase(wv, lds, g, S, E); } SEAM(); TSTAMP(2);
            if (RUN) { TL(); p3_mla_prep(p, vcu, G, lane, wave); } SEAM(); TSTAMP(3);
            if (RUN) { const PP p = params_ptr(); unsigned char* ws = p->ws; pg8::Gemm g{(const bf16*)(ws + WS_A2), (const bf16*)(ws + WS_WUP), NTOK, N_UP, K_UP}; pg8::StaticOrder S; S.init(NTOK, N_UP, G, bx, 0);
              pg8::EpiBf16 E{(bf16*)(ws + WS_QKV2), N_UP}; pg8::gemm_phase(wv, lds, g, S, E); } SEAM(); TSTAMP(4);
            if (RUN) { TL(); LAS float* tab = (LAS float*)(lds + att::L_TAB);
              __syncthreads();
              for (int i = tid; i < 8 * 465; i += NTHREADS) tab[i] = p->in[5][i] * att::LOG2E;
              __syncthreads();
              const int nk = (MOE_TILES - vcu + G - 1) / G; int nmla = 0; for (int r = vcu; r < 2048; r += G) ++nmla;
              { PolNA cur, nx; bool pre = false; int u = 0;
                for (int r = vcu; r < 2048; r += G, ++u) { if (u == 0) cur.init(r, ws, tab); const bool hn = r + G < 2048; if (hn) nx.init(r + G, ws, tab);
                  CvtRider<true> rd; const int k = nmla * 16 + u * 8 + wv, k1 = u * 8 + wv;
                  rd.init(p, 0, k < nk ? k * G + vcu : -1, k1 * G + vcu < moe1_split(G) ? k1 * G + vcu : -1, 1); att::attn_unit(wv, cur, lds, rd, nx, hn, pre); pre = hn; cur = nx; } } TSTAMP(5);
              { PolMLA cur, nx; bool pre = false; int u = 0;
                for (int r = vcu; r < 2048; r += G, ++u) { if (u == 0) cur.init(r, ws); const bool hn = r + G < 2048; if (hn) nx.init(r + G, ws);
                  CvtStream rd; const int k = (u * 8 + wv) * 2; rd.init(p, k < nk ? k * G + vcu : -1, k + 1 < nk ? (k + 1) * G + vcu : -1); att::attn_unit_pipe(wv, cur, lds, rd, nx, hn, pre); pre = hn; cur = nx; } }
              { const int lane2 = opaque_tid(wv) & 63;
                for (int k = nmla * 16 + nmla * 8 + wv; k < nk; k += 8) { const CvtTile T = moe_tile(p, 0, k * G + vcu, 1); f32x4 w[16]; cvt_tile_load(T, lane2, w); cvt_tile_store_any(T, lane2, w); } } } SEAM(); TSTAMP(6);
            if (RUN) { const PP p = params_ptr(); unsigned char* ws = p->ws; pg8::Gemm g{(const bf16*)(ws + WS_ATT), (const bf16*)(ws + WS_WOUT0), NTOK, DM, DM}; pg8::StaticOrder S; S.init(NTOK, DM, G, bx, 0);
              pg8::EpiBf16 E{(bf16*)(ws + WS_MIX), DM}; pg8::gemm_phase(wv, lds, g, S, E); } SEAM(); TSTAMP(7);
        } else {
            if (RUN) { const PP p = params_ptr(); unsigned char* ws = p->ws; pg8::Gemm g{(const bf16*)(ws + WS_H), (const bf16*)(ws + WS_WDIL), NTOK, N_DIL, DM}; pg8::StaticOrder S; S.init(NTOK, N_DIL, G, bx, 0);
              pg8::EpiBf16Dil E{(bf16*)(ws + WS_QKV), N_DIL, (const float2*)(ws + WS_ROPE_H)}; pg8::gemm_phase(wv, lds, g, S, E); } SEAM(); TSTAMP(14);
            if (RUN) { const PP p = params_ptr(); unsigned char* ws = p->ws; __syncthreads();
              const int nk = (moe1_split(G) - vcu + G - 1) / G; int nna = 0; for (int r = vcu; r < 2048; r += G) ++nna; const int it = nna;
              dil_skew(wv, p, lds, vcu, G);
              { const int lane = opaque_tid(wv) & 63; for (int k = it * 8 + wv; k < nk; k += 8) { const CvtTile T = moe_tile(p, 1, k * G + vcu, 1); f32x4 w[16]; cvt_tile_load(T, lane, w); cvt_tile_store<true>(T, lane, w); } } } SEAM(); TSTAMP(16);
            if (RUN) { TL(); merge_phase(p, vcu, G, lane, wave); } SEAM(); TSTAMP(17);
            if (RUN) { const PP p = params_ptr(); unsigned char* ws = p->ws; pg8::Gemm g{(const bf16*)(ws + WS_MRG), (const bf16*)(ws + WS_WOUT1), NTOK, DM, 512}; pg8::StaticOrder S; S.init(NTOK, DM, G, bx, 0);
              pg8::EpiBf16 E{(bf16*)(ws + WS_MIX), DM}; pg8::gemm_phase(wv, lds, g, S, E); } SEAM(); TSTAMP(18);
        }
        if (RUN) { TL(); if (layer == 0) pc_post_mixer(p, 0, lds, vcu, G, tid, lane, wave); else pc_post_mixer(p, 1, lds, vcu, G, tid, lane, wave); } SEAM(); TSTAMP(8);
        if (RUN) { TL(); topk_phase(p, lds, tid, lane, wave);
          if (bx >= 2 * NEXP) {
            const int it_end = layer == 0 ? moe1_split2(G) : MOE_TILES;
            for (int it = (layer == 0 ? moe1_split(G) : moe1_split2(G)) + (bx - 2 * NEXP) * 8 + wave; it < it_end; it += (G - 2 * NEXP) * 8) { const CvtTile T = moe_tile(p, 1, it, 1); f32x4 w[16]; cvt_tile_load(T, lane, w); cvt_tile_store<true>(T, lane, w); } } } SEAM(); TSTAMP(9);
        { constexpr int MR = 2 * NEXP * CAP;
            if (RUN) { const PP p = params_ptr(); unsigned char* ws = p->ws; pg8::StaticOrder S; S.init(MR, 2 * FF, G, bx, 1); const int* ix = (const int*)(ws + WS_IDX);
              { pg8::Gemm g{(const bf16*)(ws + WS_H), (const bf16*)(ws + WS_W13 + (layer ? W13_L1OFF : 0)), MR, 2 * FF, DM};
                  pg8::EpiSwiGluF8 E{ws + WS_HH, FF, 1.0f / W13_QS}; pg8::gemm_phase<pg8::EpiSwiGluF8, pg8::StaticOrder, true, true>(wv, lds, g, S, E, ix); } } SEAM(); TSTAMP(11);
            if (RUN) { const PP p = params_ptr(); unsigned char* ws = p->ws; pg8::Gemm g{(const bf16*)(ws + WS_HH), (const bf16*)(ws + WS_W2 + (layer ? W2_L1OFF : 0)), MR, DM, FF}; pg8::StaticOrder S; S.init(MR, DM, G, bx, 1);
              { pg8::EpiBf16S E{(bf16*)(ws + WS_YE), DM, 1.0f / W2_QS}; pg8::gemm_phase<pg8::EpiBf16S, pg8::StaticOrder, false, true>(wv, lds, g, S, E); } } SEAM(); TSTAMP(12);
        }
        if (RUN) { TL(); pd_post_moe(p, layer, lds, vcu, G, tid, lane, wave);
        }
        if (layer == 0) SEAM();
        TSTAMP(13);
    }
#ifdef TM_MASK
    if (blockIdx.x == 0) { const unsigned long long t0 = __builtin_amdgcn_s_memrealtime(); while (__builtin_amdgcn_s_memrealtime() - t0 < TM_AMP * tm_acc) __builtin_amdgcn_s_sleep(8); }
#endif
#undef TL
#undef SEAM
}


extern "C" void kernel_launch(void* const* d_in, const int* in_sizes, int n_in, void* d_out, int out_size, void* d_ws, size_t ws_size, hipStream_t stream) {
    static int grid = 0;
    if (grid == 0) {
        if (n_in != 25 || out_size != NTOK * DM || ws_size < WS_END) { fprintf(stderr, "kernel_launch: unexpected shapes (n_in %d, out %d, ws %zu, need %zu); nothing launched\n", n_in, out_size, ws_size, (size_t)WS_END); grid = -1; return; }
        int dev = 0, cus = 0, per_cu = 0;
        if (hipGetDevice(&dev) != hipSuccess || hipDeviceGetAttribute(&cus, hipDeviceAttributeMultiprocessorCount, dev) != hipSuccess) { grid = -1; return; }
        if (hipFuncSetAttribute((const void*)fwd_kernel, hipFuncAttributeMaxDynamicSharedMemorySize, LDS_BYTES) != hipSuccess) { fprintf(stderr, "kernel_launch: hipFuncSetAttribute failed\n"); grid = -1; return; }
        if (hipOccupancyMaxActiveBlocksPerMultiprocessor(&per_cu, (const void*)fwd_kernel, NTHREADS, LDS_BYTES) != hipSuccess || per_cu < 1) fprintf(stderr, "kernel_launch: occupancy query reports %d\n", per_cu);
        (void)hipGetLastError();
        grid = cus;
    }
    if (grid < 0) return;
    if (hipMemsetAsync((char*)d_ws + WS_CTL, 0, CTL_ZERO_BYTES, stream) != hipSuccess) return;
    Params p{};
    for (int i = 0; i < 25; ++i) p.in[i] = (const float*)d_in[i];
    p.out = (float*)d_out; p.ws = (unsigned char*)d_ws;
#ifndef PH_HI
#define PH_HI 1000
#endif
    p.ph_lo = 0; p.ph_hi = PH_HI;
    hipLaunchKernelGGL(fwd_kernel, dim3(grid), dim3(NTHREADS), LDS_BYTES, stream, p);
    const hipError_t le = hipPeekAtLastError();
    if (le != hipSuccess) fprintf(stderr, "kernel_launch: launch failed: %s\n", hipGetErrorName(le));
}
```

```cpp
#include <hip/hip_runtime.h>
#include <hip/hip_bf16.h>
#include <cstdio>
#include <cstdint>
#include <cmath>

#define LAS __attribute__((address_space(3)))
#define GAS __attribute__((address_space(1)))
__device__ __forceinline__ int opaque_tid(int wv) { unsigned z = 0u; asm volatile("" : "+v"(z)); return wv * 64 + (int)__builtin_amdgcn_mbcnt_hi(~0u, __builtin_amdgcn_mbcnt_lo(~0u, z)); }

namespace pg8 {
typedef unsigned short bf16_t;
typedef short bf16x8 __attribute__((ext_vector_type(8)));
typedef float f32x4 __attribute__((ext_vector_type(4)));
typedef unsigned u32x4 __attribute__((ext_vector_type(4)));
typedef int i32x4 __attribute__((ext_vector_type(4)));
typedef int i32x8 __attribute__((ext_vector_type(8)));
typedef unsigned u32x2 __attribute__((ext_vector_type(2)));
constexpr int BM = 256, BK = 64, HALF = 128, HTB = HALF * BK * 2, STAGE_BYTES = 8 * HTB, NXCD = 8, WGM = 8;

__host__ __device__ __forceinline__ int lds_byte(int r, int c) { const int st = (r >> 4) * 2 + (c >> 5), rr = r & 15, cc = c & 31, ob = rr * 64 + cc * 2; return st * 1024 + (ob ^ (((ob >> 9) & 1) << 5)); }
__host__ __device__ __forceinline__ void stage_rc(int b, int& R, int& C) { const int st = b / 1024, sb = b % 1024, swz = sb ^ (((sb >> 9) & 1) << 5); R = (st >> 1) * 16 + swz / 64; C = (st & 1) * 32 + (swz % 64) / 2; }
__host__ __device__ __forceinline__ int perm32(int rho) { const int n = rho >> 4, i = rho & 15; return 8 * (i >> 2) + 4 * n + (i & 3); }

struct Unit { int pm, pn, pb; };
struct Gemm { const bf16_t* A; const bf16_t* Bt; int M, N, K; };

struct StaticOrder {
    int nM, nN, nwg, G, c, ne;
    __device__ void init(int M, int N, int G_, int c_, int ne_) { nM = M / BM; nN = N / BM; nwg = nM * nN; G = G_; c = c_; ne = ne_; }
    __device__ bool next(int i, Unit& u) const {
        const long L = (long)i * G + c; if (L >= nwg) return false;
        int wgid = (int)L; { const int q = nwg / NXCD, r = nwg % NXCD, xcd = wgid % NXCD, off = wgid / NXCD; wgid = (xcd < r ? xcd * (q + 1) : r * (q + 1) + (xcd - r) * q) + off; }
        const int nig = WGM * nN, gid = wgid / nig, fm = gid * WGM, gsz = (nM - fm) < WGM ? (nM - fm) : WGM;
        u.pm = fm + ((wgid % nig) % gsz); u.pn = (wgid % nig) / gsz; u.pb = ne ? ((u.pm >> 4) & 15) * nN + u.pn : u.pn; return true;
    }
};

__device__ __forceinline__ unsigned cvt_pk_bf16(float lo, float hi) { unsigned r; asm volatile("v_cvt_pk_bf16_f32 %0, %1, %2" : "=v"(r) : "v"(lo), "v"(hi)); return r; }

struct EpiBf16 {
    static constexpr bool PERM = true;
    bf16_t* O; int ldc;
    __device__ __forceinline__ void operator()(const f32x4 (&acc)[2][2][4][2], const Unit& u, int wr, int wc, int fr, int fq) const {
        const int row0 = u.pm * BM + wr * 64 + fr; const int col0 = u.pn * BM + wc * 32 + 8 * fq;
#pragma unroll
        for (int ai = 0; ai < 2; ++ai)
#pragma unroll
            for (int m = 0; m < 4; ++m) { bf16_t* rowp = O + (size_t)(row0 + ai * HALF + m * 16) * ldc + col0;
#pragma unroll
                for (int bj = 0; bj < 2; ++bj) { const f32x4 v0 = acc[ai][bj][m][0], v1 = acc[ai][bj][m][1];
                    u32x4 w; w.x = cvt_pk_bf16(v0[0], v0[1]); w.y = cvt_pk_bf16(v0[2], v0[3]); w.z = cvt_pk_bf16(v1[0], v1[1]); w.w = cvt_pk_bf16(v1[2], v1[3]);
                    *(u32x4*)(rowp + bj * HALF) = w; } }
    }
};
__device__ __forceinline__ unsigned pk4_fp8(float a, float b, float c, float d) { int w = __builtin_amdgcn_cvt_pk_fp8_f32(a, b, 0, false); w = __builtin_amdgcn_cvt_pk_fp8_f32(c, d, w, true); return (unsigned)w; }
struct EpiBf16S {
    static constexpr bool PERM = true;
    bf16_t* O; int ldc; float sc;
    __device__ __forceinline__ void operator()(const f32x4 (&acc)[2][2][4][2], const Unit& u, int wr, int wc, int fr, int fq) const {
        const int row0 = u.pm * BM + wr * 64 + fr; const int col0 = u.pn * BM + wc * 32 + 8 * fq;
#pragma unroll
        for (int ai = 0; ai < 2; ++ai)
#pragma unroll
            for (int m = 0; m < 4; ++m) { bf16_t* rowp = O + (size_t)(row0 + ai * HALF + m * 16) * ldc + col0;
#pragma unroll
                for (int bj = 0; bj < 2; ++bj) { const f32x4 v0 = acc[ai][bj][m][0] * sc, v1 = acc[ai][bj][m][1] * sc;
                    u32x4 w; w.x = cvt_pk_bf16(v0[0], v0[1]); w.y = cvt_pk_bf16(v0[2], v0[3]); w.z = cvt_pk_bf16(v1[0], v1[1]); w.w = cvt_pk_bf16(v1[2], v1[3]);
                    *(u32x4*)(rowp + bj * HALF) = w; } }
    }
};
struct EpiF8S {
    static constexpr bool PERM = true;
    unsigned char* O; int ldc; float sc;
    __device__ __forceinline__ void operator()(const f32x4 (&acc)[2][2][4][2], const Unit& u, int wr, int wc, int fr, int fq) const {
        const int row0 = u.pm * BM + wr * 64 + fr; const int col0 = u.pn * BM + wc * 32 + 8 * fq;
#pragma unroll
        for (int ai = 0; ai < 2; ++ai)
#pragma unroll
            for (int m = 0; m < 4; ++m) { unsigned char* rowp = O + (size_t)(row0 + ai * HALF + m * 16) * ldc + col0;
#pragma unroll
                for (int bj = 0; bj < 2; ++bj) { const f32x4 v0 = acc[ai][bj][m][0] * sc, v1 = acc[ai][bj][m][1] * sc;
                    u32x2 w; w.x = pk4_fp8(v0[0], v0[1], v0[2], v0[3]); w.y = pk4_fp8(v1[0], v1[1], v1[2], v1[3]);
                    *(u32x2*)(rowp + bj * HALF) = w; } }
    }
};
__device__ __forceinline__ int dil_row(int t, int gi) { const int lg = t < 32768 ? 12 : 13, S1 = (1 << lg) - 1, pos = t & S1, d2 = 2 * gi; return (t & ~S1) + ((pos & ((1 << d2) - 1)) << (lg - d2)) + (pos >> d2); }
struct EpiBf16Dil {
    static constexpr bool PERM = true;
    bf16_t* O; int ldc; const float2* rope;
    __device__ __forceinline__ void operator()(const f32x4 (&acc)[2][2][4][2], const Unit& u, int wr, int wc, int fr, int fq) const {
        const int row0 = u.pm * BM + wr * 64 + fr; const int col0 = u.pn * BM + wc * 32 + 8 * fq; const int gi = u.pn / 6; const bool qk = (u.pn % 6) < 4;
#pragma unroll
        for (int ai = 0; ai < 2; ++ai)
#pragma unroll
            for (int m = 0; m < 4; ++m) { const int t = row0 + ai * HALF + m * 16; bf16_t* rowp = O + (size_t)dil_row(t, gi) * ldc + col0;
                const float2* cs = rope + (size_t)(t < 32768 ? (t & 4095) : (t & 8191)) * 32;
#pragma unroll
                for (int bj = 0; bj < 2; ++bj) { f32x4 v0 = acc[ai][bj][m][0], v1 = acc[ai][bj][m][1];
                    if (qk) { const int i0 = ((col0 + bj * HALF) & 63) >> 1;
                        const f32x4 c01 = *(const f32x4*)(cs + i0), c23 = *(const f32x4*)(cs + i0 + 2);
                        const f32x4 r0 = {v0[0] * c01[0] - v0[1] * c01[1], v0[0] * c01[1] + v0[1] * c01[0], v0[2] * c01[2] - v0[3] * c01[3], v0[2] * c01[3] + v0[3] * c01[2]};
                        const f32x4 r1 = {v1[0] * c23[0] - v1[1] * c23[1], v1[0] * c23[1] + v1[1] * c23[0], v1[2] * c23[2] - v1[3] * c23[3], v1[2] * c23[3] + v1[3] * c23[2]};
                        v0 = r0; v1 = r1; }
                    u32x4 w; w.x = cvt_pk_bf16(v0[0], v0[1]); w.y = cvt_pk_bf16(v0[2], v0[3]); w.z = cvt_pk_bf16(v1[0], v1[1]); w.w = cvt_pk_bf16(v1[2], v1[3]);
                    *(u32x4*)(rowp + bj * HALF) = w; } }
    }
};
__device__ __forceinline__ float silu_f(float g) { return g * __builtin_amdgcn_rcpf(1.0f + __builtin_amdgcn_exp2f(-1.4426950408889634f * g)); }
struct EpiSwiGlu {
    static constexpr bool PERM = true;
    bf16_t* O; int ldc;
    __device__ __forceinline__ void operator()(const f32x4 (&acc)[2][2][4][2], const Unit& u, int wr, int wc, int fr, int fq) const {
        const int row0 = u.pm * BM + wr * 64 + fr; const int col0 = u.pn * HALF + wc * 32 + 8 * fq;
#pragma unroll
        for (int ai = 0; ai < 2; ++ai)
#pragma unroll
            for (int m = 0; m < 4; ++m) { bf16_t* rowp = O + (size_t)(row0 + ai * HALF + m * 16) * ldc + col0;
                const f32x4 g0 = acc[ai][0][m][0], g1 = acc[ai][0][m][1], u0 = acc[ai][1][m][0], u1 = acc[ai][1][m][1];
                u32x4 w; w.x = cvt_pk_bf16(silu_f(g0[0]) * u0[0], silu_f(g0[1]) * u0[1]); w.y = cvt_pk_bf16(silu_f(g0[2]) * u0[2], silu_f(g0[3]) * u0[3]);
                w.z = cvt_pk_bf16(silu_f(g1[0]) * u1[0], silu_f(g1[1]) * u1[1]); w.w = cvt_pk_bf16(silu_f(g1[2]) * u1[2], silu_f(g1[3]) * u1[3]);
                *(u32x4*)rowp = w; }
    }
};

struct EpiSwiGluF8 {
    static constexpr bool PERM = true;
    unsigned char* O; int ldc; float sc;
    __device__ __forceinline__ void operator()(const f32x4 (&acc)[2][2][4][2], const Unit& u, int wr, int wc, int fr, int fq) const {
        const int row0 = u.pm * BM + wr * 64 + fr; const int col0 = u.pn * HALF + wc * 32 + 8 * fq;
#pragma unroll
        for (int ai = 0; ai < 2; ++ai)
#pragma unroll
            for (int m = 0; m < 4; ++m) { unsigned char* rowp = O + (size_t)(row0 + ai * HALF + m * 16) * ldc + col0;
                const f32x4 g0 = acc[ai][0][m][0] * sc, g1 = acc[ai][0][m][1] * sc, u0 = acc[ai][1][m][0] * sc, u1 = acc[ai][1][m][1] * sc;
                u32x2 w; w.x = pk4_fp8(silu_f(g0[0]) * u0[0], silu_f(g0[1]) * u0[1], silu_f(g0[2]) * u0[2], silu_f(g0[3]) * u0[3]);
                w.y = pk4_fp8(silu_f(g1[0]) * u1[0], silu_f(g1[1]) * u1[1], silu_f(g1[2]) * u1[2], silu_f(g1[3]) * u1[3]);
                *(u32x2*)rowp = w; }
    }
};

template <class Epi, class Sched, bool GATHER = false, bool F8 = false>
__device__ __forceinline__ void gemm_phase(int wv, LAS unsigned char* lds, const Gemm g, const Sched& S, const Epi& E, const int* aidx = nullptr) {
    const int tid = opaque_tid(wv), wid = __builtin_amdgcn_readfirstlane(tid >> 6), lane = tid & 63, wr = wid >> 2, wc = wid & 3, fr = lane & 15, fq = lane >> 4;
    const int K = g.K; const unsigned RB = F8 ? (unsigned)K : 2u * (unsigned)K;
    const int nt = (int)(RB / 128u);
    const size_t kstep = (size_t)(BK * 2);
    const size_t hstep = (size_t)HALF * RB;
    const size_t tstep = 2 * hstep;
    unsigned vG[2][2], voffB[2];
#pragma unroll
    for (int i = 0; i < 2; ++i) { int R, C; stage_rc(tid * 16 + i * 8192, R, C); const int Rb = Epi::PERM ? ((R & ~31) + perm32(R & 31)) : R;
        vG[0][i] = (unsigned)R * RB + (unsigned)C * 2u; vG[1][i] = vG[0][i] + (unsigned)hstep; voffB[i] = (unsigned)Rb * RB + (unsigned)C * 2u; }
    const unsigned ldsw = (unsigned)wid * 1024u;
    const int aoff = lds_byte(wr * 64 + fr, fq * 8), boff = lds_byte(wc * 32 + fr, fq * 8);
    LAS int* itab = (LAS int*)(lds + STAGE_BYTES + 1024);
#define PG8_SA(b, h) (((b) * 2 + (h)) * HTB)
#define PG8_SB(b, h) ((4 + (b) * 2 + (h)) * HTB)
#define PG8_STAGE2(bufoff, gbase, o0, o1) do { \
        __builtin_amdgcn_global_load_lds((const unsigned*)((const char*)(gbase) + (o0)), (LAS unsigned*)(lds + (bufoff) + ldsw), 16, 0, 0); \
        __builtin_amdgcn_global_load_lds((const unsigned*)((const char*)(gbase) + (o1)), (LAS unsigned*)(lds + (bufoff) + ldsw + 8192), 16, 0, 0); } while (0)
#define PG8_STAGE(bufoff, gbase, voff) PG8_STAGE2(bufoff, gbase, (voff)[0], (voff)[1])
#define PG8_LD8(p_) __builtin_shufflevector(*(const LAS i32x4*)(p_), *(const LAS i32x4*)((p_) + 1024), 0, 1, 2, 3, 4, 5, 6, 7)
#define PG8_LDA(dst, b, h) do { if constexpr (F8) { _Pragma("unroll") for (int m = 0; m < 4; ++m) dst##8[m] = PG8_LD8(lds + PG8_SA(b, h) + aoff + m * 2048); } \
        else { _Pragma("unroll") for (int m = 0; m < 4; ++m) _Pragma("unroll") for (int k = 0; k < 2; ++k) dst[m][k] = *(const LAS bf16x8*)(lds + PG8_SA(b, h) + aoff + m * 2048 + k * 1024); } } while (0)
#define PG8_LDB(dst, b, h) do { if constexpr (F8) { _Pragma("unroll") for (int n = 0; n < 2; ++n) dst##8[n] = PG8_LD8(lds + PG8_SB(b, h) + boff + n * 2048); } \
        else { _Pragma("unroll") for (int n = 0; n < 2; ++n) _Pragma("unroll") for (int k = 0; k < 2; ++k) dst[n][k] = *(const LAS bf16x8*)(lds + PG8_SB(b, h) + boff + n * 2048 + k * 1024); } } while (0)
#define PG8_MMA(ai, bj, At, Bt) do { __builtin_amdgcn_s_setprio(1); \
        if constexpr (F8) { _Pragma("unroll") for (int m = 0; m < 4; ++m) _Pragma("unroll") for (int n = 0; n < 2; ++n) \
            asm volatile("v_mfma_f32_16x16x128_f8f6f4 %0, %1, %2, %0" : "+v"(acc[ai][bj][m][n]) : "v"(Bt##8[n]), "v"(At##8[m])); } \
        else { _Pragma("unroll") for (int m = 0; m < 4; ++m) _Pragma("unroll") for (int n = 0; n < 2; ++n) _Pragma("unroll") for (int k = 0; k < 2; ++k) \
            acc[ai][bj][m][n] = __builtin_amdgcn_mfma_f32_16x16x32_bf16(Bt[n][k], At[m][k], acc[ai][bj][m][n], 0, 0, 0); } __builtin_amdgcn_s_setprio(0); } while (0)
#define PG8_WAIT_V(n) asm volatile("s_waitcnt vmcnt(" #n ")" ::: "memory")
#define PG8_WAIT_L(n) asm volatile("s_waitcnt lgkmcnt(" #n ")" ::: "memory")
#define PG8_BAR __builtin_amdgcn_s_barrier()
#define PG8_SCHED __builtin_amdgcn_sched_barrier(0)
    Unit cur, nxt; int ui = 0; int sl_nx = 1, sl_n2 = 2;
    if (!S.next(0, cur)) return;
    if constexpr (GATHER) {
        Unit u1; const bool h1 = S.next(1, u1);
        if (tid < 256) { itab[tid] = aidx[cur.pm * BM + tid]; if (h1) itab[256 + tid] = aidx[u1.pm * BM + tid]; }
        __syncthreads();
#pragma unroll
        for (int h = 0; h < 2; ++h)
#pragma unroll
            for (int i = 0; i < 2; ++i) { int R, C; stage_rc(tid * 16 + i * 8192, R, C); vG[h][i] = (unsigned)itab[h * HALF + R] * RB + (unsigned)C * 2u; }
    }
    f32x4 acc[2][2][4][2];
#pragma unroll
    for (int a = 0; a < 2; ++a)
#pragma unroll
        for (int b = 0; b < 2; ++b)
#pragma unroll
            for (int m = 0; m < 4; ++m)
#pragma unroll
                for (int n = 0; n < 2; ++n) acc[a][b][m][n] = (f32x4){0.f, 0.f, 0.f, 0.f};
    bf16x8 At[4][2], B0[2][2], B1[2][2]; i32x8 At8[4], B08[2], B18[2];
    const char* cA = GATHER ? (const char*)g.A : (const char*)g.A + (size_t)cur.pm * tstep; const char* cB = (const char*)g.Bt + (size_t)cur.pb * tstep;
    PG8_STAGE(PG8_SB(0, 0), cB, voffB); PG8_STAGE(PG8_SB(0, 1), cB + hstep, voffB); PG8_STAGE(PG8_SA(0, 0), cA, vG[0]); PG8_STAGE(PG8_SA(0, 1), cA, vG[1]);
    if (wr == 1) PG8_BAR;
    PG8_WAIT_V(2); PG8_BAR;
    PG8_STAGE(PG8_SB(1, 0), cB + kstep, voffB); PG8_STAGE(PG8_SA(1, 0), cA + kstep, vG[0]); PG8_STAGE(PG8_SB(1, 1), cB + hstep + kstep, voffB);
    PG8_WAIT_V(6); PG8_BAR;
    for (;;) {
        const bool has_next = S.next(ui + 1, nxt);
        const char* nA = GATHER ? cA : (has_next ? (const char*)g.A + (size_t)nxt.pm * tstep : cA); const char* nB = has_next ? (const char*)g.Bt + (size_t)nxt.pb * tstep : cB;
        if constexpr (GATHER) { Unit u2;
            if (wid == 0 && S.next(ui + 2, u2)) {
                int lo_ = lane; asm volatile("" : "+v"(lo_));
                const int* src = aidx + (size_t)u2.pm * BM + lo_; LAS int* dst = itab + sl_n2 * 256;
#pragma unroll
                for (int q = 0; q < 4; ++q) __builtin_amdgcn_global_load_lds((const unsigned*)(src + q * 64), (LAS unsigned*)(dst + q * 64), 4, 0, 0); } }
        for (int t = 0; t < nt; t += 2) {
            const bool last = (t == nt - 2);
            const char* a1 = cA + (size_t)(t + 1) * kstep;
            const char* a2 = last ? nA : cA + (size_t)(t + 2) * kstep; const char* b2 = last ? nB : cB + (size_t)(t + 2) * kstep;
            const char* a3 = a2 + kstep; const char* b3 = b2 + kstep;
            unsigned o00 = vG[0][0], o01 = vG[0][1], o10 = vG[1][0], o11 = vG[1][1];
            if constexpr (GATHER) { if (last && has_next) { const LAS int* tb = itab + sl_nx * 256; int R0, C0, R1, C1; stage_rc((lane + wid * 64) * 16, R0, C0); stage_rc((lane + wid * 64) * 16 + 8192, R1, C1);
                o00 = (unsigned)tb[R0] * RB + (unsigned)C0 * 2u; o01 = (unsigned)tb[R1] * RB + (unsigned)C1 * 2u; o10 = (unsigned)tb[HALF + R0] * RB + (unsigned)C0 * 2u; o11 = (unsigned)tb[HALF + R1] * RB + (unsigned)C1 * 2u; } }
            PG8_LDB(B0, 0, 0); PG8_LDB(B1, 0, 1); PG8_SCHED; PG8_LDA(At, 0, 0); PG8_STAGE(PG8_SA(1, 1), a1, vG[1]);
            PG8_WAIT_V(8); PG8_WAIT_L(0); PG8_BAR; PG8_MMA(0, 0, At, B0); PG8_MMA(0, 1, At, B1); PG8_BAR; PG8_SCHED;
            PG8_LDA(At, 0, 1); PG8_STAGE(PG8_SB(0, 0), b2, voffB); PG8_STAGE(PG8_SB(0, 1), b2 + hstep, voffB); PG8_STAGE2(PG8_SA(0, 0), a2, o00, o01);
            PG8_WAIT_V(8); PG8_WAIT_L(0); PG8_BAR; PG8_MMA(1, 0, At, B0); PG8_MMA(1, 1, At, B1); PG8_BAR; PG8_SCHED;
            PG8_LDB(B0, 1, 0); PG8_LDB(B1, 1, 1); PG8_SCHED; PG8_LDA(At, 1, 0); PG8_STAGE2(PG8_SA(0, 1), a2, o10, o11);
            PG8_WAIT_V(8); PG8_WAIT_L(0); PG8_BAR; PG8_MMA(0, 0, At, B0); PG8_MMA(0, 1, At, B1); PG8_BAR; PG8_SCHED;
            PG8_LDA(At, 1, 1); PG8_STAGE(PG8_SB(1, 0), b3, voffB); PG8_STAGE(PG8_SB(1, 1), b3 + hstep, voffB); PG8_STAGE2(PG8_SA(1, 0), a3, o00, o01);
            PG8_WAIT_V(8); PG8_WAIT_L(0); PG8_BAR; PG8_MMA(1, 0, At, B0); PG8_MMA(1, 1, At, B1); PG8_BAR; PG8_SCHED;
        }
        if (wr == 0) PG8_BAR;
        if constexpr (F8) asm volatile("s_nop 15\n\ts_nop 15" ::: "memory");
        E(acc, cur, wr, wc, fr, fq);
        if (!has_next) break;
#pragma unroll
        for (int a = 0; a < 2; ++a)
#pragma unroll
            for (int b = 0; b < 2; ++b)
#pragma unroll
                for (int m = 0; m < 4; ++m)
#pragma unroll
                    for (int n = 0; n < 2; ++n) acc[a][b][m][n] = (f32x4){0.f, 0.f, 0.f, 0.f};
        cur = nxt; cA = nA; cB = nB; ++ui;
        { const int t3 = sl_nx; sl_nx = sl_n2; sl_n2 = (sl_n2 == 2) ? 0 : sl_n2 + 1; (void)t3; }
        if constexpr (GATHER) { const LAS int* tb = itab + ((sl_nx == 0) ? 2 : sl_nx - 1) * 256;
#pragma unroll
            for (int h = 0; h < 2; ++h)
#pragma unroll
                for (int i = 0; i < 2; ++i) { int R, C; stage_rc((lane + wid * 64) * 16 + i * 8192, R, C); vG[h][i] = (unsigned)tb[h * HALF + R] * RB + (unsigned)C * 2u; } }
        if (wr == 1) PG8_BAR;
    }
    PG8_WAIT_V(0);
    PG8_BAR;
#undef PG8_SA
#undef PG8_SB
#undef PG8_STAGE
#undef PG8_STAGE2
#undef PG8_LDA
#undef PG8_LDB
#undef PG8_MMA
#undef PG8_LD8
#undef PG8_WAIT_V
#undef PG8_WAIT_L
#undef PG8_BAR
#undef PG8_SCHED
}
}

namespace att {
typedef unsigned short bf16;
typedef short bf16x8 __attribute__((ext_vector_type(8)));
typedef short s16x4 __attribute__((ext_vector_type(4)));
typedef float f32x16 __attribute__((ext_vector_type(16)));
typedef unsigned u32x4 __attribute__((ext_vector_type(4)));
typedef float f32x4 __attribute__((ext_vector_type(4)));
typedef float f32x2_t __attribute__((ext_vector_type(2)));
typedef __bf16 bf16x2_t __attribute__((ext_vector_type(2)));
constexpr int NSLOT = 3, KSLOT = 12288, VSLOT = 8192;
constexpr int L_K = 0, L_V = NSLOT * KSLOT, L_WS = L_V + NSLOT * VSLOT, L_OST = L_WS + 8 * 64 * 4, L_TAB = 114688, L_END = L_TAB + 8 * 465 * 4;
static_assert(L_OST + 8 * 4096 <= L_TAB, "attention LDS");
static_assert(L_END <= 131072, "attention LDS");
constexpr int N_KSL = 8192, N_V = 4 * N_KSL, N_WS = N_V + 4 * VSLOT, N_OST = N_WS + 8 * 64 * 4;
static_assert(N_OST + 8 * 4096 <= L_TAB, "neighbourhood attention LDS");
constexpr float LOG2E = 1.4426950408889634f, LN2 = 0.6931471805599453f;
constexpr float THR = 8.0f;
__device__ __forceinline__ int crow(int r, int hi) { return (r & 3) + 8 * (r >> 2) + 4 * hi; }
#define ATT_SBAR() __builtin_amdgcn_sched_barrier(0)
__device__ __forceinline__ void glds16(const void* gsrc, unsigned lds_dst) { unsigned keep;
  asm volatile("s_mov_b32 %0, m0\n\ts_mov_b32 m0, %2\n\ts_nop 0\n\tglobal_load_lds_dwordx4 %1, off\n\ts_mov_b32 m0, %0" : "=&s"(keep) : "v"(gsrc), "s"(lds_dst) : "memory"); }
__device__ __forceinline__ void glds16s(unsigned vofs, const void* sbase, unsigned lds_dst) { unsigned keep;
  asm volatile("s_mov_b32 %0, m0\n\ts_mov_b32 m0, %3\n\ts_nop 0\n\tglobal_load_lds_dwordx4 %1, %2\n\ts_mov_b32 m0, %0" : "=&s"(keep) : "v"(vofs), "s"(sbase), "s"(lds_dst) : "memory"); }
__device__ __forceinline__ float max3f(float a, float b, float c) { float r; asm("v_max3_f32 %0, %1, %2, %3" : "=v"(r) : "v"(a), "v"(b), "v"(c)); return r; }
__device__ __forceinline__ unsigned cvtpk_s(float lo, float hi) { f32x2_t v = {lo, hi}; bf16x2_t b = __builtin_convertvector(v, bf16x2_t); return __builtin_bit_cast(unsigned, b); }
__device__ __forceinline__ float bf2f(short s) { return __uint_as_float(((unsigned)(unsigned short)s) << 16); }
#define ATT_WAIT_BAR(N) asm volatile("s_waitcnt vmcnt(" #N ") lgkmcnt(0)\n\ts_barrier" ::: "memory")

template <int ND0> __device__ __forceinline__ void qkt(f32x16& p0, f32x16& p1, const LAS unsigned char* Kslot, const bf16x8* qr, int r32, int hi) {
  const LAS unsigned char* kb = Kslot + hi * 1024 + r32 * 16;
#pragma unroll
  for (int d0 = 0; d0 < ND0; ++d0) {
    const bf16x8 b0 = *(const LAS bf16x8*)(kb + d0 * 2048);
    const bf16x8 b1 = *(const LAS bf16x8*)(kb + d0 * 2048 + 512);
    p0 = __builtin_amdgcn_mfma_f32_32x32x16_bf16(b0, qr[d0], p0, 0, 0, 0); p1 = __builtin_amdgcn_mfma_f32_32x32x16_bf16(b1, qr[d0], p1, 0, 0, 0); }
}
__device__ __forceinline__ float rowmax(const f32x16& p0, const f32x16& p1) {
  float a = max3f(p0[0], p0[1], p1[0]), b = max3f(p0[2], p0[3], p1[1]); a = max3f(a, p1[2], p1[3]);
#pragma unroll
  for (int r = 4; r < 16; r += 4) { a = max3f(a, p0[r], p0[r + 1]); b = max3f(b, p0[r + 2], p0[r + 3]); a = max3f(a, p1[r], p1[r + 1]); b = max3f(b, p1[r + 2], p1[r + 3]); }
  const float m = fmaxf(a, b);
  auto rr = __builtin_amdgcn_permlane32_swap(__float_as_uint(m), __float_as_uint(m), false, false);
  return fmaxf(__uint_as_float(rr[0]), __uint_as_float(rr[1]));
}
__device__ __forceinline__ void pv(f32x16* o, int vb, bf16x8 pa0, bf16x8 pa1, bf16x8 pa2, bf16x8 pa3) {
#pragma unroll
  for (int d0 = 0; d0 < 2; ++d0) { s16x4 lo[4], hi[4];
#pragma unroll
    for (int ks = 0; ks < 4; ++ks) {
      asm volatile("ds_read_b64_tr_b16 %0,%1 offset:%c2" : "=&v"(lo[ks]) : "v"(vb), "i"(d0 * 4096 + ks * 1024) : "memory");
      asm volatile("ds_read_b64_tr_b16 %0,%1 offset:%c2" : "=&v"(hi[ks]) : "v"(vb), "i"(d0 * 4096 + ks * 1024 + 512) : "memory"); }
    asm volatile("s_waitcnt lgkmcnt(0)" ::: "memory"); ATT_SBAR();
#define ATT_PK(k) (bf16x8){lo[k][0], lo[k][1], lo[k][2], lo[k][3], hi[k][0], hi[k][1], hi[k][2], hi[k][3]}
    o[d0] = __builtin_amdgcn_mfma_f32_32x32x16_bf16(pa0, ATT_PK(0), o[d0], 0, 0, 0);
    o[d0] = __builtin_amdgcn_mfma_f32_32x32x16_bf16(pa1, ATT_PK(1), o[d0], 0, 0, 0);
    o[d0] = __builtin_amdgcn_mfma_f32_32x32x16_bf16(pa2, ATT_PK(2), o[d0], 0, 0, 0);
    o[d0] = __builtin_amdgcn_mfma_f32_32x32x16_bf16(pa3, ATT_PK(3), o[d0], 0, 0, 0);
#undef ATT_PK
  }
}

template <int KLO, int KHI> __device__ __forceinline__ void pv_r(f32x16* o, int vb, bf16x8 pa0, bf16x8 pa1, bf16x8 pa2, bf16x8 pa3) {
#pragma unroll
  for (int d0 = 0; d0 < 2; ++d0) { s16x4 lo[4], hi[4];
#pragma unroll
    for (int ks = KLO; ks < KHI; ++ks) {
      asm volatile("ds_read_b64_tr_b16 %0,%1 offset:%c2" : "=&v"(lo[ks]) : "v"(vb), "i"(d0 * 4096 + ks * 1024) : "memory");
      asm volatile("ds_read_b64_tr_b16 %0,%1 offset:%c2" : "=&v"(hi[ks]) : "v"(vb), "i"(d0 * 4096 + ks * 1024 + 512) : "memory"); }
    asm volatile("s_waitcnt lgkmcnt(0)" ::: "memory"); ATT_SBAR();
#define ATT_PK(k) (bf16x8){lo[k][0], lo[k][1], lo[k][2], lo[k][3], hi[k][0], hi[k][1], hi[k][2], hi[k][3]}
    if (KLO <= 0 && 0 < KHI) o[d0] = __builtin_amdgcn_mfma_f32_32x32x16_bf16(pa0, ATT_PK(0), o[d0], 0, 0, 0);
    if (KLO <= 1 && 1 < KHI) o[d0] = __builtin_amdgcn_mfma_f32_32x32x16_bf16(pa1, ATT_PK(1), o[d0], 0, 0, 0);
    if (KLO <= 2 && 2 < KHI) o[d0] = __builtin_amdgcn_mfma_f32_32x32x16_bf16(pa2, ATT_PK(2), o[d0], 0, 0, 0);
    if (KLO <= 3 && 3 < KHI) o[d0] = __builtin_amdgcn_mfma_f32_32x32x16_bf16(pa3, ATT_PK(3), o[d0], 0, 0, 0);
#undef ATT_PK
  }
}
template <class P, int VAR> __device__ __forceinline__ float rowmax_v(const f32x16& p0, const f32x16& p1) {
  const f32x16& F = (VAR == 0) ? p0 : p1; const f32x16& H = (VAR == 0) ? p1 : p0; constexpr int o = P::live4(VAR);
  float a = max3f(F[0], F[1], F[2]), b = max3f(F[3], F[4], F[5]); a = max3f(a, F[6], F[7]); b = max3f(b, F[8], F[9]); a = max3f(a, F[10], F[11]); b = max3f(b, F[12], F[13]); a = max3f(a, F[14], F[15]);
  b = max3f(b, H[o], H[o + 1]); a = max3f(a, H[o + 2], H[o + 3]);
  const float m = fmaxf(a, b);
  auto rr = __builtin_amdgcn_permlane32_swap(__float_as_uint(m), __float_as_uint(m), false, false);
  return fmaxf(__uint_as_float(rr[0]), __uint_as_float(rr[1]));
}
template <class P, class R> __device__ __forceinline__ void attn_unit(int wv, const P& pol, LAS unsigned char* shm, R& rider, const P& nxt, bool has_nxt, bool pre) {
  constexpr int ND0 = P::ND0;
  const int tid = opaque_tid(wv), lane = tid & 63, r32 = lane & 31, hi = lane >> 5; const int wid = __builtin_amdgcn_readfirstlane(tid >> 6);
  const unsigned lds0 = (unsigned)(uintptr_t)shm;
  static_assert(ND0 == 4, "this unit's ring is laid out for qk dim 64 (8 KiB K tiles): four slots, requests three tiles ahead");
  LAS float* wsf = (LAS float*)(shm + N_WS) + wid * 64;
  const int NT = pol.ntiles();
  const bool three = (ND0 == 6) && (wid < 4);
#define ATT_DMA_P(PL, t, slot) do { \
    glds16((PL).k_src((t), wid, lane), (unsigned)__builtin_amdgcn_readfirstlane(lds0 + (slot) * N_KSL + wid * 1024)); \
    glds16((PL).v_src((t), wid, lane), (unsigned)__builtin_amdgcn_readfirstlane(lds0 + N_V + (slot) * VSLOT + wid * 1024)); } while (0)
#define ATT_DMA(t, slot) ATT_DMA_P(pol, t, slot)
  if (!pre) { ATT_DMA(0, 0); ATT_DMA(1, 1); ATT_DMA(2, 2); }
  bf16x8 qr[ND0];
  { const bf16* qp = pol.q_ptr(wid, r32);
#pragma unroll
    for (int d0 = 0; d0 < ND0; ++d0) qr[d0] = *reinterpret_cast<const bf16x8*>(qp + d0 * 16 + hi * 8); }
  pol.q_fix(qr, wid, r32, hi);
  float m = -1e30f, lsum = 0.f; f32x16 o[2]; o[0] = f32x16{}; o[1] = f32x16{};
  const int vb0 = (int)(lds0 + N_V) + ((lane >> 4) & 1) * 32 + (lane & 3) * 8 + (4 * hi + ((lane & 15) >> 2)) * 64;
  ATT_WAIT_BAR(0);
  f32x4 rw[R::NW]; rider.begin(lane, rw);
  int s_cur = 0, s_n3 = 3;
  for (int t = 0; t < NT; ++t) {
    if (t + 3 < NT) ATT_DMA(t + 3, s_n3);
    const int xr = rider.mid(t, NT, lane, rw);
    if (pol.needs(t, wid)) {
#define ATT_BODY(VAR) do { \
      f32x16 p0 = f32x16{}, p1 = f32x16{}; \
      qkt<ND0>(p0, p1, shm + s_cur * N_KSL, qr, r32, hi); \
      pol.template transform_v<VAR>(p0, p1, t, wid, r32, hi); \
      const float rm = rowmax_v<P, VAR>(p0, p1); \
      const bool grow = rm > m + THR; \
      if (__any(grow)) { \
        const float mn = grow ? rm : m; const float f = __builtin_amdgcn_exp2f(m - mn); m = mn; lsum *= f; \
        if (hi == 0) wsf[r32] = f; \
        asm volatile("s_waitcnt lgkmcnt(0)" ::: "memory"); \
        _Pragma("unroll") for (int r = 0; r < 16; ++r) { const float ff = wsf[crow(r, hi)]; o[0][r] *= ff; o[1][r] *= ff; } } \
      float sacc = 0.f; \
      _Pragma("unroll") for (int r = 0; r < 16; ++r) { \
        if (!P::dead(VAR, 0, r)) { p0[r] = __builtin_amdgcn_exp2f(p0[r] - m); sacc += p0[r]; } else p0[r] = 0.f; \
        if (!P::dead(VAR, 1, r)) { p1[r] = __builtin_amdgcn_exp2f(p1[r] - m); sacc += p1[r]; } else p1[r] = 0.f; } \
      lsum += sacc; \
      u32x4 pw0, pw1, pw2, pw3; \
      pw0 = (u32x4){cvtpk_s(p0[0], p0[1]), cvtpk_s(p0[2], p0[3]), cvtpk_s(p0[4], p0[5]), cvtpk_s(p0[6], p0[7])}; \
      pw1 = (u32x4){cvtpk_s(p0[8], p0[9]), cvtpk_s(p0[10], p0[11]), cvtpk_s(p0[12], p0[13]), cvtpk_s(p0[14], p0[15])}; \
      pw2 = (u32x4){cvtpk_s(p1[0], p1[1]), cvtpk_s(p1[2], p1[3]), cvtpk_s(p1[4], p1[5]), cvtpk_s(p1[6], p1[7])}; \
      pw3 = (u32x4){cvtpk_s(p1[8], p1[9]), cvtpk_s(p1[10], p1[11]), cvtpk_s(p1[12], p1[13]), cvtpk_s(p1[14], p1[15])}; \
      ATT_SBAR(); \
      pv_r<P::kslo(VAR), P::kshi(VAR)>(o, vb0 + s_cur * VSLOT, __builtin_bit_cast(bf16x8, pw0), __builtin_bit_cast(bf16x8, pw1), __builtin_bit_cast(bf16x8, pw2), __builtin_bit_cast(bf16x8, pw3)); \
      } while (0)
      if (pol.variant(wid)) ATT_BODY(1); else ATT_BODY(0);
#undef ATT_BODY
    }
    if (xr == 16 && t + 3 < NT) ATT_WAIT_BAR(20); else if (xr == 20 && t + 3 < NT) ATT_WAIT_BAR(24);
    else if (t + 3 < NT) ATT_WAIT_BAR(4); else if (t + 2 < NT) ATT_WAIT_BAR(2); else ATT_WAIT_BAR(0);
    s_cur = (s_cur + 1) & 3; s_n3 = (s_n3 + 1) & 3;
  }
  rider.end(lane, rw);
  if (has_nxt) { ATT_DMA_P(nxt, 0, 0); ATT_DMA_P(nxt, 1, 1); ATT_DMA_P(nxt, 2, 2); }
  { auto rr = __builtin_amdgcn_permlane32_swap(__float_as_uint(lsum), __float_as_uint(lsum), false, false); lsum = __uint_as_float(rr[0]) + __uint_as_float(rr[1]); }
  if (hi == 0) { wsf[32 + r32] = lsum; pol.lse_out(wid, r32, (m + __builtin_amdgcn_logf(lsum)) * LN2); }
  asm volatile("s_waitcnt lgkmcnt(0)" ::: "memory");
  float rli[16];
#pragma unroll
  for (int r = 0; r < 16; ++r) rli[r] = __builtin_amdgcn_rcpf(wsf[32 + crow(r, hi)]);
  { LAS bf16* stg = (LAS bf16*)(shm + N_OST) + wid * 2048;
#pragma unroll
    for (int r = 0; r < 16; ++r) { const int orow = crow(r, hi);
#pragma unroll
      for (int d0 = 0; d0 < 2; ++d0) stg[orow * 64 + d0 * 32 + r32] = (bf16)(cvtpk_s(o[d0][r] * rli[r], 0.f) & 0xffffu); }
    asm volatile("s_waitcnt lgkmcnt(0)" ::: "memory");
#pragma unroll
    for (int i = 0; i < 4; ++i) { const int row = i * 8 + (lane >> 3), ch = lane & 7; const u32x4 v = *(const LAS u32x4*)(stg + row * 64 + ch * 8); *(u32x4*)(pol.o_ptr(wid, row) + ch * 8) = v; } }
  asm volatile("s_waitcnt lgkmcnt(0)\n\ts_barrier" ::: "memory");
#undef ATT_DMA
#undef ATT_DMA_P
}

typedef short v4i16_t __attribute__((ext_vector_type(4)));
__device__ __forceinline__ s16x4 vtr(const LAS unsigned char* p) { return __builtin_bit_cast(s16x4, __builtin_amdgcn_ds_read_tr16_b64_v4i16((LAS v4i16_t*)p)); }
#define ATT_PIN(x) asm volatile("" : "+v"(x))
#define ATT_MFMA(a, b, c) __builtin_amdgcn_mfma_f32_32x32x16_bf16(a, b, c, 0, 0, 0)
template <class P, class R> __device__ __forceinline__ void attn_unit_pipe(int wv, const P& pol, LAS unsigned char* shm, R& rider, const P& nxt, bool has_nxt, bool pre) {
  static_assert(P::ND0 == 6 && P::FUSED, "dense pipelined unit: qk dim 96, scale folded into the exponent");
  const int tid = opaque_tid(wv), lane = tid & 63, r32 = lane & 31, hi = lane >> 5; const int wid = __builtin_amdgcn_readfirstlane(tid >> 6);
  const unsigned lds0 = (unsigned)(uintptr_t)shm;
  LAS float* wsf = (LAS float*)(shm + L_WS) + wid * 64;
  const int NT = pol.ntiles();
  const bool three = wid < 4;
  const unsigned kofs = P::k_lofs(wid, lane), k2ofs = P::k2_lofs(wid, lane), vofs = P::v_lofs(wid, lane);
  const unsigned kdst = (unsigned)__builtin_amdgcn_readfirstlane(lds0 + L_K + wid * 1024), vdst = (unsigned)__builtin_amdgcn_readfirstlane(lds0 + L_V + wid * 1024);
#define ATT_DMAK(PL, t, slot) do { glds16s(kofs, (PL).k_base() + (size_t)(t) * P::KSTRIDE, kdst + (slot) * KSLOT); \
    if (three) glds16s(k2ofs, (PL).k2_base() + (size_t)(t) * P::K2STRIDE, kdst + 8192 + (slot) * KSLOT); } while (0)
#define ATT_DMAV(PL, t, slot) glds16s(vofs, (PL).k_base() + (size_t)(t) * P::KSTRIDE, vdst + (slot) * VSLOT)
  if (!pre) { ATT_DMAK(pol, 0, 0); ATT_DMAK(pol, 1, 1); }
  bf16x8 qr[6];
  { const bf16* qp = pol.q_ptr(wid, r32);
#pragma unroll
    for (int d0 = 0; d0 < 6; ++d0) qr[d0] = *reinterpret_cast<const bf16x8*>(qp + d0 * 16 + hi * 8); }
  pol.q_fix(qr, wid, r32, hi);
  ATT_DMAV(pol, 0, 0);
  float mhat = 0.f, lsum = 0.f; f32x16 o[2]; o[0] = f32x16{}; o[1] = f32x16{};
  const LAS unsigned char* vp0 = shm + L_V + ((lane >> 4) & 1) * 32 + (lane & 3) * 8 + (4 * hi + ((lane & 15) >> 2)) * 64;
  const LAS unsigned char* kp0 = shm + L_K + hi * 1024 + r32 * 16;
  f32x16 pA0, pA1, pB0, pB1; u32x4 pw0, pw1, pw2, pw3; bool resc = false, rl = false;
  asm volatile("s_waitcnt vmcnt(1) lgkmcnt(0)\n\ts_barrier" ::: "memory");
  f32x4 rw[R::NW]; rider.begin(lane, rw);
  int sl_prev = 2, sl_cur = 0, sl_next = 1;
#define ATT_ROT() do { const int t_ = sl_prev; sl_prev = sl_cur; sl_cur = sl_next; sl_next = t_; } while (0)
#define ATT_KF(i) (*(const LAS bf16x8*)(kp_ + ((i) >> 1) * 2048 + ((i) & 1) * 512))
#define ATT_EX(v) __builtin_amdgcn_exp2f(__builtin_fmaf((v), P::SC, nmh))
#define ATT_RESC() do { if (resc) { _Pragma("unroll") for (int d_ = 0; d_ < 2; ++d_) _Pragma("unroll") for (int r = 0; r < 16; ++r) o[d_][r] *= wsf[crow(r, hi)]; } } while (0)
  ATT_DMAK(pol, 2, 2); ATT_DMAV(pol, 1, 1);
  { const LAS unsigned char* kp_ = kp0; pA0 = f32x16{}; pA1 = f32x16{};
#pragma unroll
    for (int d0 = 0; d0 < 6; ++d0) { const bf16x8 b0 = ATT_KF(2 * d0), b1 = ATT_KF(2 * d0 + 1); pA0 = ATT_MFMA(b0, qr[d0], pA0); pA1 = ATT_MFMA(b1, qr[d0], pA1); }
    const float rm = rowmax(pA0, pA1); mhat = rm * P::SC; const float nmh = -mhat;
#pragma unroll
    for (int r = 0; r < 16; ++r) pA0[r] = ATT_EX(pA0[r]);
#pragma unroll
    for (int r = 0; r < 8; ++r) pA1[r] = ATT_EX(pA1[r]); }
  if (three) ATT_WAIT_BAR(3); else ATT_WAIT_BAR(2);
  ATT_ROT();
#define ATT_PKW(X, i) cvtpk_s(X[i], X[(i) + 1])
#define ATT_PAF(k) __builtin_bit_cast(bf16x8, pw##k)
#define ATT_VFR(v) (bf16x8){v##l[0], v##l[1], v##l[2], v##l[3], v##h[0], v##h[1], v##h[2], v##h[3]}
#define ATT_VRD(v, f) do { v##l = vtr(vp_ + ((f) >> 2) * 4096 + ((f) & 3) * 1024); v##h = vtr(vp_ + ((f) >> 2) * 4096 + ((f) & 3) * 1024 + 512); } while (0)
#define ATT_GAPE(LD, MF, X, i) do { LD; MF; X[i] = ATT_EX0(X[i]); X[(i) + 1] = ATT_EX0(X[(i) + 1]); ATT_PIN(X); ATT_SBAR(); } while (0)
#define ATT_GAPA(LD, MF, a0, a1, a2, a3, W0, W1, PW) do { LD; MF; sacc += a0; sacc += a1; sacc += a2; sacc += a3; W0; W1; ATT_PIN(PW); ATT_PIN(sacc); ATT_SBAR(); } while (0)
#define ATT_GAPB(LD, MF, X, a, Y, b, Z, c) do { LD; MF; X[a] = ATT_EX(X[a]); Y[b] = ATT_EX(Y[b]); Z[c] = ATT_EX(Z[c]); ATT_PIN(X); ATT_PIN(Z); ATT_SBAR(); } while (0)
#define ATT_EX0(v) __builtin_amdgcn_exp2f(__builtin_fmaf((v), P::SC, nmh0))
#define ATT_STEP(C0, C1, P0, P1, s, GK, GV) do { ATT_SBAR(); \
    rl = rider.pre((s), lane, rw);                                  \
    if (GK) ATT_DMAK(pol, (s) + 2, sl_prev); if (GV) ATT_DMAV(pol, (s) + 1, sl_next); \
    if (rl) rider.post(lane, rw);                                   \
    const LAS unsigned char* kp_ = kp0 + sl_cur * KSLOT; const LAS unsigned char* vp_ = vp0 + sl_prev * VSLOT; const float nmh0 = -mhat; \
    bf16x8 k0 = ATT_KF(0), k1 = ATT_KF(1), k2; s16x4 vAl, vAh, vBl, vBh, vCl, vCh; ATT_SBAR(); \
    ATT_GAPE(k2 = ATT_KF(2),  C0 = ATT_MFMA(k0, qr[0], f32x16{}), P1, 8); \
    ATT_GAPE(k0 = ATT_KF(3),  C1 = ATT_MFMA(k1, qr[0], f32x16{}), P1, 10); \
    ATT_GAPE(k1 = ATT_KF(4),  C0 = ATT_MFMA(k2, qr[1], C0),       P1, 12); \
    ATT_GAPE(k2 = ATT_KF(5),  C1 = ATT_MFMA(k0, qr[1], C1),       P1, 14); \
    float sacc = P0[0] + P0[1]; \
    ATT_GAPA(k0 = ATT_KF(6),  C0 = ATT_MFMA(k1, qr[2], C0),       P0[2], P0[3], P0[4], P0[5],     pw0[0] = ATT_PKW(P0, 0),  pw0[1] = ATT_PKW(P0, 2),  pw0); \
    ATT_GAPA(k1 = ATT_KF(7),  C1 = ATT_MFMA(k2, qr[2], C1),       P0[6], P0[7], P0[8], P0[9],     pw0[2] = ATT_PKW(P0, 4),  pw0[3] = ATT_PKW(P0, 6),  pw0); \
    ATT_GAPA(k2 = ATT_KF(8),  C0 = ATT_MFMA(k0, qr[3], C0),       P0[10], P0[11], P0[12], P0[13], pw1[0] = ATT_PKW(P0, 8),  pw1[1] = ATT_PKW(P0, 10), pw1); \
    ATT_GAPA(k0 = ATT_KF(9),  C1 = ATT_MFMA(k1, qr[3], C1),       P0[14], P0[15], P1[0], P1[1],   pw1[2] = ATT_PKW(P0, 12), pw1[3] = ATT_PKW(P0, 14), pw1); \
    ATT_GAPA(k1 = ATT_KF(10), C0 = ATT_MFMA(k2, qr[4], C0),       P1[2], P1[3], P1[4], P1[5],     pw2[0] = ATT_PKW(P1, 0),  pw2[1] = ATT_PKW(P1, 2),  pw2); \
    ATT_GAPA(k2 = ATT_KF(11), C1 = ATT_MFMA(k0, qr[4], C1),       P1[6], P1[7], P1[8], P1[9],     pw2[2] = ATT_PKW(P1, 4),  pw2[3] = ATT_PKW(P1, 6),  pw2); \
    ATT_GAPA(ATT_VRD(vA, 0),  C0 = ATT_MFMA(k1, qr[5], C0),       P1[10], P1[11], P1[12], P1[13], pw3[0] = ATT_PKW(P1, 8),  pw3[1] = ATT_PKW(P1, 10), pw3); \
    ATT_GAPA(ATT_VRD(vB, 4),  C1 = ATT_MFMA(k2, qr[5], C1),       P1[14], P1[15], 0.f, 0.f,       pw3[2] = ATT_PKW(P1, 12), pw3[3] = ATT_PKW(P1, 14), pw3); \
    lsum += sacc; \
    { const float rm = __builtin_fmaf(rowmax(C0, C1), P::SC, -mhat); resc = false;                                        \
      if (__builtin_expect(__any(rm > THR), 0)) { const float dl = __builtin_fmaxf(rm, 0.f); mhat += dl;                   \
          const float f = __builtin_amdgcn_exp2f(-dl); lsum *= f; if (hi == 0) wsf[r32] = f; resc = true; } } \
    const float nmh = -mhat; ATT_SBAR(); \
    ATT_GAPB(ATT_VRD(vC, 1), o[0] = ATT_MFMA(ATT_PAF(0), ATT_VFR(vA), o[0]), C0, 0,  C0, 1,  C0, 2); \
    ATT_GAPB(ATT_VRD(vA, 5), o[1] = ATT_MFMA(ATT_PAF(0), ATT_VFR(vB), o[1]), C0, 3,  C0, 4,  C0, 5); \
    ATT_GAPB(ATT_VRD(vB, 2), o[0] = ATT_MFMA(ATT_PAF(1), ATT_VFR(vC), o[0]), C0, 6,  C0, 7,  C0, 8); \
    ATT_GAPB(ATT_VRD(vC, 6), o[1] = ATT_MFMA(ATT_PAF(1), ATT_VFR(vA), o[1]), C0, 9,  C0, 10, C0, 11); \
    ATT_GAPB(ATT_VRD(vA, 3), o[0] = ATT_MFMA(ATT_PAF(2), ATT_VFR(vB), o[0]), C0, 12, C0, 13, C0, 14); \
    ATT_GAPB(ATT_VRD(vB, 7), o[1] = ATT_MFMA(ATT_PAF(2), ATT_VFR(vC), o[1]), C0, 15, C1, 0,  C1, 1); \
    ATT_GAPB((void)0,        o[0] = ATT_MFMA(ATT_PAF(3), ATT_VFR(vA), o[0]), C1, 2,  C1, 3,  C1, 4); \
    ATT_GAPB((void)0,        o[1] = ATT_MFMA(ATT_PAF(3), ATT_VFR(vB), o[1]), C1, 5,  C1, 6,  C1, 7); \
    } while (0)
#define ATT_WAIT23() do { if (rl) { if (three) ATT_WAIT_BAR(7); else ATT_WAIT_BAR(6); } else { if (three) ATT_WAIT_BAR(3); else ATT_WAIT_BAR(2); } } while (0)
  int t = 1;
  for (; t + 3 < NT; t += 2) {
    ATT_STEP(pB0, pB1, pA0, pA1, t, true, true);      ATT_WAIT23(); ATT_RESC(); ATT_ROT();
    ATT_STEP(pA0, pA1, pB0, pB1, t + 1, true, true);  ATT_WAIT23(); ATT_RESC(); ATT_ROT();
  }
  ATT_STEP(pB0, pB1, pA0, pA1, t, true, true);        ATT_WAIT23();    ATT_RESC(); ATT_ROT();
  ATT_STEP(pA0, pA1, pB0, pB1, t + 1, false, true);   ATT_WAIT_BAR(1); ATT_RESC(); ATT_ROT();
  ATT_STEP(pB0, pB1, pA0, pA1, t + 2, false, false);  ATT_WAIT_BAR(0); ATT_RESC(); ATT_ROT();
  rider.end(lane, rw);
  if (has_nxt) { ATT_DMAK(nxt, 0, 0); ATT_DMAK(nxt, 1, 1); }
  { { const float nmh0 = -mhat;
#pragma unroll
      for (int r = 8; r < 16; ++r) pB1[r] = ATT_EX0(pB1[r]); }
    float sacc = pB0[0] + pB0[1];
#pragma unroll
    for (int r = 2; r < 16; ++r) sacc += pB0[r];
#pragma unroll
    for (int r = 0; r < 16; ++r) sacc += pB1[r];
    lsum += sacc;
    pw0 = (u32x4){ATT_PKW(pB0, 0), ATT_PKW(pB0, 2), ATT_PKW(pB0, 4), ATT_PKW(pB0, 6)}; pw1 = (u32x4){ATT_PKW(pB0, 8), ATT_PKW(pB0, 10), ATT_PKW(pB0, 12), ATT_PKW(pB0, 14)};
    pw2 = (u32x4){ATT_PKW(pB1, 0), ATT_PKW(pB1, 2), ATT_PKW(pB1, 4), ATT_PKW(pB1, 6)}; pw3 = (u32x4){ATT_PKW(pB1, 8), ATT_PKW(pB1, 10), ATT_PKW(pB1, 12), ATT_PKW(pB1, 14)};
    pv(o, (int)(lds0 + L_V) + ((lane >> 4) & 1) * 32 + (lane & 3) * 8 + (4 * hi + ((lane & 15) >> 2)) * 64 + sl_prev * VSLOT, ATT_PAF(0), ATT_PAF(1), ATT_PAF(2), ATT_PAF(3)); }
  { auto rr = __builtin_amdgcn_permlane32_swap(__float_as_uint(lsum), __float_as_uint(lsum), false, false); lsum = __uint_as_float(rr[0]) + __uint_as_float(rr[1]); }
  if (hi == 0) { wsf[32 + r32] = lsum; pol.lse_out(wid, r32, (mhat + __builtin_amdgcn_logf(lsum)) * LN2); }
  asm volatile("s_waitcnt lgkmcnt(0)" ::: "memory");
  float rli[16];
#pragma unroll
  for (int r = 0; r < 16; ++r) rli[r] = __builtin_amdgcn_rcpf(wsf[32 + crow(r, hi)]);
  { LAS bf16* stg = (LAS bf16*)(shm + L_OST) + wid * 2048;
#pragma unroll
    for (int r = 0; r < 16; ++r) { const int orow = crow(r, hi);
#pragma unroll
      for (int d0 = 0; d0 < 2; ++d0) stg[orow * 64 + d0 * 32 + r32] = (bf16)(cvtpk_s(o[d0][r] * rli[r], 0.f) & 0xffffu); }
    asm volatile("s_waitcnt lgkmcnt(0)" ::: "memory");
#pragma unroll
    for (int i = 0; i < 4; ++i) { const int row = i * 8 + (lane >> 3), ch = lane & 7; const u32x4 v = *(const LAS u32x4*)(stg + row * 64 + ch * 8); *(u32x4*)(pol.o_ptr(wid, row) + ch * 8) = v; } }
  asm volatile("s_waitcnt lgkmcnt(0)\n\ts_barrier" ::: "memory");
#undef ATT_DMAK
#undef ATT_DMAV
}
}

constexpr int NWAVES = 8, NTHREADS = NWAVES * 64;
constexpr int DM = 1024, NTOK = 65536, GTOK = 32768;
constexpr int NEXP = 16, CAP = 4096, FF = 2816;
constexpr int N_IN0 = 2048  , N_UP = 1792, K_UP = 384, N_DIL = 4608;
constexpr float LN_EPS = 1e-5f, RMS_EPS = 1e-6f, DN_ALPHA = 1.4142135623730951f;
constexpr int KSPLIT = 8;

constexpr size_t MiB = 1u << 20;
constexpr size_t WS_CTL = 0, CTL_ZERO_BYTES = 1 * MiB;
constexpr size_t WS_MODP = 1 * MiB;
constexpr size_t WS_MODF = 14 * MiB + 384 * 1024;
constexpr size_t WS_ROPE_R = 6 * MiB;
constexpr size_t WS_ROPE_H = 7 * MiB;
static_assert(13 * MiB + (size_t)N_UP * K_UP * 2 <= WS_MODF && WS_MODF + 4 * 12 * 3072 * 4 <= 15 * MiB, "adaLN table fits behind the up-projection weights");
constexpr size_t WS_WIN0 = 9 * MiB, WS_WUP = 13 * MiB, WS_WOUT0 = 15 * MiB, WS_WDIL = 17 * MiB, WS_WOUT1 = 26 * MiB;
constexpr size_t WS_AFF = 27 * MiB, WS_SLOTOF = 31 * MiB, WS_IDX = 35 * MiB, WS_GATEV = 35 * MiB + 512 * 1024;
constexpr size_t WS_W13 = 36 * MiB, WS_W2 = 212 * MiB, WS_H = 300 * MiB, WS_R = 428 * MiB;
constexpr size_t W13_L1OFF = 88 * MiB, W2_L1OFF = 44 * MiB;
constexpr size_t WS_PROJ = WS_R, WS_A2 = WS_R + 256 * MiB, WS_KPE = WS_R + 304 * MiB, WS_QKV2 = WS_R + 308 * MiB, WS_ATT = WS_R + 532 * MiB, WS_MIX = WS_R;
constexpr size_t WS_HH = WS_R, WS_YE = WS_R + 704 * MiB;
constexpr size_t WS_QKV = WS_R, WS_OG = WS_R + 576 * MiB, WS_LSE = WS_R + 768 * MiB, WS_MRG = WS_R + 774 * MiB;
constexpr size_t WS_END = WS_R + 960 * MiB;
constexpr int CW_BAR = 4096;

constexpr int RING_BYTES = 131072, LDSCTL_OFF = RING_BYTES, MISC_OFF = LDSCTL_OFF + 320, LDS_BYTES = 147456;

typedef unsigned short bf16;
typedef unsigned v4u __attribute__((ext_vector_type(4)));
typedef unsigned v2u __attribute__((ext_vector_type(2)));
typedef unsigned v2u __attribute__((ext_vector_type(2)));
typedef float f32x4 __attribute__((ext_vector_type(4)));
typedef GAS unsigned gu32;
#define RLX_AGENT __ATOMIC_RELAXED, __HIP_MEMORY_SCOPE_AGENT
#define LDS_WAIT() asm volatile("s_waitcnt lgkmcnt(0)" ::: "memory")
__device__ __forceinline__ unsigned f2bf(float f) { return att::cvtpk_s(f, 0.f) & 0xffffu; }
__device__ __forceinline__ unsigned pk2(float lo, float hi) { return att::cvtpk_s(lo, hi); }
__device__ __forceinline__ float bflo(unsigned w) { return __uint_as_float(w << 16); }
__device__ __forceinline__ float bfhi(unsigned w) { return __uint_as_float(w & 0xffff0000u); }

#define XB_TMO      128
#define XB_XCNT(j)  (256  + 64 * (j))
#define XB_XSUB(j)  (1280 + 64 * (j))
#define XB_XGEN(j)  (2304 + 64 * (j))
#define XB_TOP      3328
#define XB_TOPGEN   3392
#define XCD_BAR_WORDS 3456
#define XB_SPIN_CAP (1u << 18)
__device__ __forceinline__ unsigned xb_ld(unsigned* p)              { return __hip_atomic_load(p, __ATOMIC_RELAXED, __HIP_MEMORY_SCOPE_AGENT); }
__device__ __forceinline__ unsigned xb_add(unsigned* p, unsigned v) { return __hip_atomic_fetch_add(p, v, __ATOMIC_RELAXED, __HIP_MEMORY_SCOPE_AGENT); }
__device__ __forceinline__ unsigned xb_xcc_id() { return (unsigned)__builtin_amdgcn_s_getreg((3 << 11) | 20) & 0xFu; }
#define XB_SPIN(cond, bar) do { unsigned _sp = 0; while (cond) { __builtin_amdgcn_s_sleep(1); \
    if ((++_sp & 255u) == 0u) { if (xb_ld(&(bar)[XB_TMO])) break; if (_sp > XB_SPIN_CAP) { atomicAdd(&(bar)[XB_TMO], 1u); break; } } } } while (0)
struct XcdBarrier { unsigned* bar; unsigned x; volatile LAS unsigned* st; };
__device__ __forceinline__ XcdBarrier xcd_barrier_post(unsigned* bar, volatile LAS unsigned* st) {
    XcdBarrier b; b.bar = bar; b.x = xb_xcc_id(); b.st = st;
    if (threadIdx.x == 0) (void)xb_add(&bar[XB_XCNT(b.x)], 1u);
    return b;
}
__device__ __forceinline__ void xcd_barrier_complete(unsigned* bar, unsigned x, unsigned& nloc, unsigned& nx) {
    const unsigned G = gridDim.x * gridDim.y * gridDim.z;
    unsigned sum, cnt, mine, sp = 0u;
    for (;;) {
        sum = 0u; cnt = 0u; mine = 0u;
#pragma unroll
        for (unsigned j = 0; j < 16; ++j) { const unsigned c = xb_ld(&bar[XB_XCNT(j)]); sum += c; cnt += (c > 0u) ? 1u : 0u; mine = (j == x) ? c : mine; }
        if (sum == G) break;
        __builtin_amdgcn_s_sleep(1);
        if ((++sp & 255u) == 0u) { if (xb_ld(&bar[XB_TMO])) break; if (sp > XB_SPIN_CAP) { atomicAdd(&bar[XB_TMO], 1u); break; } }
    }
    nloc = mine > 0u ? mine : 1u; nx = cnt > 0u ? cnt : 1u;
}
__device__ __forceinline__ void xcd_barrier(const XcdBarrier& b, int wv) {
    asm volatile("s_waitcnt vmcnt(0)" ::: "memory");
    __syncthreads();
    if (opaque_tid(wv) == 0) {
        unsigned* bar = b.bar;
        __builtin_amdgcn_s_waitcnt(0);
        unsigned nloc = b.st[0], nx = b.st[1];
        if (nloc == 0u) { xcd_barrier_complete(bar, b.x, nloc, nx); b.st[0] = nloc; b.st[1] = nx; }
        const unsigned old = xb_add(&bar[XB_XSUB(b.x)], 1u);
        const unsigned gen = old / nloc;
        if (old + 1u == (gen + 1u) * nloc) {
            __builtin_amdgcn_fence(__ATOMIC_RELEASE, "agent");
            asm volatile("s_waitcnt vmcnt(0)" ::: "memory");
            const unsigned og = xb_add(&bar[XB_TOP], 1u);
            const unsigned tg = og / nx;
            if (og + 1u == (tg + 1u) * nx) xb_add(&bar[XB_TOPGEN], 1u);
            else XB_SPIN(xb_ld(&bar[XB_TOPGEN]) == tg, bar);
            __builtin_amdgcn_fence(__ATOMIC_ACQUIRE, "agent");
            xb_add(&bar[XB_XGEN(b.x)], 1u);
            asm volatile("s_waitcnt vmcnt(0)" ::: "memory");
        } else {
            XB_SPIN(xb_ld(&bar[XB_XGEN(b.x)]) == gen, bar);
            __builtin_amdgcn_fence(__ATOMIC_ACQUIRE, "agent");
            asm volatile("s_waitcnt vmcnt(0)" ::: "memory");
        }
    }
    __syncthreads();
}

struct Params {
    const float* in[25];
    float* out; unsigned char* ws;
    int ph_lo, ph_hi;
};
typedef const __attribute__((address_space(4))) Params* PP;
__device__ __forceinline__ PP params_ptr() { PP q = (PP)__builtin_amdgcn_kernarg_segment_ptr(); asm volatile("" : "+s"(q)); return q; }
__device__ __forceinline__ int tok_bidx(int t) { return t < GTOK ? (t >> 12) : 8 + ((t - GTOK) >> 13); }
__device__ __forceinline__ int tok_pos(int t) { return t < GTOK ? (t & 4095) : (t & 8191); }
__device__ __forceinline__ const float* x_in_row(PP p, int t) { return t < GTOK ? p->in[0] + (size_t)t * DM : p->in[1] + (size_t)(t - GTOK) * DM; }

template <int CTRL> __device__ __forceinline__ float dpp_f(float v) { return __int_as_float(__builtin_amdgcn_update_dpp(0, __float_as_int(v), CTRL, 0xf, 0xf, true)); }
template <int CTRL> __device__ __forceinline__ int dpp_i(int v) { return __builtin_amdgcn_update_dpp(0, v, CTRL, 0xf, 0xf, true); }
__device__ __forceinline__ float wave_sum(float v) {
    v += dpp_f<0xB1>(v); v += dpp_f<0x4E>(v); v += dpp_f<0x141>(v); v += dpp_f<0x140>(v);
    { auto rr = __builtin_amdgcn_permlane16_swap(__float_as_uint(v), __float_as_uint(v), false, false); v = __uint_as_float(rr[0]) + __uint_as_float(rr[1]); }
    { auto rr = __builtin_amdgcn_permlane32_swap(__float_as_uint(v), __float_as_uint(v), false, false); v = __uint_as_float(rr[0]) + __uint_as_float(rr[1]); }
    return v;
}
__device__ __forceinline__ int wave_sum_i(int v) {
    v += dpp_i<0xB1>(v); v += dpp_i<0x4E>(v); v += dpp_i<0x141>(v); v += dpp_i<0x140>(v);
    { auto rr = __builtin_amdgcn_permlane16_swap((unsigned)v, (unsigned)v, false, false); v = (int)(rr[0] + rr[1]); }
    { auto rr = __builtin_amdgcn_permlane32_swap((unsigned)v, (unsigned)v, false, false); v = (int)(rr[0] + rr[1]); }
    return v;
}

__device__ const float INV_R[16] = {1.0f, 0.562341332f, 0.316227764f, 0.177827939f, 0.100000001f, 0.0562341325f, 0.0316227749f, 0.0177827943f, 0.00999999978f, 0.00562341325f, 0.00316227763f, 0.00177827943f, 0.00100000005f, 0.000562341302f, 0.000316227757f, 0.00017782794f};
__device__ const float INV_H[32] = {1.0f, 0.749894202f, 0.562341332f, 0.421696514f, 0.316227764f, 0.237137377f, 0.177827939f, 0.133352146f, 0.100000001f, 0.0749894232f, 0.0562341325f, 0.0421696492f, 0.0316227749f, 0.0237137377f, 0.0177827943f, 0.013335214f, 0.00999999978f, 0.00749894232f, 0.00562341325f, 0.00421696482f, 0.00316227763f, 0.00237137382f, 0.00177827943f, 0.00133352145f, 0.00100000005f, 0.000749894185f, 0.000562341302f, 0.000421696517f, 0.000316227757f, 0.00023713737f, 0.00017782794f, 0.00013335215f};
__device__ __forceinline__ void cvt_item(const float* __restrict__ W, int ldw, int k0, int n0, bf16* WT, size_t ldk, size_t wt0, LAS float* scr, int lane, int rs = 1) {
#pragma unroll 8
    for (int i = 0; i < 32; ++i) { const int kk = 2 * i + (lane >> 5); scr[kk * 33 + (lane & 31)] = W[(size_t)(k0 + kk) * ldw + n0 + (lane & 31)]; }
    LDS_WAIT(); asm volatile("" ::: "memory");
    const int c = lane & 7;
#pragma unroll
    for (int j = 0; j < 4; ++j) { const int n = (lane >> 3) + 8 * j; const LAS float* s = scr + (8 * c) * 33 + n;
        v4u o; o.x = pk2(s[0 * 33], s[1 * 33]); o.y = pk2(s[2 * 33], s[3 * 33]); o.z = pk2(s[4 * 33], s[5 * 33]); o.w = pk2(s[6 * 33], s[7 * 33]);
        *(GAS v4u*)(WT + wt0 + (size_t)(n * rs) * ldk + 8 * c) = o; }
    LDS_WAIT(); asm volatile("" ::: "memory");
}
constexpr float W13_QS = 64.0f, W2_QS = 256.0f, YE_QS = 16.0f;
struct CvtTile { const float* W; int ldw, k0, n0; unsigned char* WT; size_t ldkb; size_t off0; float sc; bool f8; };
__device__ __forceinline__ void cvt_tile_load(const CvtTile& T, int lane, f32x4 (&w)[16]) {
    const float* src = T.W + (size_t)(T.k0 + 16 * (lane >> 4)) * T.ldw + T.n0 + 4 * (lane & 15);
#pragma unroll
    for (int i = 0; i < 16; ++i) w[i] = *(const GAS f32x4*)(src + (size_t)i * T.ldw);
}
template <bool F8> __device__ __forceinline__ void cvt_tile_store(const CvtTile& T, int lane, const f32x4 (&w)[16]) {
    const int q = lane >> 4, c = lane & 15;
#pragma unroll
    for (int j = 0; j < 4; ++j) { unsigned char* dst = T.WT + T.off0 + (size_t)(4 * c + j) * T.ldkb + (F8 ? 16 : 32) * q;
        if constexpr (F8) { v4u o; o.x = pg8::pk4_fp8(w[0][j] * T.sc, w[1][j] * T.sc, w[2][j] * T.sc, w[3][j] * T.sc); o.y = pg8::pk4_fp8(w[4][j] * T.sc, w[5][j] * T.sc, w[6][j] * T.sc, w[7][j] * T.sc);
            o.z = pg8::pk4_fp8(w[8][j] * T.sc, w[9][j] * T.sc, w[10][j] * T.sc, w[11][j] * T.sc); o.w = pg8::pk4_fp8(w[12][j] * T.sc, w[13][j] * T.sc, w[14][j] * T.sc, w[15][j] * T.sc); *(GAS v4u*)dst = o; }
        else { v4u o0, o1; o0.x = pk2(w[0][j], w[1][j]); o0.y = pk2(w[2][j], w[3][j]); o0.z = pk2(w[4][j], w[5][j]); o0.w = pk2(w[6][j], w[7][j]);
            o1.x = pk2(w[8][j], w[9][j]); o1.y = pk2(w[10][j], w[11][j]); o1.z = pk2(w[12][j], w[13][j]); o1.w = pk2(w[14][j], w[15][j]); *(GAS v4u*)dst = o0; *(GAS v4u*)(dst + 16) = o1; } }
}
__device__ __forceinline__ void cvt_tile_store_any(const CvtTile& T, int lane, const f32x4 (&w)[16]) { if (T.f8) cvt_tile_store<true>(T, lane, w); else cvt_tile_store<false>(T, lane, w); }
constexpr int MOE_TILES = NEXP * 2112;
__device__ __forceinline__ CvtTile moe_tile(PP p, int layer, int it, int ES) {
    CvtTile T; const int e = it / 2112, r = it % 2112, which = r / 704, q = r % 704;
    if (which < 2) { const int kb = q / 44, nb = q % 44; T.k0 = kb * 64; T.n0 = nb * 64; T.W = p->in[22 + which] + ((size_t)layer * NEXP + e) * (size_t)DM * FF; T.ldw = FF;
        const size_t row0 = (size_t)e * 5632 + (size_t)(T.n0 >> 7) * 256 + which * 128 + (T.n0 & 127);
        T.WT = p->ws + WS_W13 + (layer ? W13_L1OFF : 0); T.ldkb = (size_t)DM * ES; T.off0 = (row0 * DM + T.k0) * ES; T.sc = W13_QS; T.f8 = ES == 1;
    } else { const int kb = q / 16, nb = q % 16; T.k0 = kb * 64; T.n0 = nb * 64; T.W = p->in[24] + ((size_t)layer * NEXP + e) * (size_t)FF * DM; T.ldw = DM;
        T.WT = p->ws + WS_W2 + (layer ? W2_L1OFF : 0); T.ldkb = (size_t)FF; T.off0 = ((size_t)e * DM + T.n0) * FF + T.k0; T.sc = W2_QS; T.f8 = true; }
    return T;
}

__device__ __forceinline__ void p0_prologue(PP p, LAS unsigned char* lds, int vcu, int G, int tid, int lane, int wave) {
    LAS float* scr = (LAS float*)(lds + wave * 8448);
    LAS float* sc = (LAS float*)(lds + 69632);
    for (int i = tid; i < 12 * DM; i += NTHREADS) { const int b = i >> 10, k = i & 1023; const float c = b < 8 ? p->in[2][b * DM + k] : p->in[3][(b - 8) * DM + k];
        sc[i] = c / (1.0f + __expf(-c)); }
    __syncthreads();
    const int gw = vcu * NWAVES + wave, NGW = G * NWAVES;
    for (int it = gw; it < 4 * 48 * KSPLIT; it += NGW) {
        const int kc = it % KSPLIT, jb = (it / KSPLIT) % 48, mi = it / (KSPLIT * 48);
        const float* W = (mi & 1 ? p->in[17] : p->in[13]) + (size_t)(mi >> 1) * DM * 3072 + jb * 64 + lane;
        float acc[12];
#pragma unroll
        for (int b = 0; b < 12; ++b) acc[b] = 0.f;
        for (int k0 = kc * 128; k0 < kc * 128 + 128; k0 += 8) {
            float w[8];
#pragma unroll
            for (int i = 0; i < 8; ++i) w[i] = W[(size_t)(k0 + i) * 3072];
#pragma unroll
            for (int b = 0; b < 12; ++b) { const f32x4 s0 = *(const LAS f32x4*)(sc + b * DM + k0), s1 = *(const LAS f32x4*)(sc + b * DM + k0 + 4);
                acc[b] += w[0] * s0[0] + w[1] * s0[1] + w[2] * s0[2] + w[3] * s0[3] + w[4] * s1[0] + w[5] * s1[1] + w[6] * s1[2] + w[7] * s1[3]; }
        }
        float* o = (float*)(p->ws + WS_MODP) + ((size_t)(kc * 4 + mi) * 12) * 3072 + jb * 64 + lane;
#pragma unroll
        for (int b = 0; b < 12; ++b) o[(size_t)b * 3072] = acc[b];
    }
    for (int i = gw * 64 + lane; i < 8192 * 48; i += NGW * 64) {
        const int pos = i / 48, j = i % 48; const float inv = j < 16 ? INV_R[j] : INV_H[j - 16];
        const float ang = (float)pos * inv; double rev = (double)ang * 0.15915494309189535; rev -= floor(rev);
        const float rf = (float)rev; float2 cs; cs.x = __builtin_amdgcn_cosf(rf); cs.y = __builtin_amdgcn_sinf(rf);
        if (j < 16) ((float2*)(p->ws + WS_ROPE_R))[pos * 16 + j] = cs; else ((float2*)(p->ws + WS_ROPE_H))[pos * 32 + (j - 16)] = cs;
    }
    { const v4u z = {0u, 0u, 0u, 0u};
      for (int i = gw * 64 + lane; i < 12288 + 12288 + 32768; i += NGW * 64) {
        if (i < 12288) ((GAS v4u*)(p->ws + WS_WIN0 + (size_t)1952 * DM * 2))[i] = z;
        else if (i < 24576) { const int q = i - 12288, row = q >> 4, c = q & 15; *(GAS v4u*)(p->ws + WS_WUP + ((size_t)row * K_UP + 256) * 2 + c * 16) = z; }
        else { const int q = i - 24576, row = 768 + (q >> 5), c = q & 31; *(GAS v4u*)(p->ws + WS_WUP + (size_t)row * K_UP * 2 + c * 16) = z; } } }
    constexpr int I0 = 16 * 61, I1 = 4 * 24, I2 = 2 * 32, I3 = 16 * 32, I4 = 16 * 144, I5 = 8 * 32;
    for (int it = gw; it < I0 + I1 + I2 + I3 + I4 + I5; it += NGW) {
        int r = it;
        if (r < I0) { const int kb = r / 61, nb = r % 61; cvt_item(p->in[4], 1952, kb * 64, nb * 32, (bf16*)(p->ws + WS_WIN0), DM, (size_t)nb * 32 * DM + kb * 64, scr, lane); continue; } r -= I0;
        if (r < I1) { const int kb = r / 24, nb = r % 24; cvt_item(p->in[7], 768, kb * 64, nb * 32, (bf16*)(p->ws + WS_WUP), K_UP, (size_t)nb * 32 * K_UP + kb * 64, scr, lane); continue; } r -= I1;
        if (r < I2) { const int kb = r / 32, nb = r % 32; cvt_item(p->in[9], 1024, kb * 64, nb * 32, (bf16*)(p->ws + WS_WUP), K_UP, (size_t)(768 + nb * 32) * K_UP + 256 + kb * 64, scr, lane); continue; } r -= I2;
        if (r < I3) { const int kb = r / 32, nb = r % 32; cvt_item(p->in[10], 1024, kb * 64, nb * 32, (bf16*)(p->ws + WS_WOUT0), DM, (size_t)nb * 32 * DM + kb * 64, scr, lane); continue; } r -= I3;
        if (r < I4) { const int kb = r / 144, nb = r % 144, c0 = nb * 32;
            const bool qk = (c0 % 1536) < 1024; const int row0 = qk ? (c0 & ~63) + ((c0 >> 5) & 1) : c0;
            cvt_item(p->in[11], N_DIL, kb * 64, c0, (bf16*)(p->ws + WS_WDIL), DM, (size_t)row0 * DM + kb * 64, scr, lane, qk ? 2 : 1); continue; } r -= I4;
        { const int kb = r / 32, nb = r % 32; cvt_item(p->in[12], 1024, kb * 64, nb * 32, (bf16*)(p->ws + WS_WOUT1), 512, (size_t)nb * 32 * 512 + kb * 64, scr, lane); }
    }
}

__device__ __forceinline__ float mod_reduce(PP p, int mi, int b, int j) {
    float s = (mi & 1 ? p->in[18] : p->in[14])[(size_t)(mi >> 1) * 3072 + j];
    const float* mp = (const float*)(p->ws + WS_MODP) + ((size_t)mi * 12 + b) * 3072 + j;
#pragma unroll
    for (int kc = 0; kc < KSPLIT; ++kc) s += mp[(size_t)kc * 4 * 12 * 3072];
    return s;
}
template <bool FINAL> __device__ __forceinline__ void load_mod_vec(PP p, LAS float* dst, int mi, int b, int part, int tid) {
    if constexpr (FINAL) { const float* mf = (const float*)(p->ws + WS_MODF) + ((size_t)mi * 12 + b) * 3072 + part * DM; for (int j = tid; j < DM; j += NTHREADS) dst[j] = mf[j]; }
    else { for (int j = tid; j < DM; j += NTHREADS) dst[j] = mod_reduce(p, mi, b, part * DM + j); }
}
__device__ __forceinline__ void store_row_bf16(bf16* orow, const f32x4 (&v)[4], int lane) {
    GAS unsigned long long* o8 = (GAS unsigned long long*)orow + lane;
#pragma unroll
    for (int j = 0; j < 4; ++j) o8[64 * j] = (unsigned long long)pk2(v[j].x, v[j].y) | ((unsigned long long)pk2(v[j].z, v[j].w) << 32);
}

__device__ __forceinline__ void p1_modulate(PP p, LAS unsigned char* lds, int vcu, int G, int tid, int lane, int wave) {
    LAS float* vsh = (LAS float*)lds; LAS float* vsc = vsh + DM;
    for (int i = vcu * NTHREADS + tid; i < 4 * 12 * 3072; i += G * NTHREADS) ((float*)(p->ws + WS_MODF))[i] = mod_reduce(p, i / (12 * 3072), (i / 3072) % 12, i % 3072);
    for (int ch = vcu; ch < NTOK / 256; ch += G) {
        const int t0 = ch * 256, b = tok_bidx(t0);
        __syncthreads();
        load_mod_vec<false>(p, vsh, 0, b, 0, tid); load_mod_vec<false>(p, vsc, 0, b, 1, tid);
        __syncthreads();
        _Pragma("unroll 1") for (int i = 0; i < 32; ++i) { const int t = t0 + wave * 32 + i;
            const GAS f32x4* xr = (const GAS f32x4*)x_in_row(p, t) + lane; f32x4 v[4];
#pragma unroll
            for (int j = 0; j < 4; ++j) { const f32x4 x = xr[64 * j]; const f32x4 sh = *(const LAS f32x4*)(vsh + 4 * lane + 256 * j), sc = *(const LAS f32x4*)(vsc + 4 * lane + 256 * j); v[j] = x * (1.0f + sc) + sh; }
            store_row_bf16((bf16*)(p->ws + WS_H) + (size_t)t * DM, v, lane); }
    }
}

__device__ __forceinline__ void p3_mla_prep(PP p, int vcu, int G, int lane, int wave) {
    const int gw = vcu * NWAVES + wave, NGW = G * NWAVES;
    const bf16* proj = (const bf16*)(p->ws + WS_PROJ); bf16* a2 = (bf16*)(p->ws + WS_A2); bf16* kpe = (bf16*)(p->ws + WS_KPE);
    const f32x4 qn = *((const f32x4*)p->in[6] + lane); const float2 kn = *((const float2*)p->in[8] + lane);
    for (int t = gw; t < NTOK; t += NGW) {
        const bf16* row = proj + (size_t)t * N_IN0;
        const v2u ql = *(const v2u*)(row + 1536 + 4 * lane); const unsigned kl = *(const unsigned*)(row + 1792 + 2 * lane);
        const float q0 = bflo(ql.x), q1 = bfhi(ql.x), q2 = bflo(ql.y), q3 = bfhi(ql.y), k0 = bflo(kl), k1 = bfhi(kl);
        const float qs = wave_sum(q0 * q0 + q1 * q1 + q2 * q2 + q3 * q3), ks = wave_sum(k0 * k0 + k1 * k1);
        const float qr = 1.0f / sqrtf(qs * (1.0f / 256.0f) + RMS_EPS), kr = 1.0f / sqrtf(ks * (1.0f / 128.0f) + RMS_EPS);
        v2u qo; qo.x = pk2(q0 * qr * qn.x, q1 * qr * qn.y); qo.y = pk2(q2 * qr * qn.z, q3 * qr * qn.w);
        *(v2u*)(a2 + (size_t)t * K_UP + 4 * lane) = qo;
        *(unsigned*)(a2 + (size_t)t * K_UP + 256 + 2 * lane) = pk2(k0 * kr * kn.x, k1 * kr * kn.y);
        if (lane < 16) { const float x1 = bflo((unsigned)row[1920 + lane]), x2 = bflo((unsigned)row[1936 + lane]);
            const float2 cs = ((const float2*)(p->ws + WS_ROPE_R))[tok_pos(t) * 16 + lane];
            kpe[(size_t)t * 32 + lane] = (bf16)f2bf(x1 * cs.x - x2 * cs.y); kpe[(size_t)t * 32 + 16 + lane] = (bf16)f2bf(x1 * cs.y + x2 * cs.x); }
    }
}

__device__ __forceinline__ int moe1_split(int G) { return G >= 4 * NEXP ? MOE_TILES / 2 : MOE_TILES; }
__device__ __forceinline__ int moe1_split2(int G) { return G >= 4 * NEXP ? MOE_TILES - MOE_TILES / 4 : MOE_TILES; }
struct NoRider { static constexpr int NW = 1; __device__ __forceinline__ void begin(int, f32x4 (&)[1]) {} __device__ __forceinline__ int mid(int, int, int, f32x4 (&)[1]) { return 0; } __device__ __forceinline__ void end(int, f32x4 (&)[1]) {} };
template <bool F8> struct CvtRider {
    static constexpr int NW = 16;
    PP p; int layer, layer_b, ka, kb; CvtTile T; bool live;
    __device__ __forceinline__ void init(PP p_, int layer_, int ka_, int kb_, int layer_b_ = -1) { p = p_; layer = layer_; layer_b = layer_b_ < 0 ? layer_ : layer_b_; ka = ka_; kb = kb_; live = false; }
    __device__ __forceinline__ void begin(int lane, f32x4 (&w)[16]) { if (ka >= 0) { T = moe_tile(p, layer, ka, F8 ? 1 : 2); cvt_tile_load(T, lane, w); live = true; } }
    __device__ __forceinline__ int mid(int t, int NT, int lane, f32x4 (&w)[16]) { if (t == (NT >> 1) && kb >= 0) { int n = 16; if (live) { cvt_tile_store_any(T, lane, w); n += T.f8 ? 4 : 8; } T = moe_tile(p, layer_b, kb, F8 ? 1 : 2); cvt_tile_load(T, lane, w); live = true; return n; } return 0; }
    __device__ __forceinline__ void end(int lane, f32x4 (&w)[16]) { if (live) { cvt_tile_store_any(T, lane, w); live = false; } }
};
struct CvtStream {
    static constexpr int NW = 4;
    PP p; int ka, kb, nb; CvtTile T; bool live;
    __device__ __forceinline__ void init(PP p_, int ka_, int kb_) { p = p_; ka = ka_; kb = kb_; nb = 0; live = false; }
    __device__ __forceinline__ void begin(int, f32x4 (&)[4]) {}
    __device__ __forceinline__ void store(int lane, const f32x4 (&w)[4]) { const int r = lane >> 2, c4 = lane & 3, q4 = (nb - 1) & 3;
#pragma unroll
        for (int j = 0; j < 4; ++j) { unsigned char* dst = T.WT + T.off0 + (size_t)(16 * q4 + 4 * c4 + j) * T.ldkb;
            if (T.f8) *(GAS unsigned*)(dst + 4 * r) = pg8::pk4_fp8(w[0][j] * T.sc, w[1][j] * T.sc, w[2][j] * T.sc, w[3][j] * T.sc);
            else { v2u o; o.x = pk2(w[0][j], w[1][j]); o.y = pk2(w[2][j], w[3][j]); *(GAS v2u*)(dst + 8 * r) = o; } }
        live = false; }
    __device__ __forceinline__ bool pre(int s, int lane, f32x4 (&w)[4]) { if ((s & 3) != 0) return false; if (live) store(lane, w); return (nb < 4 ? ka : (nb < 8 ? kb : -1)) >= 0; }
    __device__ __forceinline__ void post(int lane, f32x4 (&w)[4]) { if ((nb & 3) == 0) T = moe_tile(p, 0, nb < 4 ? ka : kb, 1);
        const float* src = T.W + (size_t)(T.k0 + 4 * (lane >> 2)) * T.ldw + T.n0 + 16 * (nb & 3) + 4 * (lane & 3);
#pragma unroll
        for (int i = 0; i < 4; ++i) w[i] = *(const GAS f32x4*)(src + (size_t)i * T.ldw);
        ++nb; live = true; }
    __device__ __forceinline__ void end(int lane, f32x4 (&w)[4]) { if (live) store(lane, w); }
};
__device__ __forceinline__ void decode_unit(int r, int& S, int& tok0, int& h, int& within) {
    if (r < 1024) { const int bh = r >> 4; within = r & 15; S = 4096; tok0 = (bh >> 3) * 4096; h = bh & 7; }
    else { const int r2 = r - 1024, bh = r2 >> 5; within = r2 & 31; S = 8192; tok0 = GTOK + (bh >> 3) * 8192; h = bh & 7; }
}
__device__ __forceinline__ int clampi(int v, int lo, int hi) { return v < lo ? lo : (v > hi ? hi : v); }
using att::bf16x8; using att::f32x16;
__device__ __forceinline__ void rope8(bf16x8& a, bf16x8& b, const float2* cs) {
#pragma unroll
    for (int j = 0; j < 8; ++j) { const float x1 = att::bf2f(a[j]), x2 = att::bf2f(b[j]); const float2 c = cs[j];
        a[j] = (short)f2bf(x1 * c.x - x2 * c.y); b[j] = (short)f2bf(x1 * c.y + x2 * c.x); }
}

struct PolNA {
    static constexpr int NLSE = 0; static constexpr int ND0 = 4; static constexpr bool FUSED = false; static constexpr float SC = 1.0f;
    __device__ __forceinline__ void mask(f32x16&, f32x16&, int, int, int, int) const {}
    const att::bf16* proj; att::bf16* out; const LAS float* tab; int tok0, h, R4, rows, kr_lo, nt;
    __device__ __forceinline__ void init(int r, const unsigned char* ws, const LAS float* tab_all) {
        int S, within; decode_unit(r, S, tok0, h, within); R4 = within; rows = S >> 6;
        kr_lo = clampi(4 * R4 - 4, 0, rows - 8); nt = clampi(4 * R4 - 1, 0, rows - 8) + 8 - kr_lo;
        proj = (const att::bf16*)(ws + WS_PROJ); out = (att::bf16*)(ws + WS_ATT); tab = tab_all + h * 465; }
    __device__ __forceinline__ int ntiles() const { return nt; }
    __device__ __forceinline__ const att::bf16* q_ptr(int wid, int r32) const { return proj + (size_t)(tok0 + (4 * R4 + (wid >> 1)) * 64 + (wid & 1) * 32 + r32) * N_IN0 + h * 64; }
    __device__ __forceinline__ void q_fix(bf16x8 (&)[ND0], int, int, int) const {}
    __device__ __forceinline__ const void* k_src(int t, int wid, int lane) const { return proj + (size_t)(tok0 + (kr_lo + t) * 64 + lane) * N_IN0 + 512 + h * 64 + wid * 8; }
    __device__ __forceinline__ const void* k2_src(int, int, int) const { return nullptr; }
    __device__ __forceinline__ const void* v_src(int t, int wid, int lane) const { return proj + (size_t)(tok0 + (kr_lo + t) * 64 + 16 * (wid & 3) + (lane >> 2)) * N_IN0 + 1024 + h * 64 + (wid >> 2) * 32 + (lane & 3) * 8; }
    __device__ __forceinline__ bool needs(int t, int wid) const { const int r = 4 * R4 + (wid >> 1), r0 = clampi(r - 4, 0, rows - 8), kr = kr_lo + t; return kr >= r0 && kr < r0 + 8; }
    __device__ __forceinline__ bool variant(int wid) const { return (wid & 1) != 0; }
    static constexpr __device__ bool dead(int var, int half, int i) { return var == 0 ? (half == 1 && i >= 4) : (half == 0 && i < 12); }
    static constexpr __device__ int live4(int var) { return var == 0 ? 0 : 12; }
    static constexpr __device__ int kslo(int var) { return var == 0 ? 0 : 1; }
    static constexpr __device__ int kshi(int var) { return var == 0 ? 3 : 4; }
    template <int VAR> __device__ __forceinline__ void transform_v(f32x16& p0, f32x16& p1, int t, int wid, int r32, int hi) const {
        const int r = 4 * R4 + (wid >> 1), qc = (wid & 1) * 32 + r32, c0 = clampi(qc - 8, 0, 48);
        const LAS float* trow = tab + (kr_lo + t - r + 7) * 31 + (15 - qc);
        const LAS float* th = trow + 4 * hi; const unsigned u0 = (unsigned)(4 * hi - c0);
#pragma unroll
        for (int i = 0; i < 16; ++i) { const int kq = (i & 3) + 8 * (i >> 2);
            if (!dead(VAR, 0, i)) { const float b_ = th[kq]; const float f_ = __builtin_fmaf(p0[i], 0.125f * att::LOG2E, b_); p0[i] = (u0 + (unsigned)kq < 16u) ? f_ : -INFINITY; }
            if (!dead(VAR, 1, i)) { const float b_ = th[kq + 32]; const float f_ = __builtin_fmaf(p1[i], 0.125f * att::LOG2E, b_); p1[i] = (u0 + (unsigned)(kq + 32) < 16u) ? f_ : -INFINITY; } }
    }
    __device__ __forceinline__ att::bf16* o_ptr(int wid, int row) const { return out + (size_t)(tok0 + (4 * R4 + (wid >> 1)) * 64 + (wid & 1) * 32 + row) * DM + h * 64; }
    __device__ __forceinline__ void lse_out(int, int, float) const {}
};
struct PolMLA {
    static constexpr int NLSE = 0; static constexpr int ND0 = 6; static constexpr bool FUSED = true; static constexpr float SC = 0.10206207261596577f * att::LOG2E;
    __device__ __forceinline__ void mask(f32x16&, f32x16&, int, int, int, int) const {}
    const att::bf16* qkv2; const att::bf16* kpe; att::bf16* out; const float2* rope; int tok0, h, qt, S;
    __device__ __forceinline__ void init(int r, const unsigned char* ws) { int within; decode_unit(r, S, tok0, h, within); qt = within;
        qkv2 = (const att::bf16*)(ws + WS_QKV2); kpe = (const att::bf16*)(ws + WS_KPE); out = (att::bf16*)(ws + WS_ATT); rope = (const float2*)(ws + WS_ROPE_R); }
    __device__ __forceinline__ int ntiles() const { return S >> 6; }
    __device__ __forceinline__ const att::bf16* q_ptr(int wid, int r32) const { return qkv2 + (size_t)(tok0 + qt * 256 + wid * 32 + r32) * N_UP + h * 96; }
    __device__ __forceinline__ void q_fix(bf16x8 (&qr)[ND0], int wid, int r32, int hi) const { rope8(qr[4], qr[5], rope + (size_t)(qt * 256 + wid * 32 + r32) * 16 + 8 * hi); }
    __device__ __forceinline__ const void* k_src(int t, int wid, int lane) const { return qkv2 + (size_t)(tok0 + t * 64 + lane) * N_UP + 768 + h * 128 + wid * 8; }
    static constexpr int KSTRIDE = 64 * N_UP * 2, K2STRIDE = 64 * 32 * 2;
    __device__ __forceinline__ const unsigned char* k_base() const { return (const unsigned char*)(qkv2 + (size_t)tok0 * N_UP + 768 + h * 128); }
    __device__ __forceinline__ const unsigned char* k2_base() const { return (const unsigned char*)(kpe + (size_t)tok0 * 32); }
    static __device__ __forceinline__ unsigned k_lofs(int wid, int lane) { return (unsigned)(lane * N_UP + wid * 8) * 2u; }
    static __device__ __forceinline__ unsigned k2_lofs(int wid, int lane) { return (unsigned)(lane * 32 + wid * 8) * 2u; }
    static __device__ __forceinline__ unsigned v_lofs(int wid, int lane) { return (unsigned)((16 * (wid & 3) + (lane >> 2)) * N_UP + 64 + (wid >> 2) * 32 + (lane & 3) * 8) * 2u; }
    __device__ __forceinline__ const void* k2_src(int t, int wid, int lane) const { return kpe + (size_t)(tok0 + t * 64 + lane) * 32 + wid * 8; }
    __device__ __forceinline__ const void* v_src(int t, int wid, int lane) const { return qkv2 + (size_t)(tok0 + t * 64 + 16 * (wid & 3) + (lane >> 2)) * N_UP + 768 + h * 128 + 64 + (wid >> 2) * 32 + (lane & 3) * 8; }
    __device__ __forceinline__ bool needs(int, int) const { return true; }
    __device__ __forceinline__ void transform(f32x16&, f32x16&, int, int, int, int) const {}
    __device__ __forceinline__ att::bf16* o_ptr(int wid, int row) const { return out + (size_t)(tok0 + qt * 256 + wid * 32 + row) * DM + 512 + h * 64; }
    __device__ __forceinline__ void lse_out(int, int, float) const {}
};
struct PolDil {
    static constexpr int NLSE = 1;   static constexpr int ND0 = 4; static constexpr bool FUSED = true; static constexpr float SC = 0.125f * att::LOG2E;
    const att::bf16* qkv; att::bf16* og; float* lse; const float2* rope; int gi, d, tok0, h, rho, blk, ks, t_lo, nt, rbase;
    __device__ __forceinline__ void init(int r, int gi_, const unsigned char* ws) { int S, within; decode_unit(r, S, tok0, h, within); gi = gi_; d = 1 << (2 * gi);
        const int Ssub = S / d, nblk = Ssub >> 8; rho = within / nblk; blk = within % nblk; ks = 256 * blk - 64; t_lo = ks < 0 ? 1 : 0; rbase = tok0 + rho * Ssub;
        int t_hi = (Ssub - ks) >> 6; if (t_hi > 6) t_hi = 6; nt = t_hi - t_lo;
        qkv = (const att::bf16*)(ws + WS_QKV); og = (att::bf16*)(ws + WS_OG) + (size_t)gi * NTOK * 512; lse = (float*)(ws + WS_LSE) + (size_t)gi * NTOK * 8; rope = (const float2*)(ws + WS_ROPE_H); }
    __device__ __forceinline__ int ntiles() const { return nt; }
    __device__ __forceinline__ int qtok(int wid, int row) const { return tok0 + (256 * blk + 32 * wid + row) * d + rho; }
    __device__ __forceinline__ const att::bf16* q_ptr(int wid, int r32) const { return qkv + (size_t)(rbase + 256 * blk + 32 * wid + r32) * N_DIL + gi * 1536 + h * 64; }
    __device__ __forceinline__ void q_fix(bf16x8 (&)[ND0], int, int, int) const {}
    __device__ __forceinline__ const void* k_src(int t, int wid, int lane) const { return qkv + (size_t)(rbase + ks + 64 * (t + t_lo) + lane) * N_DIL + gi * 1536 + 512 + h * 64 + wid * 8; }
    __device__ __forceinline__ const void* k2_src(int, int, int) const { return nullptr; }
    __device__ __forceinline__ const void* v_src(int t, int wid, int lane) const { return qkv + (size_t)(rbase + ks + 64 * (t + t_lo) + 16 * (wid & 3) + (lane >> 2)) * N_DIL + gi * 1536 + 1024 + h * 64 + (wid >> 2) * 32 + (lane & 3) * 8; }
    __device__ __forceinline__ bool needs(int t, int wid) const { const int kt0 = ks + 64 * (t + t_lo), q0 = 256 * blk + 32 * wid; return kt0 + 63 >= q0 - 64 && kt0 <= q0 + 95; }
    __device__ __forceinline__ void transform(f32x16&, f32x16&, int, int, int, int) const {}
    __device__ __forceinline__ void mask(f32x16& p0, f32x16& p1, int t, int wid, int r32, int hi) const {
        const int rel0 = ks + 64 * (t + t_lo) - (256 * blk + 32 * wid);
        if (rel0 == 0 || rel0 == -32) return;
        const unsigned base = (unsigned)(rel0 - r32 + 64 + 4 * hi);
#pragma unroll
        for (int i = 0; i < 16; ++i) { const unsigned c = (unsigned)((i & 3) + 8 * (i >> 2));
            p0[i] = (base + c <= 128u) ? p0[i] : -INFINITY; p1[i] = (base + c + 32u <= 128u) ? p1[i] : -INFINITY; }
    }
    __device__ __forceinline__ att::bf16* o_ptr(int wid, int row) const { return og + (size_t)qtok(wid, row) * 512 + h * 64; }
    __device__ __forceinline__ void lse_out(int wid, int r32, float v) const { lse[(size_t)qtok(wid, r32) * 8 + h] = v; }
};


constexpr int DS_SLOT = 32768, DS_KB = 16384, DS_OST = 3 * DS_SLOT;
static_assert(DS_OST + 8 * 4096 <= RING_BYTES, "dilated attention LDS");
__device__ __forceinline__ void dil_unit_init(PolDil& P_, int n, int NU, int vcu, int G, const unsigned char* ws) {
    const bool ok = n >= 0 && n < NU; const int u = ok ? vcu + n * G : vcu;
    P_.init(u & 2047, u >> 11, ws); if (!ok) P_.nt = 0;
}
__device__ __forceinline__ void dil_skew(int wv, PP p, LAS unsigned char* shm, int vcu, int G) {
    using namespace att;
    const unsigned char* ws = p->ws;
    const int tid = opaque_tid(wv), lane = tid & 63, r32 = lane & 31, hi = lane >> 5; const int wid = __builtin_amdgcn_readfirstlane(tid >> 6);
    const int j = wid >> 1;
    const unsigned lds0 = (unsigned)(uintptr_t)shm;
    LAS float* wsf = (LAS float*)(shm + DS_OST + wid * 4096);
    int NU = 0; for (int u = vcu; u < 3 * 2048; u += G) ++NU;
    PolDil pPrev, pCur, pNext; dil_unit_init(pPrev, -1, NU, vcu, G, ws); dil_unit_init(pCur, 0, NU, vcu, G, ws); dil_unit_init(pNext, 1, NU, vcu, G, ws);
#define DS_DMA(PL, i, sl) do { int t_ = (i) - (PL).t_lo; const int tm_ = (PL).nt > 0 ? (PL).nt - 1 : 0; t_ = t_ < 0 ? 0 : (t_ > tm_ ? tm_ : t_); \
      const unsigned b_ = (unsigned)__builtin_amdgcn_readfirstlane(lds0 + (sl) * DS_SLOT + ((i) >= 3 ? DS_KB : 0) + wid * 1024); \
      glds16((PL).k_src(t_, wid, lane), b_); glds16((PL).v_src(t_, wid, lane), b_ + 8192u); } while (0)
    bf16x8 qr[4], qn[4];
    { const bf16* qp = pCur.q_ptr(wid, r32);
#pragma unroll
      for (int d0 = 0; d0 < 4; ++d0) qr[d0] = *reinterpret_cast<const bf16x8*>(qp + d0 * 16 + hi * 8); }
#pragma unroll
    for (int d0 = 0; d0 < 4; ++d0) qn[d0] = qr[d0];
    DS_DMA(pCur, 0, 0); DS_DMA(pPrev, 3, 0); DS_DMA(pCur, 1, 1); DS_DMA(pPrev, 4, 1);
    float m = -1e30f, lsum = 0.f; f32x16 o[2]; o[0] = f32x16{}; o[1] = f32x16{};
    const int vlane = ((lane >> 4) & 1) * 32 + (lane & 3) * 8 + (4 * hi + ((lane & 15) >> 2)) * 64;
    ATT_WAIT_BAR(4);
    int s_cur = 0, x_prev = 0;
#define DS_STEP(r) do { \
    { const int sl2 = s_cur >= 1 ? s_cur - 1 : 2; \
      if ((r) == 0) { DS_DMA(pCur, 2, sl2); DS_DMA(pPrev, 5, sl2); } else if ((r) == 1) { DS_DMA(pNext, 0, sl2); DS_DMA(pCur, 3, sl2); } else { DS_DMA(pNext, 1, sl2); DS_DMA(pCur, 4, sl2); } } \
    const bool inA = j <= (r); const PolDil own = inA ? pCur : pPrev; const int i = inA ? (r) : 3 + (r); const int k = i - j; int x_cur = 0; \
    const bool live = own.nt > 0; \
    if (live && k == 0) { m = -1e30f; lsum = 0.f; o[0] = f32x16{}; o[1] = f32x16{}; \
      const PolDil suc = inA ? pNext : pCur; \
      if (suc.nt > 0) { const bf16* qp = suc.q_ptr(wid, r32); \
        _Pragma("unroll") for (int d0 = 0; d0 < 4; ++d0) qn[d0] = *reinterpret_cast<const bf16x8*>(qp + d0 * 16 + hi * 8); \
        x_cur = 4; } } \
    if (live && i >= own.t_lo && i < own.t_lo + own.nt) { \
      const LAS unsigned char* kt = shm + s_cur * DS_SLOT + (inA ? 0 : DS_KB); \
      f32x16 p0 = f32x16{}, p1 = f32x16{}; \
      qkt<4>(p0, p1, kt, qr, r32, hi); \
      { const int rel0 = own.ks + 64 * i - (256 * own.blk + 32 * wid);        \
        if (!(rel0 == 0 || rel0 == -32)) { const unsigned base = (unsigned)(rel0 - r32 + 64 + 4 * hi); \
          _Pragma("unroll") for (int ii = 0; ii < 16; ++ii) { const unsigned c = (unsigned)((ii & 3) + 8 * (ii >> 2)); \
            p0[ii] = (base + c <= 128u) ? p0[ii] : -INFINITY; p1[ii] = (base + c + 32u <= 128u) ? p1[ii] : -INFINITY; } } } \
      const float rm = rowmax(p0, p1) * PolDil::SC; \
      const bool grow = rm > m + THR; \
      if (__any(grow)) { const float mn = grow ? rm : m; const float f = __builtin_amdgcn_exp2f(m - mn); m = mn; lsum *= f; \
        if (hi == 0) wsf[r32] = f; \
        asm volatile("s_waitcnt lgkmcnt(0)" ::: "memory"); \
        _Pragma("unroll") for (int rr = 0; rr < 16; ++rr) { const float ff = wsf[crow(rr, hi)]; o[0][rr] *= ff; o[1][rr] *= ff; } } \
      float sacc = 0.f; \
      _Pragma("unroll") for (int rr = 0; rr < 16; ++rr) { p0[rr] = __builtin_amdgcn_exp2f(__builtin_fmaf(p0[rr], PolDil::SC, -m)); p1[rr] = __builtin_amdgcn_exp2f(__builtin_fmaf(p1[rr], PolDil::SC, -m)); sacc += p0[rr]; sacc += p1[rr]; } \
      lsum += sacc; \
      u32x4 pw0, pw1, pw2, pw3; \
      pw0 = (u32x4){cvtpk_s(p0[0], p0[1]), cvtpk_s(p0[2], p0[3]), cvtpk_s(p0[4], p0[5]), cvtpk_s(p0[6], p0[7])}; \
      pw1 = (u32x4){cvtpk_s(p0[8], p0[9]), cvtpk_s(p0[10], p0[11]), cvtpk_s(p0[12], p0[13]), cvtpk_s(p0[14], p0[15])}; \
      pw2 = (u32x4){cvtpk_s(p1[0], p1[1]), cvtpk_s(p1[2], p1[3]), cvtpk_s(p1[4], p1[5]), cvtpk_s(p1[6], p1[7])}; \
      pw3 = (u32x4){cvtpk_s(p1[8], p1[9]), cvtpk_s(p1[10], p1[11]), cvtpk_s(p1[12], p1[13]), cvtpk_s(p1[14], p1[15])}; \
      ATT_SBAR(); \
      pv(o, (int)lds0 + s_cur * DS_SLOT + (inA ? 0 : DS_KB) + 8192 + vlane, __builtin_bit_cast(bf16x8, pw0), __builtin_bit_cast(bf16x8, pw1), __builtin_bit_cast(bf16x8, pw2), __builtin_bit_cast(bf16x8, pw3)); } \
    if (live && k == 2) {                                             \
      float ls = lsum; { auto rr = __builtin_amdgcn_permlane32_swap(__float_as_uint(ls), __float_as_uint(ls), false, false); ls = __uint_as_float(rr[0]) + __uint_as_float(rr[1]); } \
      if (hi == 0) { wsf[32 + r32] = ls; own.lse_out(wid, r32, (m + __builtin_amdgcn_logf(ls)) * LN2); } \
      asm volatile("s_waitcnt lgkmcnt(0)" ::: "memory"); \
      float rli[16]; \
      _Pragma("unroll") for (int rr = 0; rr < 16; ++rr) rli[rr] = __builtin_amdgcn_rcpf(wsf[32 + crow(rr, hi)]); \
      asm volatile("s_waitcnt lgkmcnt(0)" ::: "memory"); \
      LAS bf16* stg = (LAS bf16*)(shm + DS_OST) + wid * 2048; \
      _Pragma("unroll") for (int rr = 0; rr < 16; ++rr) { const int orow = crow(rr, hi); \
        _Pragma("unroll") for (int d0 = 0; d0 < 2; ++d0) stg[orow * 64 + d0 * 32 + r32] = (bf16)(cvtpk_s(o[d0][rr] * rli[rr], 0.f) & 0xffffu); } \
      asm volatile("s_waitcnt lgkmcnt(0)" ::: "memory"); \
      _Pragma("unroll") for (int q4 = 0; q4 < 4; ++q4) { const int row = q4 * 8 + (lane >> 3), ch = lane & 7; const u32x4 v = *(const LAS u32x4*)(stg + row * 64 + ch * 8); *(u32x4*)(own.o_ptr(wid, row) + ch * 8) = v; } \
      x_cur = 5; \
      asm volatile("" : "+v"(qn[0]), "+v"(qn[1]), "+v"(qn[2]), "+v"(qn[3]));        \
      _Pragma("unroll") for (int d0 = 0; d0 < 4; ++d0) qr[d0] = qn[d0]; } \
    { const int xs = x_prev + x_cur;                                  \
      if (xs == 4) ATT_WAIT_BAR(8); else if (xs == 5) ATT_WAIT_BAR(9); else if (xs == 9) ATT_WAIT_BAR(13); else ATT_WAIT_BAR(4); }        \
    x_prev = x_cur; s_cur = (s_cur == 2) ? 0 : s_cur + 1; \
    } while (0)
#pragma unroll 1
    for (int a = 0; a <= NU; ++a) {
        DS_STEP(0); DS_STEP(1); DS_STEP(2);
        pPrev = pCur; pCur = pNext; dil_unit_init(pNext, a + 2, NU, vcu, G, ws);
    }
    ATT_WAIT_BAR(0);
#undef DS_STEP
#undef DS_DMA
}

__device__ __forceinline__ void pc_post_mixer(PP p, int layer, LAS unsigned char* lds, int vcu, int G, int tid, int lane, int wave) {
    constexpr int PST = 1028;
    LAS float* vec = (LAS float*)lds; LAS float* panel = (LAS float*)(lds + 20480); LAS float* part = panel + 16 * PST;
    static_assert(20480 + 16 * PST * 4 + 8 * 16 * 16 * 4 <= 131072, "post-mixer LDS map");
    const float* wrg = p->in[21] + (size_t)layer * DM * NEXP;
    float wreg[8][4];
#pragma unroll
    for (int s_ = 0; s_ < 8; ++s_)
#pragma unroll
        for (int jj = 0; jj < 4; ++jj) wreg[s_][jj] = wrg[(size_t)(128 * wave + 16 * s_ + 4 * (lane >> 4) + jj) * NEXP + (lane & 15)];
    __syncthreads();
    for (int i = tid; i < DM; i += NTHREADS) { vec[3 * DM + i] = p->in[15][layer * DM + i]; vec[4 * DM + i] = p->in[16][layer * DM + i]; }
    const bf16* mix = (const bf16*)(p->ws + WS_MIX);
    for (int ch = vcu; ch < NTOK / 256; ch += G) {
        const int t0 = ch * 256, b = tok_bidx(t0), tw = t0 + wave * 32;
        __syncthreads();
        load_mod_vec<true>(p, vec, 2 * layer, b, 2, tid); load_mod_vec<true>(p, vec + DM, 2 * layer + 1, b, 0, tid); load_mod_vec<true>(p, vec + 2 * DM, 2 * layer + 1, b, 1, tid);
        __syncthreads();
#define PC_LOAD(X, M, r_) do { const int t_ = tw + (r_); const GAS f32x4* xr_ = (const GAS f32x4*)(layer == 0 ? x_in_row(p, t_) : p->out + (size_t)t_ * DM) + lane; const GAS v2u* mr_ = (const GAS v2u*)(mix + (size_t)t_ * DM) + lane; \
            _Pragma("unroll") for (int j_ = 0; j_ < 4; ++j_) { X[j_] = xr_[64 * j_]; M[j_] = mr_[64 * j_]; } } while (0)
#define PC_PART1(X, M, r_, slot_) do { const int t = tw + (r_); \
            LAS float* vec_ = vec; asm volatile("" : "+v"(vec_));     \
            f32x4 v[4]; float s = 0.f; \
            _Pragma("unroll") for (int j = 0; j < 4; ++j) { const f32x4 x = X[j]; const v2u m2 = M[j]; const f32x4 gt = *(const LAS f32x4*)(vec_ + 4 * lane + 256 * j); \
                const f32x4 o = {bflo(m2.x), bfhi(m2.x), bflo(m2.y), bfhi(m2.y)}; v[j] = x * DN_ALPHA + gt * o; s += (v[j].x + v[j].y) + (v[j].z + v[j].w); } \
            if ((r_) + 2 < 32) PC_LOAD(X, M, (r_) + 2); \
            const float mean = wave_sum(s) * (1.f / DM); float s2 = 0.f; \
            _Pragma("unroll") for (int j = 0; j < 4; ++j) { v[j] = v[j] - mean; s2 += (v[j].x * v[j].x + v[j].y * v[j].y) + (v[j].z * v[j].z + v[j].w * v[j].w); } \
            const float rstd = 1.f / sqrtf(wave_sum(s2) * (1.f / DM) + LN_EPS); \
            GAS f32x4* orow = (GAS f32x4*)(p->out + (size_t)t * DM) + lane; \
            _Pragma("unroll") for (int j = 0; j < 4; ++j) { const int c = 4 * lane + 256 * j; \
                const f32x4 g = *(const LAS f32x4*)(vec_ + 3 * DM + c), bb = *(const LAS f32x4*)(vec_ + 4 * DM + c), sh = *(const LAS f32x4*)(vec_ + DM + c), sc = *(const LAS f32x4*)(vec_ + 2 * DM + c); \
                const f32x4 x1 = v[j] * rstd * g + bb; orow[64 * j] = x1; const f32x4 hh = x1 * (1.0f + sc) + sh; v[j] = hh; \
                *(LAS f32x4*)(panel + (slot_) * PST + c) = hh; } \
            { GAS unsigned* o4 = (GAS unsigned*)(p->ws + WS_H + (size_t)t * DM) + lane;        \
                _Pragma("unroll") for (int j = 0; j < 4; ++j) o4[64 * j] = pg8::pk4_fp8(v[j].x, v[j].y, v[j].z, v[j].w); } \
            } while (0)
#define PC_PART2(r_, slot_) do { const int t = tw + (r_); const int e_ = lane & 15, pg_ = lane >> 4; \
            float lg = part[((pg_) * 16 + (slot_)) * 16 + e_] + part[((pg_ + 4) * 16 + (slot_)) * 16 + e_]; \
            { auto rr = __builtin_amdgcn_permlane16_swap(__float_as_uint(lg), __float_as_uint(lg), false, false); lg = __uint_as_float(rr[0]) + __uint_as_float(rr[1]); } \
            { auto rr = __builtin_amdgcn_permlane32_swap(__float_as_uint(lg), __float_as_uint(lg), false, false); lg = __uint_as_float(rr[0]) + __uint_as_float(rr[1]); } \
            float mx = lg; mx = fmaxf(mx, dpp_f<0xB1>(mx)); mx = fmaxf(mx, dpp_f<0x4E>(mx)); mx = fmaxf(mx, dpp_f<0x141>(mx)); mx = fmaxf(mx, dpp_f<0x140>(mx)); \
            const float ex = __expf(lg - mx); float den = ex; den += dpp_f<0xB1>(den); den += dpp_f<0x4E>(den); den += dpp_f<0x141>(den); den += dpp_f<0x140>(den); \
            float af_ = ex / den; af_ = (af_ >= 0.f && af_ <= 1.f) ? af_ : 0.f;        \
            if (lane < NEXP) ((float*)(p->ws + WS_AFF))[((size_t)(t >> 15) * NEXP + lane) * GTOK + (t & (GTOK - 1))] = af_; } while (0)
        f32x4 xa[4], xb[4]; v2u ma[4], mb[4];
        PC_LOAD(xa, ma, 0); PC_LOAD(xb, mb, 1);
        _Pragma("unroll 1") for (int i = 0; i < 32; i += 2) {
            PC_PART1(xa, ma, i, 2 * wave); PC_PART1(xb, mb, i + 1, 2 * wave + 1);
            asm volatile("s_waitcnt lgkmcnt(0)\n\ts_barrier" ::: "memory");
            { pg8::f32x4 D = {0.f, 0.f, 0.f, 0.f}; const LAS float* brow = panel + (lane & 15) * PST + 128 * wave + 4 * (lane >> 4);
#pragma unroll
              for (int s_ = 0; s_ < 8; ++s_) { const f32x4 hv = *(const LAS f32x4*)(brow + 16 * s_);
                  D = __builtin_amdgcn_mfma_f32_16x16x4f32(wreg[s_][0], hv.x, D, 0, 0, 0); D = __builtin_amdgcn_mfma_f32_16x16x4f32(wreg[s_][1], hv.y, D, 0, 0, 0);
                  D = __builtin_amdgcn_mfma_f32_16x16x4f32(wreg[s_][2], hv.z, D, 0, 0, 0); D = __builtin_amdgcn_mfma_f32_16x16x4f32(wreg[s_][3], hv.w, D, 0, 0, 0); }
              *(LAS f32x4*)(part + ((wave * 16 + (lane & 15)) * 16 + 4 * (lane >> 4))) = (f32x4){D[0], D[1], D[2], D[3]}; }
            asm volatile("s_waitcnt lgkmcnt(0)\n\ts_barrier" ::: "memory");
            PC_PART2(i, 2 * wave); PC_PART2(i + 1, 2 * wave + 1);
        }
#undef PC_LOAD
#undef PC_PART1
#undef PC_PART2
    }
}

__device__ __forceinline__ void topk_phase(PP p, LAS unsigned char* lds, int tid, int lane, int wave) {
    LAS int* red = (LAS int*)lds;
    for (int prob = blockIdx.x; prob < 2 * NEXP; prob += gridDim.x) {
        const float* a = (const float*)(p->ws + WS_AFF) + (size_t)prob * GTOK + tid * 64;
        unsigned v[64];
#pragma unroll
        for (int i = 0; i < 16; ++i) { const v4u x = ((const GAS v4u*)a)[i]; v[4 * i] = x.x; v[4 * i + 1] = x.y; v[4 * i + 2] = x.z; v[4 * i + 3] = x.w; }
        unsigned prefix = 0u;
        __syncthreads();
#pragma unroll 1
        for (int bit = 30; bit >= 0; --bit) {
            const unsigned cand = prefix | (1u << bit); int c = 0;
#pragma unroll
            for (int i = 0; i < 64; ++i) c += (int)((cand - 1u - v[i]) >> 31);
            c = wave_sum_i(c);
            if (lane == 0) red[(bit & 1) * 8 + wave] = c;
            __syncthreads();
            int tot = 0;
#pragma unroll
            for (int w = 0; w < 8; ++w) tot += red[(bit & 1) * 8 + w];
            if (tot >= CAP) prefix = cand;
        }
        const unsigned T = prefix;
        unsigned cg = 0u, ce = 0u;
#pragma unroll
        for (int i = 0; i < 64; ++i) { cg += (v[i] > T) ? 1u : 0u; ce += (v[i] == T) ? 1u : 0u; if ((i & 7) == 7) __builtin_amdgcn_sched_barrier(0); }
        const unsigned pack = cg | (ce << 16); unsigned x = pack;
#pragma unroll
        for (int o = 1; o < 64; o <<= 1) { const unsigned y = (unsigned)__builtin_amdgcn_ds_bpermute(((lane - o) & 63) << 2, (int)x); if (lane >= o) x += y; }
        if (lane == 63) red[32 + wave] = (int)x;
        __syncthreads();
        unsigned off = 0u, tot = 0u;
#pragma unroll
        for (int w = 0; w < 8; ++w) { const unsigned tw = (unsigned)red[32 + w]; tot += tw; off += (w < wave) ? tw : 0u; }
        const unsigned excl = x - pack + off;
        unsigned gt_before = excl & 0xffffu, eq_before = excl >> 16; const unsigned need_eq = (unsigned)CAP - (tot & 0xffffu);
        int* idx = (int*)(p->ws + WS_IDX) + (size_t)prob * CAP; float* gv = (float*)(p->ws + WS_GATEV) + (size_t)prob * CAP;
        int so[64];
#pragma unroll
        for (int i = 0; i < 64; ++i) {
            const bool isg = v[i] > T, ise = v[i] == T; const bool sel = isg || (ise && eq_before < need_eq);
            const unsigned slot = gt_before + (eq_before < need_eq ? eq_before : need_eq);
            if (sel) { idx[slot] = (prob >> 4) * GTOK + tid * 64 + i; gv[slot] = __uint_as_float(v[i]); }
            so[i] = sel ? (int)slot : -1; gt_before += isg ? 1u : 0u; eq_before += ise ? 1u : 0u; if ((i & 7) == 7) __builtin_amdgcn_sched_barrier(0); }
        GAS v4u* sp = (GAS v4u*)((int*)(p->ws + WS_SLOTOF) + (size_t)prob * GTOK + tid * 64);
#pragma unroll
        for (int i = 0; i < 16; ++i) { v4u w; w.x = (unsigned)so[4 * i]; w.y = (unsigned)so[4 * i + 1]; w.z = (unsigned)so[4 * i + 2]; w.w = (unsigned)so[4 * i + 3]; sp[i] = w; }
        __syncthreads();
    }
}

__device__ __forceinline__ f32x4 pd_fp8x4(unsigned w) { const auto lo = __builtin_amdgcn_cvt_pk_f32_fp8((int)w, false), hi = __builtin_amdgcn_cvt_pk_f32_fp8((int)w, true); return (f32x4){lo[0], lo[1], hi[0], hi[1]}; }
__device__ __forceinline__ void pd_post_moe(PP p, int layer, LAS unsigned char* lds, int vcu, int G, int tid, int lane, int wave) {
    LAS float* vec = (LAS float*)lds;
    LAS int* st_slot = (LAS int*)(lds + 32768) + wave * 1024;
    LAS float* st_gate = (LAS float*)(st_slot + 512);
    __syncthreads();
    for (int i = tid; i < DM; i += NTHREADS) { vec[DM + i] = p->in[19][layer * DM + i]; vec[2 * DM + i] = p->in[20][layer * DM + i]; }
    const unsigned char* ye = p->ws + WS_YE;
    for (int ch = vcu; ch < NTOK / 256; ch += G) {
        const int t0 = ch * 256, b = tok_bidx(t0), g = t0 >> 15, tw = t0 + wave * 32;
        __syncthreads();
        load_mod_vec<true>(p, vec, 2 * layer + 1, b, 2, tid);
        if (layer == 0) { load_mod_vec<true>(p, vec + 3 * DM, 2, b, 0, tid); load_mod_vec<true>(p, vec + 4 * DM, 2, b, 1, tid); }
        { const int sub = lane >> 4, e = lane & 15;
          const int* so = (const int*)(p->ws + WS_SLOTOF) + ((size_t)g * NEXP + e) * GTOK + (tw & (GTOK - 1)); const float* gvp = (const float*)(p->ws + WS_GATEV) + ((size_t)g * NEXP + e) * CAP;
          int s8[8]; float g8[8];
#pragma unroll
          for (int j = 0; j < 8; ++j) s8[j] = so[4 * j + sub];
#pragma unroll
          for (int j = 0; j < 8; ++j) g8[j] = gvp[s8[j] < 0 ? 0 : s8[j]];
#pragma unroll
          for (int j = 0; j < 8; ++j) { const float gg = s8[j] >= 0 ? g8[j] * (1.0f / YE_QS) : 0.f; st_slot[(4 * j + sub) * 16 + e] = s8[j]; st_gate[(4 * j + sub) * 16 + e] = gg; } }
        __syncthreads();
        const unsigned char* yeg = ye + (size_t)g * NEXP * CAP * DM;
#define PD_STAGE(S_, i_) do { const int t_ = tw + (i_); int sl_ = -1; float gv_ = 0.f; if (lane < NEXP) { sl_ = st_slot[(i_) * 16 + lane]; gv_ = st_gate[(i_) * 16 + lane]; } \
            unsigned mk_ = (unsigned)__ballot(sl_ >= 0); \
            _Pragma("unroll") for (int k_ = 0; k_ < 4; ++k_) { const unsigned char* rp_ = yeg; float g_ = 0.f; \
                if (mk_) { const int e_ = __builtin_ctz(mk_); mk_ &= mk_ - 1u; const int s_ = __builtin_amdgcn_readlane(sl_, e_); g_ = __int_as_float(__builtin_amdgcn_readlane(__float_as_int(gv_), e_)); rp_ = yeg + ((size_t)e_ * CAP + s_) * DM; } \
                g##S_[k_] = g_; const GAS unsigned* yr_ = (const GAS unsigned*)rp_ + lane; _Pragma("unroll") for (int j_ = 0; j_ < 4; ++j_) y##S_[k_][j_] = yr_[64 * j_]; } \
            slot##S_ = sl_; gval##S_ = gv_; rest##S_ = mk_; \
            const GAS f32x4* xr_ = (const GAS f32x4*)(p->out + (size_t)t_ * DM) + lane; _Pragma("unroll") for (int j_ = 0; j_ < 4; ++j_) x##S_[j_] = xr_[64 * j_]; } while (0)
#define PD_ROW(S_, i_) do { const int t = tw + (i_); \
            LAS float* vec_ = vec; asm volatile("" : "+v"(vec_)); \
            f32x4 y[4]; \
            _Pragma("unroll") for (int j = 0; j < 4; ++j) { y[j] = (f32x4){0.f, 0.f, 0.f, 0.f}; \
                _Pragma("unroll") for (int k = 0; k < 4; ++k) y[j] += pd_fp8x4(y##S_[k][j]) * g##S_[k]; } \
            { unsigned rest = rest##S_; while (rest) { const int e = __builtin_ctz(rest); rest &= rest - 1u;            \
                const int sl = __builtin_amdgcn_readlane(slot##S_, e); const float gv = __int_as_float(__builtin_amdgcn_readlane(__float_as_int(gval##S_), e)); \
                const GAS unsigned* yr = (const GAS unsigned*)(yeg + ((size_t)e * CAP + sl) * DM) + lane; \
                _Pragma("unroll") for (int j = 0; j < 4; ++j) y[j] += pd_fp8x4(yr[64 * j]) * gv; } } \
            GAS f32x4* xr = (GAS f32x4*)(p->out + (size_t)t * DM) + lane; \
            f32x4 v[4]; float s = 0.f; \
            _Pragma("unroll") for (int j = 0; j < 4; ++j) { const f32x4 gt = *(const LAS f32x4*)(vec_ + 4 * lane + 256 * j); v[j] = x##S_[j] * DN_ALPHA + gt * y[j]; s += (v[j].x + v[j].y) + (v[j].z + v[j].w); } \
            if ((i_) + 2 < 32) PD_STAGE(S_, (i_) + 2); \
            const float mean = wave_sum(s) * (1.f / DM); float s2 = 0.f; \
            _Pragma("unroll") for (int j = 0; j < 4; ++j) { v[j] = v[j] - mean; s2 += (v[j].x * v[j].x + v[j].y * v[j].y) + (v[j].z * v[j].z + v[j].w * v[j].w); } \
            const float rstd = 1.f / sqrtf(wave_sum(s2) * (1.f / DM) + LN_EPS); \
            _Pragma("unroll") for (int j = 0; j < 4; ++j) { const int c = 4 * lane + 256 * j; const f32x4 gg = *(const LAS f32x4*)(vec_ + DM + c), bb = *(const LAS f32x4*)(vec_ + 2 * DM + c); \
                const f32x4 x2 = v[j] * rstd * gg + bb; xr[64 * j] = x2; \
                if (layer == 0) { const f32x4 sh = *(const LAS f32x4*)(vec_ + 3 * DM + c), sc = *(const LAS f32x4*)(vec_ + 4 * DM + c); v[j] = x2 * (1.0f + sc) + sh; } } \
            if (layer == 0) store_row_bf16((bf16*)(p->ws + WS_H) + (size_t)t * DM, v, lane); } while (0)
        f32x4 xA[4], xB[4]; unsigned yA[4][4], yB[4][4]; float gA[4], gB[4]; int slotA = -1, slotB = -1; float gvalA = 0.f, gvalB = 0.f; unsigned restA = 0u, restB = 0u;
        PD_STAGE(A, 0); PD_STAGE(B, 1);
        _Pragma("unroll 1") for (int i = 0; i < 32; i += 2) { PD_ROW(A, i); PD_ROW(B, i + 1); }
#undef PD_STAGE
#undef PD_ROW
    }
}

__device__ __forceinline__ void merge_phase(PP p, int vcu, int G, int lane, int wave) {
    const int gw = vcu * NWAVES + wave, NGW = G * NWAVES;
    const bf16* og = (const bf16*)(p->ws + WS_OG); const float* lse = (const float*)(p->ws + WS_LSE); bf16* mrg = (bf16*)(p->ws + WS_MRG);
    for (int t = gw; t < NTOK; t += NGW) {
        const int h = lane >> 3;
        const float l0 = lse[(size_t)t * 8 + h], l1 = lse[(size_t)NTOK * 8 + (size_t)t * 8 + h], l2 = lse[(size_t)2 * NTOK * 8 + (size_t)t * 8 + h];
        const float mx = fmaxf(l0, fmaxf(l1, l2)); float w0 = __expf(l0 - mx), w1 = __expf(l1 - mx), w2 = __expf(l2 - mx); const float inv = 1.0f / (w0 + w1 + w2); w0 *= inv; w1 *= inv; w2 *= inv;
        const v4u a = *((const GAS v4u*)(og + (size_t)t * 512) + lane), b = *((const GAS v4u*)(og + (size_t)NTOK * 512 + (size_t)t * 512) + lane), c = *((const GAS v4u*)(og + (size_t)2 * NTOK * 512 + (size_t)t * 512) + lane);
        v4u o;
#define MRG1(f) o.f = pk2(w0 * bflo(a.f) + w1 * bflo(b.f) + w2 * bflo(c.f), w0 * bfhi(a.f) + w1 * bfhi(b.f) + w2 * bfhi(c.f))
        MRG1(x); MRG1(y); MRG1(z); MRG1(w);
#undef MRG1
        *((GAS v4u*)(mrg + (size_t)t * 512) + lane) = o;
    }
}

__global__ void __launch_bounds__(NTHREADS, 2) fwd_kernel(Params p_unused) {
    extern __shared__ __attribute__((aligned(16))) unsigned char lds_raw[];
    LAS unsigned char* lds = (LAS unsigned char*)lds_raw;
    const int G = gridDim.x; const int bx = blockIdx.x; const int vcu = (G % 8 == 0) ? (bx % 8) * (G / 8) + bx / 8 : bx;
    int wv = __builtin_amdgcn_readfirstlane((int)threadIdx.x >> 6); asm volatile("" : "+s"(wv));
    { const int tid = opaque_tid(wv); for (int u = tid; u < (LDS_BYTES - LDSCTL_OFF) / 4; u += NTHREADS) ((LAS unsigned*)(lds + LDSCTL_OFF))[u] = 0u; }
    __syncthreads();
    XcdBarrier bar = xcd_barrier_post((unsigned*)(params_ptr()->ws + WS_CTL) + CW_BAR, (volatile LAS unsigned*)(lds + MISC_OFF) + 8);
    int ph = 0;
#ifdef TM_MASK
    unsigned long long tm_prev = __builtin_amdgcn_s_memrealtime(), tm_acc = 0ull;
#define TSTAMP(cls) do { const unsigned long long _n = __builtin_amdgcn_s_memrealtime(); if ((TM_MASK >> (cls)) & 1u) tm_acc += _n - tm_prev; tm_prev = _n; } while (0)
#else
#define TSTAMP(cls) do { } while (0)
#endif
#define SEAM() do { ++ph; if (ph >= params_ptr()->ph_hi) return; if (ph > params_ptr()->ph_lo) xcd_barrier(bar, wv); } while (0)
#define RUN (ph >= params_ptr()->ph_lo)
#define TL() const PP p = params_ptr(); unsigned char* ws = p->ws; (void)ws; const int tid = opaque_tid(wv), lane = tid & 63, wave = wv; (void)lane; (void)wave

    if (RUN) { TL(); p0_prologue(p, lds, vcu, G, tid, lane, wave); } SEAM(); TSTAMP(0);
    if (RUN) { TL(); p1_modulate(p, lds, vcu, G, tid, lane, wave); } SEAM(); TSTAMP(1);

    for (int layer = 0; layer < 2; ++layer) {
        if (layer == 0) {
            if (RUN) { const PP p = params_ptr(); unsigned char* ws = p->ws; pg8::Gemm g{(const bf16*)(ws + WS_H), (const bf16*)(ws + WS_WIN0), NTOK, N_IN0, DM}; pg8::StaticOrder S; S.init(NTOK, N_IN0, G, bx, 0);
              pg8::EpiBf16 E{(bf16*)(ws + WS_PROJ), N_IN0}; pg8::gemm_phase(wv, lds, g, S, E); } SEAM(); TSTAMP(2);
            if (RUN) { TL(); p3_mla_prep(p, vcu, G, lane, wave); } SEAM(); TSTAMP(3);
            if (RUN) { const PP p = params_ptr(); unsigned char* ws = p->ws; pg8::Gemm g{(const bf16*)(ws + WS_A2), (const bf16*)(ws + WS_WUP), NTOK, N_UP, K_UP}; pg8::StaticOrder S; S.init(NTOK, N_UP, G, bx, 0);
              pg8::EpiBf16 E{(bf16*)(ws + WS_QKV2), N_UP}; pg8::gemm_phase(wv, lds, g, S, E); } SEAM(); TSTAMP(4);
            if (RUN) { TL(); LAS float* tab = (LAS float*)(lds + att::L_TAB);
              __syncthreads();
              for (int i = tid; i < 8 * 465; i += NTHREADS) tab[i] = p->in[5][i] * att::LOG2E;
              __syncthreads();
              const int nk = (MOE_TILES - vcu + G - 1) / G; int nmla = 0; for (int r = vcu; r < 2048; r += G) ++nmla;
              { PolNA cur, nx; bool pre = false; int u = 0;
                for (int r = vcu; r < 2048; r += G, ++u) { if (u == 0) cur.init(r, ws, tab); const bool hn = r + G < 2048; if (hn) nx.init(r + G, ws, tab);
                  CvtRider<true> rd; const int k = nmla * 16 + u * 8 + wv, k1 = u * 8 + wv;
                  rd.init(p, 0, k < nk ? k * G + vcu : -1, k1 * G + vcu < moe1_split(G) ? k1 * G + vcu : -1, 1); att::attn_unit(wv, cur, lds, rd, nx, hn, pre); pre = hn; cur = nx; } } TSTAMP(5);
              { PolMLA cur, nx; bool pre = false; int u = 0;
                for (int r = vcu; r < 2048; r += G, ++u) { if (u == 0) cur.init(r, ws); const bool hn = r + G < 2048; if (hn) nx.init(r + G, ws);
                  CvtStream rd; const int k = (u * 8 + wv) * 2; rd.init(p, k < nk ? k * G + vcu : -1, k + 1 < nk ? (k + 1) * G + vcu : -1); att::attn_unit_pipe(wv, cur, lds, rd, nx, hn, pre); pre = hn; cur = nx; } }
              { const int lane2 = opaque_tid(wv) & 63;
                for (int k = nmla * 16 + nmla * 8 + wv; k < nk; k += 8) { const CvtTile T = moe_tile(p, 0, k * G + vcu, 1); f32x4 w[16]; cvt_tile_load(T, lane2, w); cvt_tile_store_any(T, lane2, w); } } } SEAM(); TSTAMP(6);
            if (RUN) { const PP p = params_ptr(); unsigned char* ws = p->ws; pg8::Gemm g{(const bf16*)(ws + WS_ATT), (const bf16*)(ws + WS_WOUT0), NTOK, DM, DM}; pg8::StaticOrder S; S.init(NTOK, DM, G, bx, 0);
              pg8::EpiBf16 E{(bf16*)(ws + WS_MIX), DM}; pg8::gemm_phase(wv, lds, g, S, E); } SEAM(); TSTAMP(7);
        } else {
            if (RUN) { const PP p = params_ptr(); unsigned char* ws = p->ws; pg8::Gemm g{(const bf16*)(ws + WS_H), (const bf16*)(ws + WS_WDIL), NTOK, N_DIL, DM}; pg8::StaticOrder S; S.init(NTOK, N_DIL, G, bx, 0);
              pg8::EpiBf16Dil E{(bf16*)(ws + WS_QKV), N_DIL, (const float2*)(ws + WS_ROPE_H)}; pg8::gemm_phase(wv, lds, g, S, E); } SEAM(); TSTAMP(14);
            if (RUN) { const PP p = params_ptr(); unsigned char* ws = p->ws; __syncthreads();
              const int nk = (moe1_split(G) - vcu + G - 1) / G; int nna = 0; for (int r = vcu; r < 2048; r += G) ++nna; const int it = nna;
              dil_skew(wv, p, lds, vcu, G);
              { const int lane = opaque_tid(wv) & 63; for (int k = it * 8 + wv; k < nk; k += 8) { const CvtTile T = moe_tile(p, 1, k * G + vcu, 1); f32x4 w[16]; cvt_tile_load(T, lane, w); cvt_tile_store<true>(T, lane, w); } } } SEAM(); TSTAMP(16);
            if (RUN) { TL(); merge_phase(p, vcu, G, lane, wave); } SEAM(); TSTAMP(17);
            if (RUN) { const PP p = params_ptr(); unsigned char* ws = p->ws; pg8::Gemm g{(const bf16*)(ws + WS_MRG), (const bf16*)(ws + WS_WOUT1), NTOK, DM, 512}; pg8::StaticOrder S; S.init(NTOK, DM, G, bx, 0);
              pg8::EpiBf16 E{(bf16*)(ws + WS_MIX), DM}; pg8::gemm_phase(wv, lds, g, S, E); } SEAM(); TSTAMP(18);
        }
        if (RUN) { TL(); if (layer == 0) pc_post_mixer(p, 0, lds, vcu, G, tid, lane, wave); else pc_post_mixer(p, 1, lds, vcu, G, tid, lane, wave); } SEAM(); TSTAMP(8);
        if (RUN) { TL(); topk_phase(p, lds, tid, lane, wave);
          if (bx >= 2 * NEXP) {
            const int it_end = layer == 0 ? moe1_split2(G) : MOE_TILES;
            for (int it = (layer == 0 ? moe1_split(G) : moe1_split2(G)) + (bx - 2 * NEXP) * 8 + wave; it < it_end; it += (G - 2 * NEXP) * 8) { const CvtTile T = moe_tile(p, 1, it, 1); f32x4 w[16]; cvt_tile_load(T, lane, w); cvt_tile_store<true>(T, lane, w); } } } SEAM(); TSTAMP(9);
        { constexpr int MR = 2 * NEXP * CAP;
            if (RUN) { const PP p = params_ptr(); unsigned char* ws = p->ws; pg8::StaticOrder S; S.init(MR, 2 * FF, G, bx, 1); const int* ix = (const int*)(ws + WS_IDX);
              { pg8::Gemm g{(const bf16*)(ws + WS_H), (const bf16*)(ws + WS_W13 + (layer ? W13_L1OFF : 0)), MR, 2 * FF, DM};
                  pg8::EpiSwiGluF8 E{ws + WS_HH, FF, 1.0f / W13_QS}; pg8::gemm_phase<pg8::EpiSwiGluF8, pg8::StaticOrder, true, true>(wv, lds, g, S, E, ix); } } SEAM(); TSTAMP(11);
            if (RUN) { const PP p = params_ptr(); unsigned char* ws = p->ws; pg8::Gemm g{(const bf16*)(ws + WS_HH), (const bf16*)(ws + WS_W2 + (layer ? W2_L1OFF : 0)), MR, DM, FF}; pg8::StaticOrder S; S.init(MR, DM, G, bx, 1);
              { pg8::EpiF8S E{ws + WS_YE, DM, YE_QS / W2_QS}; pg8::gemm_phase<pg8::EpiF8S, pg8::StaticOrder, false, true>(wv, lds, g, S, E); } } SEAM(); TSTAMP(12);
        }
        if (RUN) { TL(); pd_post_moe(p, layer, lds, vcu, G, tid, lane, wave);
        }
        if (layer == 0) SEAM();
        TSTAMP(13);
    }
#ifdef TM_MASK
    if (blockIdx.x == 0) { const unsigned long long t0 = __builtin_amdgcn_s_memrealtime(); while (__builtin_amdgcn_s_memrealtime() - t0 < TM_AMP * tm_acc) __builtin_amdgcn_s_sleep(8); }
#endif
#undef TL
#undef SEAM
}


extern "C" void kernel_launch(void* const* d_in, const int* in_sizes, int n_in, void* d_out, int out_size, void* d_ws, size_t ws_size, hipStream_t stream) {
    static int grid = 0;
    if (grid == 0) {
        if (n_in != 25 || out_size != NTOK * DM || ws_size < WS_END) { fprintf(stderr, "kernel_launch: unexpected shapes (n_in %d, out %d, ws %zu, need %zu); nothing launched\n", n_in, out_size, ws_size, (size_t)WS_END); grid = -1; return; }
        int dev = 0, cus = 0, per_cu = 0;
        if (hipGetDevice(&dev) != hipSuccess || hipDeviceGetAttribute(&cus, hipDeviceAttributeMultiprocessorCount, dev) != hipSuccess) { grid = -1; return; }
        if (hipFuncSetAttribute((const void*)fwd_kernel, hipFuncAttributeMaxDynamicSharedMemorySize, LDS_BYTES) != hipSuccess) { fprintf(stderr, "kernel_launch: hipFuncSetAttribute failed\n"); grid = -1; return; }
        if (hipOccupancyMaxActiveBlocksPerMultiprocessor(&per_cu, (const void*)fwd_kernel, NTHREADS, LDS_BYTES) != hipSuccess || per_cu < 1) fprintf(stderr, "kernel_launch: occupancy query reports %d\n", per_cu);
        (void)hipGetLastError();
        grid = cus;
    }
    if (grid < 0) return;
    if (hipMemsetAsync((char*)d_ws + WS_CTL, 0, CTL_ZERO_BYTES, stream) != hipSuccess) return;
    Params p{};
    for (int i = 0; i < 25; ++i) p.in[i] = (const float*)d_in[i];
    p.out = (float*)d_out; p.ws = (unsigned char*)d_ws;
#ifndef PH_HI
#define PH_HI 1000
#endif
    p.ph_lo = 0; p.ph_hi = PH_HI;
    hipLaunchKernelGGL(fwd_kernel, dim3(grid), dim3(NTHREADS), LDS_BYTES, stream, p);
    const hipError_t le = hipPeekAtLastError();
    if (le != hipSuccess) fprintf(stderr, "kernel_launch: launch failed: %s\n", hipGetErrorName(le));
}
```

```cpp
#include <hip/hip_runtime.h>
#include <hip/hip_bf16.h>
#include <cstdio>
#include <cstdint>
#include <cmath>

#define LAS __attribute__((address_space(3)))
#define GAS __attribute__((address_space(1)))
__device__ __forceinline__ int opaque_tid(int wv) { unsigned z = 0u; asm volatile("" : "+v"(z)); return wv * 64 + (int)__builtin_amdgcn_mbcnt_hi(~0u, __builtin_amdgcn_mbcnt_lo(~0u, z)); }

namespace pg8 {
typedef unsigned short bf16_t;
typedef short bf16x8 __attribute__((ext_vector_type(8)));
typedef float f32x4 __attribute__((ext_vector_type(4)));
typedef unsigned u32x4 __attribute__((ext_vector_type(4)));
typedef int i32x4 __attribute__((ext_vector_type(4)));
typedef int i32x8 __attribute__((ext_vector_type(8)));
typedef unsigned u32x2 __attribute__((ext_vector_type(2)));
constexpr int BM = 256, BK = 64, HALF = 128, HTB = HALF * BK * 2, STAGE_BYTES = 8 * HTB, NXCD = 8, WGM = 8;

__host__ __device__ __forceinline__ int lds_byte(int r, int c) { const int st = (r >> 4) * 2 + (c >> 5), rr = r & 15, cc = c & 31, ob = rr * 64 + cc * 2; return st * 1024 + (ob ^ (((ob >> 9) & 1) << 5)); }
__host__ __device__ __forceinline__ void stage_rc(int b, int& R, int& C) { const int st = b / 1024, sb = b % 1024, swz = sb ^ (((sb >> 9) & 1) << 5); R = (st >> 1) * 16 + swz / 64; C = (st & 1) * 32 + (swz % 64) / 2; }
__host__ __device__ __forceinline__ int perm32(int rho) { const int n = rho >> 4, i = rho & 15; return 8 * (i >> 2) + 4 * n + (i & 3); }

struct Unit { int pm, pn, pb; };
struct Gemm { const bf16_t* A; const bf16_t* Bt; int M, N, K; };

struct StaticOrder {
    int nM, nN, nwg, G, c, ne;
    __device__ void init(int M, int N, int G_, int c_, int ne_) { nM = M / BM; nN = N / BM; nwg = nM * nN; G = G_; c = c_; ne = ne_; }
    __device__ bool next(int i, Unit& u) const {
        const long L = (long)i * G + c; if (L >= nwg) return false;
        int wgid = (int)L; { const int q = nwg / NXCD, r = nwg % NXCD, xcd = wgid % NXCD, off = wgid / NXCD; wgid = (xcd < r ? xcd * (q + 1) : r * (q + 1) + (xcd - r) * q) + off; }
        const int nig = WGM * nN, gid = wgid / nig, fm = gid * WGM, gsz = (nM - fm) < WGM ? (nM - fm) : WGM;
        u.pm = fm + ((wgid % nig) % gsz); u.pn = (wgid % nig) / gsz; u.pb = ne ? ((u.pm >> 4) & 15) * nN + u.pn : u.pn; return true;
    }
};

__device__ __forceinline__ unsigned cvt_pk_bf16(float lo, float hi) { unsigned r; asm volatile("v_cvt_pk_bf16_f32 %0, %1, %2" : "=v"(r) : "v"(lo), "v"(hi)); return r; }

struct EpiBf16 {
    static constexpr bool PERM = true;
    bf16_t* O; int ldc;
    __device__ __forceinline__ void operator()(const f32x4 (&acc)[2][2][4][2], const Unit& u, int wr, int wc, int fr, int fq) const {
        const int row0 = u.pm * BM + wr * 64 + fr; const int col0 = u.pn * BM + wc * 32 + 8 * fq;
#pragma unroll
        for (int ai = 0; ai < 2; ++ai)
#pragma unroll
            for (int m = 0; m < 4; ++m) { bf16_t* rowp = O + (size_t)(row0 + ai * HALF + m * 16) * ldc + col0;
#pragma unroll
                for (int bj = 0; bj < 2; ++bj) { const f32x4 v0 = acc[ai][bj][m][0], v1 = acc[ai][bj][m][1];
                    u32x4 w; w.x = cvt_pk_bf16(v0[0], v0[1]); w.y = cvt_pk_bf16(v0[2], v0[3]); w.z = cvt_pk_bf16(v1[0], v1[1]); w.w = cvt_pk_bf16(v1[2], v1[3]);
                    *(u32x4*)(rowp + bj * HALF) = w; } }
    }
};
__device__ __forceinline__ unsigned pk4_fp8(float a, float b, float c, float d) { int w = __builtin_amdgcn_cvt_pk_fp8_f32(a, b, 0, false); w = __builtin_amdgcn_cvt_pk_fp8_f32(c, d, w, true); return (unsigned)w; }
struct EpiBf16S {
    static constexpr bool PERM = true;
    bf16_t* O; int ldc; float sc;
    __device__ __forceinline__ void operator()(const f32x4 (&acc)[2][2][4][2], const Unit& u, int wr, int wc, int fr, int fq) const {
        const int row0 = u.pm * BM + wr * 64 + fr; const int col0 = u.pn * BM + wc * 32 + 8 * fq;
#pragma unroll
        for (int ai = 0; ai < 2; ++ai)
#pragma unroll
            for (int m = 0; m < 4; ++m) { bf16_t* rowp = O + (size_t)(row0 + ai * HALF + m * 16) * ldc + col0;
#pragma unroll
                for (int bj = 0; bj < 2; ++bj) { const f32x4 v0 = acc[ai][bj][m][0] * sc, v1 = acc[ai][bj][m][1] * sc;
                    u32x4 w; w.x = cvt_pk_bf16(v0[0], v0[1]); w.y = cvt_pk_bf16(v0[2], v0[3]); w.z = cvt_pk_bf16(v1[0], v1[1]); w.w = cvt_pk_bf16(v1[2], v1[3]);
                    *(u32x4*)(rowp + bj * HALF) = w; } }
    }
};
struct EpiF8S {
    static constexpr bool PERM = true;
    unsigned char* O; int ldc; float sc;
    __device__ __forceinline__ void operator()(const f32x4 (&acc)[2][2][4][2], const Unit& u, int wr, int wc, int fr, int fq) const {
        const int row0 = u.pm * BM + wr * 64 + fr; const int col0 = u.pn * BM + wc * 32 + 8 * fq;
#pragma unroll
        for (int ai = 0; ai < 2; ++ai)
#pragma unroll
            for (int m = 0; m < 4; ++m) { unsigned char* rowp = O + (size_t)(row0 + ai * HALF + m * 16) * ldc + col0;
#pragma unroll
                for (int bj = 0; bj < 2; ++bj) { const f32x4 v0 = acc[ai][bj][m][0] * sc, v1 = acc[ai][bj][m][1] * sc;
                    u32x2 w; w.x = pk4_fp8(v0[0], v0[1], v0[2], v0[3]); w.y = pk4_fp8(v1[0], v1[1], v1[2], v1[3]);
                    *(u32x2*)(rowp + bj * HALF) = w; } }
    }
};
__device__ __forceinline__ int dil_row(int t, int gi) { const int lg = t < 32768 ? 12 : 13, S1 = (1 << lg) - 1, pos = t & S1, d2 = 2 * gi; return (t & ~S1) + ((pos & ((1 << d2) - 1)) << (lg - d2)) + (pos >> d2); }
struct EpiBf16Dil {
    static constexpr bool PERM = true;
    bf16_t* O; int ldc; const float2* rope;
    __device__ __forceinline__ void operator()(const f32x4 (&acc)[2][2][4][2], const Unit& u, int wr, int wc, int fr, int fq) const {
        const int row0 = u.pm * BM + wr * 64 + fr; const int col0 = u.pn * BM + wc * 32 + 8 * fq; const int gi = u.pn / 6; const bool qk = (u.pn % 6) < 4;
        if (qk) {
            const int i0 = (col0 & 63) >> 1;
            f32x4 c01[2][4], c23[2][4];
#pragma unroll
            for (int ai = 0; ai < 2; ++ai)
#pragma unroll
                for (int m = 0; m < 4; ++m) { const int t = row0 + ai * HALF + m * 16; const float2* cs = rope + (size_t)(t < 32768 ? (t & 4095) : (t & 8191)) * 32 + i0;
                    c01[ai][m] = *(const f32x4*)cs; c23[ai][m] = *(const f32x4*)(cs + 2); }
#pragma unroll
            for (int ai = 0; ai < 2; ++ai)
#pragma unroll
                for (int m = 0; m < 4; ++m) { const int t = row0 + ai * HALF + m * 16; bf16_t* rowp = O + (size_t)dil_row(t, gi) * ldc + col0; const f32x4 ca = c01[ai][m], cb = c23[ai][m];
#pragma unroll
                    for (int bj = 0; bj < 2; ++bj) { const f32x4 v0 = acc[ai][bj][m][0], v1 = acc[ai][bj][m][1];
                        const f32x4 r0 = {v0[0] * ca[0] - v0[1] * ca[1], v0[0] * ca[1] + v0[1] * ca[0], v0[2] * ca[2] - v0[3] * ca[3], v0[2] * ca[3] + v0[3] * ca[2]};
                        const f32x4 r1 = {v1[0] * cb[0] - v1[1] * cb[1], v1[0] * cb[1] + v1[1] * cb[0], v1[2] * cb[2] - v1[3] * cb[3], v1[2] * cb[3] + v1[3] * cb[2]};
                        u32x4 w; w.x = cvt_pk_bf16(r0[0], r0[1]); w.y = cvt_pk_bf16(r0[2], r0[3]); w.z = cvt_pk_bf16(r1[0], r1[1]); w.w = cvt_pk_bf16(r1[2], r1[3]);
                        *(u32x4*)(rowp + bj * HALF) = w; } }
        } else {
#pragma unroll
            for (int ai = 0; ai < 2; ++ai)
#pragma unroll
                for (int m = 0; m < 4; ++m) { const int t = row0 + ai * HALF + m * 16; bf16_t* rowp = O + (size_t)dil_row(t, gi) * ldc + col0;
#pragma unroll
                    for (int bj = 0; bj < 2; ++bj) { const f32x4 v0 = acc[ai][bj][m][0], v1 = acc[ai][bj][m][1];
                        u32x4 w; w.x = cvt_pk_bf16(v0[0], v0[1]); w.y = cvt_pk_bf16(v0[2], v0[3]); w.z = cvt_pk_bf16(v1[0], v1[1]); w.w = cvt_pk_bf16(v1[2], v1[3]);
                        *(u32x4*)(rowp + bj * HALF) = w; } }
        }
    }
};
__device__ __forceinline__ float silu_f(float g) { return g * __builtin_amdgcn_rcpf(1.0f + __builtin_amdgcn_exp2f(-1.4426950408889634f * g)); }
struct EpiSwiGlu {
    static constexpr bool PERM = true;
    bf16_t* O; int ldc;
    __device__ __forceinline__ void operator()(const f32x4 (&acc)[2][2][4][2], const Unit& u, int wr, int wc, int fr, int fq) const {
        const int row0 = u.pm * BM + wr * 64 + fr; const int col0 = u.pn * HALF + wc * 32 + 8 * fq;
#pragma unroll
        for (int ai = 0; ai < 2; ++ai)
#pragma unroll
            for (int m = 0; m < 4; ++m) { bf16_t* rowp = O + (size_t)(row0 + ai * HALF + m * 16) * ldc + col0;
                const f32x4 g0 = acc[ai][0][m][0], g1 = acc[ai][0][m][1], u0 = acc[ai][1][m][0], u1 = acc[ai][1][m][1];
                u32x4 w; w.x = cvt_pk_bf16(silu_f(g0[0]) * u0[0], silu_f(g0[1]) * u0[1]); w.y = cvt_pk_bf16(silu_f(g0[2]) * u0[2], silu_f(g0[3]) * u0[3]);
                w.z = cvt_pk_bf16(silu_f(g1[0]) * u1[0], silu_f(g1[1]) * u1[1]); w.w = cvt_pk_bf16(silu_f(g1[2]) * u1[2], silu_f(g1[3]) * u1[3]);
                *(u32x4*)rowp = w; }
    }
};

struct EpiSwiGluF8 {
    static constexpr bool PERM = true;
    unsigned char* O; int ldc; float sc;
    __device__ __forceinline__ void operator()(const f32x4 (&acc)[2][2][4][2], const Unit& u, int wr, int wc, int fr, int fq) const {
        const int row0 = u.pm * BM + wr * 64 + fr; const int col0 = u.pn * HALF + wc * 32 + 8 * fq;
#pragma unroll
        for (int ai = 0; ai < 2; ++ai)
#pragma unroll
            for (int m = 0; m < 4; ++m) { unsigned char* rowp = O + (size_t)(row0 + ai * HALF + m * 16) * ldc + col0;
                const f32x4 g0 = acc[ai][0][m][0] * sc, g1 = acc[ai][0][m][1] * sc, u0 = acc[ai][1][m][0] * sc, u1 = acc[ai][1][m][1] * sc;
                u32x2 w; w.x = pk4_fp8(silu_f(g0[0]) * u0[0], silu_f(g0[1]) * u0[1], silu_f(g0[2]) * u0[2], silu_f(g0[3]) * u0[3]);
                w.y = pk4_fp8(silu_f(g1[0]) * u1[0], silu_f(g1[1]) * u1[1], silu_f(g1[2]) * u1[2], silu_f(g1[3]) * u1[3]);
                *(u32x2*)rowp = w; }
    }
};

template <class Epi, class Sched, bool GATHER = false, bool F8 = false>
__device__ __forceinline__ void gemm_phase(int wv, LAS unsigned char* lds, const Gemm g, const Sched& S, const Epi& E, const int* aidx = nullptr) {
    const int tid = opaque_tid(wv), wid = __builtin_amdgcn_readfirstlane(tid >> 6), lane = tid & 63, wr = wid >> 2, wc = wid & 3, fr = lane & 15, fq = lane >> 4;
    const int K = g.K; const unsigned RB = F8 ? (unsigned)K : 2u * (unsigned)K;
    const int nt = (int)(RB / 128u);
    const size_t kstep = (size_t)(BK * 2);
    const size_t hstep = (size_t)HALF * RB;
    const size_t tstep = 2 * hstep;
    unsigned vG[2][2], voffB[2];
#pragma unroll
    for (int i = 0; i < 2; ++i) { int R, C; stage_rc(tid * 16 + i * 8192, R, C); const int Rb = Epi::PERM ? ((R & ~31) + perm32(R & 31)) : R;
        vG[0][i] = (unsigned)R * RB + (unsigned)C * 2u; vG[1][i] = vG[0][i] + (unsigned)hstep; voffB[i] = (unsigned)Rb * RB + (unsigned)C * 2u; }
    const unsigned ldsw = (unsigned)wid * 1024u;
    const int aoff = lds_byte(wr * 64 + fr, fq * 8), boff = lds_byte(wc * 32 + fr, fq * 8);
    LAS int* itab = (LAS int*)(lds + STAGE_BYTES + 1024);
#define PG8_SA(b, h) (((b) * 2 + (h)) * HTB)
#define PG8_SB(b, h) ((4 + (b) * 2 + (h)) * HTB)
#define PG8_STAGE2(bufoff, gbase, o0, o1) do { \
        __builtin_amdgcn_global_load_lds((const unsigned*)((const char*)(gbase) + (o0)), (LAS unsigned*)(lds + (bufoff) + ldsw), 16, 0, 0); \
        __builtin_amdgcn_global_load_lds((const unsigned*)((const char*)(gbase) + (o1)), (LAS unsigned*)(lds + (bufoff) + ldsw + 8192), 16, 0, 0); } while (0)
#define PG8_STAGE(bufoff, gbase, voff) PG8_STAGE2(bufoff, gbase, (voff)[0], (voff)[1])
#define PG8_LD8(p_) __builtin_shufflevector(*(const LAS i32x4*)(p_), *(const LAS i32x4*)((p_) + 1024), 0, 1, 2, 3, 4, 5, 6, 7)
#define PG8_LDA(dst, b, h) do { if constexpr (F8) { _Pragma("unroll") for (int m = 0; m < 4; ++m) dst##8[m] = PG8_LD8(lds + PG8_SA(b, h) + aoff + m * 2048); } \
        else { _Pragma("unroll") for (int m = 0; m < 4; ++m) _Pragma("unroll") for (int k = 0; k < 2; ++k) dst[m][k] = *(const LAS bf16x8*)(lds + PG8_SA(b, h) + aoff + m * 2048 + k * 1024); } } while (0)
#define PG8_LDB(dst, b, h) do { if constexpr (F8) { _Pragma("unroll") for (int n = 0; n < 2; ++n) dst##8[n] = PG8_LD8(lds + PG8_SB(b, h) + boff + n * 2048); } \
        else { _Pragma("unroll") for (int n = 0; n < 2; ++n) _Pragma("unroll") for (int k = 0; k < 2; ++k) dst[n][k] = *(const LAS bf16x8*)(lds + PG8_SB(b, h) + boff + n * 2048 + k * 1024); } } while (0)
#define PG8_MMA(ai, bj, At, Bt) do { __builtin_amdgcn_s_setprio(1); \
        if constexpr (F8) { _Pragma("unroll") for (int m = 0; m < 4; ++m) _Pragma("unroll") for (int n = 0; n < 2; ++n) \
            asm volatile("v_mfma_f32_16x16x128_f8f6f4 %0, %1, %2, %0" : "+v"(acc[ai][bj][m][n]) : "v"(Bt##8[n]), "v"(At##8[m])); } \
        else { _Pragma("unroll") for (int m = 0; m < 4; ++m) _Pragma("unroll") for (int n = 0; n < 2; ++n) _Pragma("unroll") for (int k = 0; k < 2; ++k) \
            acc[ai][bj][m][n] = __builtin_amdgcn_mfma_f32_16x16x32_bf16(Bt[n][k], At[m][k], acc[ai][bj][m][n], 0, 0, 0); } __builtin_amdgcn_s_setprio(0); } while (0)
#define PG8_WAIT_V(n) asm volatile("s_waitcnt vmcnt(" #n ")" ::: "memory")
#define PG8_WAIT_L(n) asm volatile("s_waitcnt lgkmcnt(" #n ")" ::: "memory")
#define PG8_BAR __builtin_amdgcn_s_barrier()
#define PG8_SCHED __builtin_amdgcn_sched_barrier(0)
    Unit cur, nxt; int ui = 0; int sl_nx = 1, sl_n2 = 2;
    if (!S.next(0, cur)) return;
    if constexpr (GATHER) {
        Unit u1; const bool h1 = S.next(1, u1);
        if (tid < 256) { itab[tid] = aidx[cur.pm * BM + tid]; if (h1) itab[256 + tid] = aidx[u1.pm * BM + tid]; }
        __syncthreads();
#pragma unroll
        for (int h = 0; h < 2; ++h)
#pragma unroll
            for (int i = 0; i < 2; ++i) { int R, C; stage_rc(tid * 16 + i * 8192, R, C); vG[h][i] = (unsigned)itab[h * HALF + R] * RB + (unsigned)C * 2u; }
    }
    f32x4 acc[2][2][4][2];
#pragma unroll
    for (int a = 0; a < 2; ++a)
#pragma unroll
        for (int b = 0; b < 2; ++b)
#pragma unroll
            for (int m = 0; m < 4; ++m)
#pragma unroll
                for (int n = 0; n < 2; ++n) acc[a][b][m][n] = (f32x4){0.f, 0.f, 0.f, 0.f};
    bf16x8 At[4][2], B0[2][2], B1[2][2]; i32x8 At8[4], B08[2], B18[2];
    const char* cA = GATHER ? (const char*)g.A : (const char*)g.A + (size_t)cur.pm * tstep; const char* cB = (const char*)g.Bt + (size_t)cur.pb * tstep;
    PG8_STAGE(PG8_SB(0, 0), cB, voffB); PG8_STAGE(PG8_SB(0, 1), cB + hstep, voffB); PG8_STAGE(PG8_SA(0, 0), cA, vG[0]); PG8_STAGE(PG8_SA(0, 1), cA, vG[1]);
    if (wr == 1) PG8_BAR;
    PG8_WAIT_V(2); PG8_BAR;
    PG8_STAGE(PG8_SB(1, 0), cB + kstep, voffB); PG8_STAGE(PG8_SA(1, 0), cA + kstep, vG[0]); PG8_STAGE(PG8_SB(1, 1), cB + hstep + kstep, voffB);
    PG8_WAIT_V(6); PG8_BAR;
    for (;;) {
        const bool has_next = S.next(ui + 1, nxt);
        const char* nA = GATHER ? cA : (has_next ? (const char*)g.A + (size_t)nxt.pm * tstep : cA); const char* nB = has_next ? (const char*)g.Bt + (size_t)nxt.pb * tstep : cB;
        if constexpr (GATHER) { Unit u2;
            if (wid == 0 && S.next(ui + 2, u2)) {
                int lo_ = lane; asm volatile("" : "+v"(lo_));
                const int* src = aidx + (size_t)u2.pm * BM + lo_; LAS int* dst = itab + sl_n2 * 256;
#pragma unroll
                for (int q = 0; q < 4; ++q) __builtin_amdgcn_global_load_lds((const unsigned*)(src + q * 64), (LAS unsigned*)(dst + q * 64), 4, 0, 0); } }
        for (int t = 0; t < nt; t += 2) {
            const bool last = (t == nt - 2);
            const char* a1 = cA + (size_t)(t + 1) * kstep;
            const char* a2 = last ? nA : cA + (size_t)(t + 2) * kstep; const char* b2 = last ? nB : cB + (size_t)(t + 2) * kstep;
            const char* a3 = a2 + kstep; const char* b3 = b2 + kstep;
            unsigned o00 = vG[0][0], o01 = vG[0][1], o10 = vG[1][0], o11 = vG[1][1];
            if constexpr (GATHER) { if (last && has_next) { const LAS int* tb = itab + sl_nx * 256; int R0, C0, R1, C1; stage_rc((lane + wid * 64) * 16, R0, C0); stage_rc((lane + wid * 64) * 16 + 8192, R1, C1);
                o00 = (unsigned)tb[R0] * RB + (unsigned)C0 * 2u; o01 = (unsigned)tb[R1] * RB + (unsigned)C1 * 2u; o10 = (unsigned)tb[HALF + R0] * RB + (unsigned)C0 * 2u; o11 = (unsigned)tb[HALF + R1] * RB + (unsigned)C1 * 2u; } }
            PG8_LDB(B0, 0, 0); PG8_LDB(B1, 0, 1); PG8_SCHED; PG8_LDA(At, 0, 0); PG8_STAGE(PG8_SA(1, 1), a1, vG[1]);
            PG8_WAIT_V(8); PG8_WAIT_L(0); PG8_BAR; PG8_MMA(0, 0, At, B0); PG8_MMA(0, 1, At, B1); PG8_BAR; PG8_SCHED;
            PG8_LDA(At, 0, 1); PG8_STAGE(PG8_SB(0, 0), b2, voffB); PG8_STAGE(PG8_SB(0, 1), b2 + hstep, voffB); PG8_STAGE2(PG8_SA(0, 0), a2, o00, o01);
            PG8_WAIT_V(8); PG8_WAIT_L(0); PG8_BAR; PG8_MMA(1, 0, At, B0); PG8_MMA(1, 1, At, B1); PG8_BAR; PG8_SCHED;
            PG8_LDB(B0, 1, 0); PG8_LDB(B1, 1, 1); PG8_SCHED; PG8_LDA(At, 1, 0); PG8_STAGE2(PG8_SA(0, 1), a2, o10, o11);
            PG8_WAIT_V(8); PG8_WAIT_L(0); PG8_BAR; PG8_MMA(0, 0, At, B0); PG8_MMA(0, 1, At, B1); PG8_BAR; PG8_SCHED;
            PG8_LDA(At, 1, 1); PG8_STAGE(PG8_SB(1, 0), b3, voffB); PG8_STAGE(PG8_SB(1, 1), b3 + hstep, voffB); PG8_STAGE2(PG8_SA(1, 0), a3, o00, o01);
            PG8_WAIT_V(8); PG8_WAIT_L(0); PG8_BAR; PG8_MMA(1, 0, At, B0); PG8_MMA(1, 1, At, B1); PG8_BAR; PG8_SCHED;
        }
        if (wr == 0) PG8_BAR;
        if constexpr (F8) asm volatile("s_nop 15\n\ts_nop 15" ::: "memory");
        E(acc, cur, wr, wc, fr, fq);
        if (!has_next) break;
#pragma unroll
        for (int a = 0; a < 2; ++a)
#pragma unroll
            for (int b = 0; b < 2; ++b)
#pragma unroll
                for (int m = 0; m < 4; ++m)
#pragma unroll
                    for (int n = 0; n < 2; ++n) acc[a][b][m][n] = (f32x4){0.f, 0.f, 0.f, 0.f};
        cur = nxt; cA = nA; cB = nB; ++ui;
        { const int t3 = sl_nx; sl_nx = sl_n2; sl_n2 = (sl_n2 == 2) ? 0 : sl_n2 + 1; (void)t3; }
        if constexpr (GATHER) { const LAS int* tb = itab + ((sl_nx == 0) ? 2 : sl_nx - 1) * 256;
#pragma unroll
            for (int h = 0; h < 2; ++h)
#pragma unroll
                for (int i = 0; i < 2; ++i) { int R, C; stage_rc((lane + wid * 64) * 16 + i * 8192, R, C); vG[h][i] = (unsigned)tb[h * HALF + R] * RB + (unsigned)C * 2u; } }
        if (wr == 1) PG8_BAR;
    }
    PG8_WAIT_V(0);
    PG8_BAR;
#undef PG8_SA
#undef PG8_SB
#undef PG8_STAGE
#undef PG8_STAGE2
#undef PG8_LDA
#undef PG8_LDB
#undef PG8_MMA
#undef PG8_LD8
#undef PG8_WAIT_V
#undef PG8_WAIT_L
#undef PG8_BAR
#undef PG8_SCHED
}
}

namespace att {
typedef unsigned short bf16;
typedef short bf16x8 __attribute__((ext_vector_type(8)));
typedef short s16x4 __attribute__((ext_vector_type(4)));
typedef float f32x16 __attribute__((ext_vector_type(16)));
typedef unsigned u32x4 __attribute__((ext_vector_type(4)));
typedef float f32x4 __attribute__((ext_vector_type(4)));
typedef float f32x2_t __attribute__((ext_vector_type(2)));
typedef __bf16 bf16x2_t __attribute__((ext_vector_type(2)));
constexpr int NSLOT = 3, KSLOT = 12288, VSLOT = 8192;
constexpr int L_K = 0, L_V = NSLOT * KSLOT, L_WS = L_V + NSLOT * VSLOT, L_OST = L_WS + 8 * 64 * 4, L_TAB = 114688, L_END = L_TAB + 8 * 465 * 4;
static_assert(L_OST + 8 * 4096 <= L_TAB, "attention LDS");
static_assert(L_END <= 131072, "attention LDS");
constexpr int N_KSL = 8192, N_V = 4 * N_KSL, N_WS = N_V + 4 * VSLOT, N_OST = N_WS + 8 * 64 * 4;
static_assert(N_OST + 8 * 4096 <= L_TAB, "neighbourhood attention LDS");
constexpr float LOG2E = 1.4426950408889634f, LN2 = 0.6931471805599453f;
constexpr float THR = 8.0f;
__device__ __forceinline__ int crow(int r, int hi) { return (r & 3) + 8 * (r >> 2) + 4 * hi; }
#define ATT_SBAR() __builtin_amdgcn_sched_barrier(0)
__device__ __forceinline__ void glds16(const void* gsrc, unsigned lds_dst) { unsigned keep;
  asm volatile("s_mov_b32 %0, m0\n\ts_mov_b32 m0, %2\n\ts_nop 0\n\tglobal_load_lds_dwordx4 %1, off\n\ts_mov_b32 m0, %0" : "=&s"(keep) : "v"(gsrc), "s"(lds_dst) : "memory"); }
__device__ __forceinline__ void glds16s(unsigned vofs, const void* sbase, unsigned lds_dst) { unsigned keep;
  asm volatile("s_mov_b32 %0, m0\n\ts_mov_b32 m0, %3\n\ts_nop 0\n\tglobal_load_lds_dwordx4 %1, %2\n\ts_mov_b32 m0, %0" : "=&s"(keep) : "v"(vofs), "s"(sbase), "s"(lds_dst) : "memory"); }
__device__ __forceinline__ float max3f(float a, float b, float c) { float r; asm("v_max3_f32 %0, %1, %2, %3" : "=v"(r) : "v"(a), "v"(b), "v"(c)); return r; }
__device__ __forceinline__ unsigned cvtpk_s(float lo, float hi) { f32x2_t v = {lo, hi}; bf16x2_t b = __builtin_convertvector(v, bf16x2_t); return __builtin_bit_cast(unsigned, b); }
__device__ __forceinline__ float bf2f(short s) { return __uint_as_float(((unsigned)(unsigned short)s) << 16); }
#define ATT_WAIT_BAR(N) asm volatile("s_waitcnt vmcnt(" #N ") lgkmcnt(0)\n\ts_barrier" ::: "memory")

template <int ND0> __device__ __forceinline__ void qkt(f32x16& p0, f32x16& p1, const LAS unsigned char* Kslot, const bf16x8* qr, int r32, int hi) {
  const LAS unsigned char* kb = Kslot + hi * 1024 + r32 * 16;
#pragma unroll
  for (int d0 = 0; d0 < ND0; ++d0) {
    const bf16x8 b0 = *(const LAS bf16x8*)(kb + d0 * 2048);
    const bf16x8 b1 = *(const LAS bf16x8*)(kb + d0 * 2048 + 512);
    p0 = __builtin_amdgcn_mfma_f32_32x32x16_bf16(b0, qr[d0], p0, 0, 0, 0); p1 = __builtin_amdgcn_mfma_f32_32x32x16_bf16(b1, qr[d0], p1, 0, 0, 0); }
}
__device__ __forceinline__ float rowmax(const f32x16& p0, const f32x16& p1) {
  float a = max3f(p0[0], p0[1], p1[0]), b = max3f(p0[2], p0[3], p1[1]); a = max3f(a, p1[2], p1[3]);
#pragma unroll
  for (int r = 4; r < 16; r += 4) { a = max3f(a, p0[r], p0[r + 1]); b = max3f(b, p0[r + 2], p0[r + 3]); a = max3f(a, p1[r], p1[r + 1]); b = max3f(b, p1[r + 2], p1[r + 3]); }
  const float m = fmaxf(a, b);
  auto rr = __builtin_amdgcn_permlane32_swap(__float_as_uint(m), __float_as_uint(m), false, false);
  return fmaxf(__uint_as_float(rr[0]), __uint_as_float(rr[1]));
}
__device__ __forceinline__ void pv(f32x16* o, int vb, bf16x8 pa0, bf16x8 pa1, bf16x8 pa2, bf16x8 pa3) {
#pragma unroll
  for (int d0 = 0; d0 < 2; ++d0) { s16x4 lo[4], hi[4];
#pragma unroll
    for (int ks = 0; ks < 4; ++ks) {
      asm volatile("ds_read_b64_tr_b16 %0,%1 offset:%c2" : "=&v"(lo[ks]) : "v"(vb), "i"(d0 * 4096 + ks * 1024) : "memory");
      asm volatile("ds_read_b64_tr_b16 %0,%1 offset:%c2" : "=&v"(hi[ks]) : "v"(vb), "i"(d0 * 4096 + ks * 1024 + 512) : "memory"); }
    asm volatile("s_waitcnt lgkmcnt(0)" ::: "memory"); ATT_SBAR();
#define ATT_PK(k) (bf16x8){lo[k][0], lo[k][1], lo[k][2], lo[k][3], hi[k][0], hi[k][1], hi[k][2], hi[k][3]}
    o[d0] = __builtin_amdgcn_mfma_f32_32x32x16_bf16(pa0, ATT_PK(0), o[d0], 0, 0, 0);
    o[d0] = __builtin_amdgcn_mfma_f32_32x32x16_bf16(pa1, ATT_PK(1), o[d0], 0, 0, 0);
    o[d0] = __builtin_amdgcn_mfma_f32_32x32x16_bf16(pa2, ATT_PK(2), o[d0], 0, 0, 0);
    o[d0] = __builtin_amdgcn_mfma_f32_32x32x16_bf16(pa3, ATT_PK(3), o[d0], 0, 0, 0);
#undef ATT_PK
  }
}

template <int KLO, int KHI> __device__ __forceinline__ void pv_r(f32x16* o, int vb, bf16x8 pa0, bf16x8 pa1, bf16x8 pa2, bf16x8 pa3) {
#pragma unroll
  for (int d0 = 0; d0 < 2; ++d0) { s16x4 lo[4], hi[4];
#pragma unroll
    for (int ks = KLO; ks < KHI; ++ks) {
      asm volatile("ds_read_b64_tr_b16 %0,%1 offset:%c2" : "=&v"(lo[ks]) : "v"(vb), "i"(d0 * 4096 + ks * 1024) : "memory");
      asm volatile("ds_read_b64_tr_b16 %0,%1 offset:%c2" : "=&v"(hi[ks]) : "v"(vb), "i"(d0 * 4096 + ks * 1024 + 512) : "memory"); }
    asm volatile("s_waitcnt lgkmcnt(0)" ::: "memory"); ATT_SBAR();
#define ATT_PK(k) (bf16x8){lo[k][0], lo[k][1], lo[k][2], lo[k][3], hi[k][0], hi[k][1], hi[k][2], hi[k][3]}
    if (KLO <= 0 && 0 < KHI) o[d0] = __builtin_amdgcn_mfma_f32_32x32x16_bf16(pa0, ATT_PK(0), o[d0], 0, 0, 0);
    if (KLO <= 1 && 1 < KHI) o[d0] = __builtin_amdgcn_mfma_f32_32x32x16_bf16(pa1, ATT_PK(1), o[d0], 0, 0, 0);
    if (KLO <= 2 && 2 < KHI) o[d0] = __builtin_amdgcn_mfma_f32_32x32x16_bf16(pa2, ATT_PK(2), o[d0], 0, 0, 0);
    if (KLO <= 3 && 3 < KHI) o[d0] = __builtin_amdgcn_mfma_f32_32x32x16_bf16(pa3, ATT_PK(3), o[d0], 0, 0, 0);
#undef ATT_PK
  }
}
template <class P, int VAR> __device__ __forceinline__ float rowmax_v(const f32x16& p0, const f32x16& p1) {
  const f32x16& F = (VAR == 0) ? p0 : p1; const f32x16& H = (VAR == 0) ? p1 : p0; constexpr int o = P::live4(VAR);
  float a = max3f(F[0], F[1], F[2]), b = max3f(F[3], F[4], F[5]); a = max3f(a, F[6], F[7]); b = max3f(b, F[8], F[9]); a = max3f(a, F[10], F[11]); b = max3f(b, F[12], F[13]); a = max3f(a, F[14], F[15]);
  b = max3f(b, H[o], H[o + 1]); a = max3f(a, H[o + 2], H[o + 3]);
  const float m = fmaxf(a, b);
  auto rr = __builtin_amdgcn_permlane32_swap(__float_as_uint(m), __float_as_uint(m), false, false);
  return fmaxf(__uint_as_float(rr[0]), __uint_as_float(rr[1]));
}
template <class P, class R> __device__ __forceinline__ void attn_unit(int wv, const P& pol, LAS unsigned char* shm, R& rider, const P& nxt, bool has_nxt, bool pre) {
  constexpr int ND0 = P::ND0;
  const int tid = opaque_tid(wv), lane = tid & 63, r32 = lane & 31, hi = lane >> 5; const int wid = __builtin_amdgcn_readfirstlane(tid >> 6);
  const unsigned lds0 = (unsigned)(uintptr_t)shm;
  static_assert(ND0 == 4, "this unit's ring is laid out for qk dim 64 (8 KiB K tiles): four slots, requests three tiles ahead");
  LAS float* wsf = (LAS float*)(shm + N_WS) + wid * 64;
  const int NT = pol.ntiles();
  const bool three = (ND0 == 6) && (wid < 4);
#define ATT_DMA_P(PL, t, slot) do { \
    glds16((PL).k_src((t), wid, lane), (unsigned)__builtin_amdgcn_readfirstlane(lds0 + (slot) * N_KSL + wid * 1024)); \
    glds16((PL).v_src((t), wid, lane), (unsigned)__builtin_amdgcn_readfirstlane(lds0 + N_V + (slot) * VSLOT + wid * 1024)); } while (0)
#define ATT_DMA(t, slot) ATT_DMA_P(pol, t, slot)
  if (!pre) { ATT_DMA(0, 0); ATT_DMA(1, 1); ATT_DMA(2, 2); }
  bf16x8 qr[ND0];
  { const bf16* qp = pol.q_ptr(wid, r32);
#pragma unroll
    for (int d0 = 0; d0 < ND0; ++d0) qr[d0] = *reinterpret_cast<const bf16x8*>(qp + d0 * 16 + hi * 8); }
  pol.q_fix(qr, wid, r32, hi);
  float m = -1e30f, lsum = 0.f; f32x16 o[2]; o[0] = f32x16{}; o[1] = f32x16{};
  const int vb0 = (int)(lds0 + N_V) + ((lane >> 4) & 1) * 32 + (lane & 3) * 8 + (4 * hi + ((lane & 15) >> 2)) * 64;
  ATT_WAIT_BAR(0);
  f32x4 rw[R::NW]; rider.begin(lane, rw);
  int s_cur = 0, s_n3 = 3;
  for (int t = 0; t < NT; ++t) {
    if (t + 3 < NT) ATT_DMA(t + 3, s_n3);
    const int xr = rider.mid(t, NT, lane, rw);
    if (pol.needs(t, wid)) {
#define ATT_BODY(VAR) do { \
      f32x16 p0 = f32x16{}, p1 = f32x16{}; \
      qkt<ND0>(p0, p1, shm + s_cur * N_KSL, qr, r32, hi); \
      pol.template transform_v<VAR>(p0, p1, t, wid, r32, hi); \
      const float rm = rowmax_v<P, VAR>(p0, p1); \
      const bool grow = rm > m + THR; \
      if (__any(grow)) { \
        const float mn = grow ? rm : m; const float f = __builtin_amdgcn_exp2f(m - mn); m = mn; lsum *= f; \
        if (hi == 0) wsf[r32] = f; \
        asm volatile("s_waitcnt lgkmcnt(0)" ::: "memory"); \
        _Pragma("unroll") for (int r = 0; r < 16; ++r) { const float ff = wsf[crow(r, hi)]; o[0][r] *= ff; o[1][r] *= ff; } } \
      float sacc = 0.f; \
      _Pragma("unroll") for (int r = 0; r < 16; ++r) { \
        if (!P::dead(VAR, 0, r)) { p0[r] = __builtin_amdgcn_exp2f(p0[r] - m); sacc += p0[r]; } else p0[r] = 0.f; \
        if (!P::dead(VAR, 1, r)) { p1[r] = __builtin_amdgcn_exp2f(p1[r] - m); sacc += p1[r]; } else p1[r] = 0.f; } \
      lsum += sacc; \
      u32x4 pw0, pw1, pw2, pw3; \
      pw0 = (u32x4){cvtpk_s(p0[0], p0[1]), cvtpk_s(p0[2], p0[3]), cvtpk_s(p0[4], p0[5]), cvtpk_s(p0[6], p0[7])}; \
      pw1 = (u32x4){cvtpk_s(p0[8], p0[9]), cvtpk_s(p0[10], p0[11]), cvtpk_s(p0[12], p0[13]), cvtpk_s(p0[14], p0[15])}; \
      pw2 = (u32x4){cvtpk_s(p1[0], p1[1]), cvtpk_s(p1[2], p1[3]), cvtpk_s(p1[4], p1[5]), cvtpk_s(p1[6], p1[7])}; \
      pw3 = (u32x4){cvtpk_s(p1[8], p1[9]), cvtpk_s(p1[10], p1[11]), cvtpk_s(p1[12], p1[13]), cvtpk_s(p1[14], p1[15])}; \
      ATT_SBAR(); \
      pv_r<P::kslo(VAR), P::kshi(VAR)>(o, vb0 + s_cur * VSLOT, __builtin_bit_cast(bf16x8, pw0), __builtin_bit_cast(bf16x8, pw1), __builtin_bit_cast(bf16x8, pw2), __builtin_bit_cast(bf16x8, pw3)); \
      } while (0)
      if (pol.variant(wid)) ATT_BODY(1); else ATT_BODY(0);
#undef ATT_BODY
    }
    if (xr == 16 && t + 3 < NT) ATT_WAIT_BAR(20); else if (xr == 20 && t + 3 < NT) ATT_WAIT_BAR(24);
    else if (t + 3 < NT) ATT_WAIT_BAR(4); else if (t + 2 < NT) ATT_WAIT_BAR(2); else ATT_WAIT_BAR(0);
    s_cur = (s_cur + 1) & 3; s_n3 = (s_n3 + 1) & 3;
  }
  rider.end(lane, rw);
  if (has_nxt) { ATT_DMA_P(nxt, 0, 0); ATT_DMA_P(nxt, 1, 1); ATT_DMA_P(nxt, 2, 2); }
  { auto rr = __builtin_amdgcn_permlane32_swap(__float_as_uint(lsum), __float_as_uint(lsum), false, false); lsum = __uint_as_float(rr[0]) + __uint_as_float(rr[1]); }
  if (hi == 0) { wsf[32 + r32] = lsum; pol.lse_out(wid, r32, (m + __builtin_amdgcn_logf(lsum)) * LN2); }
  asm volatile("s_waitcnt lgkmcnt(0)" ::: "memory");
  float rli[16];
#pragma unroll
  for (int r = 0; r < 16; ++r) rli[r] = __builtin_amdgcn_rcpf(wsf[32 + crow(r, hi)]);
  { LAS bf16* stg = (LAS bf16*)(shm + N_OST) + wid * 2048;
#pragma unroll
    for (int r = 0; r < 16; ++r) { const int orow = crow(r, hi);
#pragma unroll
      for (int d0 = 0; d0 < 2; ++d0) stg[orow * 64 + d0 * 32 + r32] = (bf16)(cvtpk_s(o[d0][r] * rli[r], 0.f) & 0xffffu); }
    asm volatile("s_waitcnt lgkmcnt(0)" ::: "memory");
#pragma unroll
    for (int i = 0; i < 4; ++i) { const int row = i * 8 + (lane >> 3), ch = lane & 7; const u32x4 v = *(const LAS u32x4*)(stg + row * 64 + ch * 8); *(u32x4*)(pol.o_ptr(wid, row) + ch * 8) = v; } }
  asm volatile("s_waitcnt lgkmcnt(0)\n\ts_barrier" ::: "memory");
#undef ATT_DMA
#undef ATT_DMA_P
}

typedef short v4i16_t __attribute__((ext_vector_type(4)));
__device__ __forceinline__ s16x4 vtr(const LAS unsigned char* p) { return __builtin_bit_cast(s16x4, __builtin_amdgcn_ds_read_tr16_b64_v4i16((LAS v4i16_t*)p)); }
#define ATT_PIN(x) asm volatile("" : "+v"(x))
#define ATT_MFMA(a, b, c) __builtin_amdgcn_mfma_f32_32x32x16_bf16(a, b, c, 0, 0, 0)
template <class P, class R> __device__ __forceinline__ void attn_unit_pipe(int wv, const P& pol, LAS unsigned char* shm, R& rider, const P& nxt, bool has_nxt, bool pre) {
  static_assert(P::ND0 == 6 && P::FUSED, "dense pipelined unit: qk dim 96, scale folded into the exponent");
  const int tid = opaque_tid(wv), lane = tid & 63, r32 = lane & 31, hi = lane >> 5; const int wid = __builtin_amdgcn_readfirstlane(tid >> 6);
  const unsigned lds0 = (unsigned)(uintptr_t)shm;
  LAS float* wsf = (LAS float*)(shm + L_WS) + wid * 64;
  const int NT = pol.ntiles();
  const bool three = wid < 4;
  const unsigned kofs = P::k_lofs(wid, lane), k2ofs = P::k2_lofs(wid, lane), vofs = P::v_lofs(wid, lane);
  const unsigned kdst = (unsigned)__builtin_amdgcn_readfirstlane(lds0 + L_K + wid * 1024), vdst = (unsigned)__builtin_amdgcn_readfirstlane(lds0 + L_V + wid * 1024);
#define ATT_DMAK(PL, t, slot) do { glds16s(kofs, (PL).k_base() + (size_t)(t) * P::KSTRIDE, kdst + (slot) * KSLOT); \
    if (three) glds16s(k2ofs, (PL).k2_base() + (size_t)(t) * P::K2STRIDE, kdst + 8192 + (slot) * KSLOT); } while (0)
#define ATT_DMAV(PL, t, slot) glds16s(vofs, (PL).k_base() + (size_t)(t) * P::KSTRIDE, vdst + (slot) * VSLOT)
  if (!pre) { ATT_DMAK(pol, 0, 0); ATT_DMAK(pol, 1, 1); }
  bf16x8 qr[6];
  { const bf16* qp = pol.q_ptr(wid, r32);
#pragma unroll
    for (int d0 = 0; d0 < 6; ++d0) qr[d0] = *reinterpret_cast<const bf16x8*>(qp + d0 * 16 + hi * 8); }
  pol.q_fix(qr, wid, r32, hi);
  ATT_DMAV(pol, 0, 0);
  float mhat = 0.f, lsum = 0.f; f32x16 o[2]; o[0] = f32x16{}; o[1] = f32x16{};
  const LAS unsigned char* vp0 = shm + L_V + ((lane >> 4) & 1) * 32 + (lane & 3) * 8 + (4 * hi + ((lane & 15) >> 2)) * 64;
  const LAS unsigned char* kp0 = shm + L_K + hi * 1024 + r32 * 16;
  f32x16 pA0, pA1, pB0, pB1; u32x4 pw0, pw1, pw2, pw3; bool resc = false, rl = false;
  asm volatile("s_waitcnt vmcnt(1) lgkmcnt(0)\n\ts_barrier" ::: "memory");
  f32x4 rw[R::NW]; rider.begin(lane, rw);
  int sl_prev = 2, sl_cur = 0, sl_next = 1;
#define ATT_ROT() do { const int t_ = sl_prev; sl_prev = sl_cur; sl_cur = sl_next; sl_next = t_; } while (0)
#define ATT_KF(i) (*(const LAS bf16x8*)(kp_ + ((i) >> 1) * 2048 + ((i) & 1) * 512))
#define ATT_EX(v) __builtin_amdgcn_exp2f(__builtin_fmaf((v), P::SC, nmh))
#define ATT_RESC() do { if (resc) { _Pragma("unroll") for (int d_ = 0; d_ < 2; ++d_) _Pragma("unroll") for (int r = 0; r < 16; ++r) o[d_][r] *= wsf[crow(r, hi)]; } } while (0)
  ATT_DMAK(pol, 2, 2); ATT_DMAV(pol, 1, 1);
  { const LAS unsigned char* kp_ = kp0; pA0 = f32x16{}; pA1 = f32x16{};
#pragma unroll
    for (int d0 = 0; d0 < 6; ++d0) { const bf16x8 b0 = ATT_KF(2 * d0), b1 = ATT_KF(2 * d0 + 1); pA0 = ATT_MFMA(b0, qr[d0], pA0); pA1 = ATT_MFMA(b1, qr[d0], pA1); }
    const float rm = rowmax(pA0, pA1); mhat = rm * P::SC; const float nmh = -mhat;
#pragma unroll
    for (int r = 0; r < 16; ++r) pA0[r] = ATT_EX(pA0[r]);
#pragma unroll
    for (int r = 0; r < 8; ++r) pA1[r] = ATT_EX(pA1[r]); }
  if (three) ATT_WAIT_BAR(3); else ATT_WAIT_BAR(2);
  ATT_ROT();
#define ATT_PKW(X, i) cvtpk_s(X[i], X[(i) + 1])
#define ATT_PAF(k) __builtin_bit_cast(bf16x8, pw##k)
#define ATT_VFR(v) (bf16x8){v##l[0], v##l[1], v##l[2], v##l[3], v##h[0], v##h[1], v##h[2], v##h[3]}
#define ATT_VRD(v, f) do { v##l = vtr(vp_ + ((f) >> 2) * 4096 + ((f) & 3) * 1024); v##h = vtr(vp_ + ((f) >> 2) * 4096 + ((f) & 3) * 1024 + 512); } while (0)
#define ATT_GAPE(LD, MF, X, i) do { LD; MF; X[i] = ATT_EX0(X[i]); X[(i) + 1] = ATT_EX0(X[(i) + 1]); ATT_PIN(X); ATT_SBAR(); } while (0)
#define ATT_GAPA(LD, MF, a0, a1, a2, a3, W0, W1, PW) do { LD; MF; sacc += a0; sacc += a1; sacc += a2; sacc += a3; W0; W1; ATT_PIN(PW); ATT_PIN(sacc); ATT_SBAR(); } while (0)
#define ATT_GAPB(LD, MF, X, a, Y, b, Z, c) do { LD; MF; X[a] = ATT_EX(X[a]); Y[b] = ATT_EX(Y[b]); Z[c] = ATT_EX(Z[c]); ATT_PIN(X); ATT_PIN(Z); ATT_SBAR(); } while (0)
#define ATT_EX0(v) __builtin_amdgcn_exp2f(__builtin_fmaf((v), P::SC, nmh0))
#define ATT_STEP(C0, C1, P0, P1, s, GK, GV) do { ATT_SBAR(); \
    rl = rider.pre((s), lane, rw);                                  \
    if (GK) ATT_DMAK(pol, (s) + 2, sl_prev); if (GV) ATT_DMAV(pol, (s) + 1, sl_next); \
    if (rl) rider.post(lane, rw);                                   \
    const LAS unsigned char* kp_ = kp0 + sl_cur * KSLOT; const LAS unsigned char* vp_ = vp0 + sl_prev * VSLOT; const float nmh0 = -mhat; \
    bf16x8 k0 = ATT_KF(0), k1 = ATT_KF(1), k2; s16x4 vAl, vAh, vBl, vBh, vCl, vCh; ATT_SBAR(); \
    ATT_GAPE(k2 = ATT_KF(2),  C0 = ATT_MFMA(k0, qr[0], f32x16{}), P1, 8); \
    ATT_GAPE(k0 = ATT_KF(3),  C1 = ATT_MFMA(k1, qr[0], f32x16{}), P1, 10); \
    ATT_GAPE(k1 = ATT_KF(4),  C0 = ATT_MFMA(k2, qr[1], C0),       P1, 12); \
    ATT_GAPE(k2 = ATT_KF(5),  C1 = ATT_MFMA(k0, qr[1], C1),       P1, 14); \
    float sacc = P0[0] + P0[1]; \
    ATT_GAPA(k0 = ATT_KF(6),  C0 = ATT_MFMA(k1, qr[2], C0),       P0[2], P0[3], P0[4], P0[5],     pw0[0] = ATT_PKW(P0, 0),  pw0[1] = ATT_PKW(P0, 2),  pw0); \
    ATT_GAPA(k1 = ATT_KF(7),  C1 = ATT_MFMA(k2, qr[2], C1),       P0[6], P0[7], P0[8], P0[9],     pw0[2] = ATT_PKW(P0, 4),  pw0[3] = ATT_PKW(P0, 6),  pw0); \
    ATT_GAPA(k2 = ATT_KF(8),  C0 = ATT_MFMA(k0, qr[3], C0),       P0[10], P0[11], P0[12], P0[13], pw1[0] = ATT_PKW(P0, 8),  pw1[1] = ATT_PKW(P0, 10), pw1); \
    ATT_GAPA(k0 = ATT_KF(9),  C1 = ATT_MFMA(k1, qr[3], C1),       P0[14], P0[15], P1[0], P1[1],   pw1[2] = ATT_PKW(P0, 12), pw1[3] = ATT_PKW(P0, 14), pw1); \
    ATT_GAPA(k1 = ATT_KF(10), C0 = ATT_MFMA(k2, qr[4], C0),       P1[2], P1[3], P1[4], P1[5],     pw2[0] = ATT_PKW(P1, 0),  pw2[1] = ATT_PKW(P1, 2),  pw2); \
    ATT_GAPA(k2 = ATT_KF(11), C1 = ATT_MFMA(k0, qr[4], C1),       P1[6], P1[7], P1[8], P1[9],     pw2[2] = ATT_PKW(P1, 4),  pw2[3] = ATT_PKW(P1, 6),  pw2); \
    ATT_GAPA(ATT_VRD(vA, 0),  C0 = ATT_MFMA(k1, qr[5], C0),       P1[10], P1[11], P1[12], P1[13], pw3[0] = ATT_PKW(P1, 8),  pw3[1] = ATT_PKW(P1, 10), pw3); \
    ATT_GAPA(ATT_VRD(vB, 4),  C1 = ATT_MFMA(k2, qr[5], C1),       P1[14], P1[15], 0.f, 0.f,       pw3[2] = ATT_PKW(P1, 12), pw3[3] = ATT_PKW(P1, 14), pw3); \
    lsum += sacc; \
    { const float rm = __builtin_fmaf(rowmax(C0, C1), P::SC, -mhat); resc = false;                                        \
      if (__builtin_expect(__any(rm > THR), 0)) { const float dl = __builtin_fmaxf(rm, 0.f); mhat += dl;                   \
          const float f = __builtin_amdgcn_exp2f(-dl); lsum *= f; if (hi == 0) wsf[r32] = f; resc = true; } } \
    const float nmh = -mhat; ATT_SBAR(); \
    ATT_GAPB(ATT_VRD(vC, 1), o[0] = ATT_MFMA(ATT_PAF(0), ATT_VFR(vA), o[0]), C0, 0,  C0, 1,  C0, 2); \
    ATT_GAPB(ATT_VRD(vA, 5), o[1] = ATT_MFMA(ATT_PAF(0), ATT_VFR(vB), o[1]), C0, 3,  C0, 4,  C0, 5); \
    ATT_GAPB(ATT_VRD(vB, 2), o[0] = ATT_MFMA(ATT_PAF(1), ATT_VFR(vC), o[0]), C0, 6,  C0, 7,  C0, 8); \
    ATT_GAPB(ATT_VRD(vC, 6), o[1] = ATT_MFMA(ATT_PAF(1), ATT_VFR(vA), o[1]), C0, 9,  C0, 10, C0, 11); \
    ATT_GAPB(ATT_VRD(vA, 3), o[0] = ATT_MFMA(ATT_PAF(2), ATT_VFR(vB), o[0]), C0, 12, C0, 13, C0, 14); \
    ATT_GAPB(ATT_VRD(vB, 7), o[1] = ATT_MFMA(ATT_PAF(2), ATT_VFR(vC), o[1]), C0, 15, C1, 0,  C1, 1); \
    ATT_GAPB((void)0,        o[0] = ATT_MFMA(ATT_PAF(3), ATT_VFR(vA), o[0]), C1, 2,  C1, 3,  C1, 4); \
    ATT_GAPB((void)0,        o[1] = ATT_MFMA(ATT_PAF(3), ATT_VFR(vB), o[1]), C1, 5,  C1, 6,  C1, 7); \
    } while (0)
#define ATT_WAIT23() do { if (rl) { if (three) ATT_WAIT_BAR(7); else ATT_WAIT_BAR(6); } else { if (three) ATT_WAIT_BAR(3); else ATT_WAIT_BAR(2); } } while (0)
  int t = 1;
  for (; t + 3 < NT; t += 2) {
    ATT_STEP(pB0, pB1, pA0, pA1, t, true, true);      ATT_WAIT23(); ATT_RESC(); ATT_ROT();
    ATT_STEP(pA0, pA1, pB0, pB1, t + 1, true, true);  ATT_WAIT23(); ATT_RESC(); ATT_ROT();
  }
  ATT_STEP(pB0, pB1, pA0, pA1, t, true, true);        ATT_WAIT23();    ATT_RESC(); ATT_ROT();
  ATT_STEP(pA0, pA1, pB0, pB1, t + 1, false, true);   ATT_WAIT_BAR(1); ATT_RESC(); ATT_ROT();
  ATT_STEP(pB0, pB1, pA0, pA1, t + 2, false, false);  ATT_WAIT_BAR(0); ATT_RESC(); ATT_ROT();
  rider.end(lane, rw);
  if (has_nxt) { ATT_DMAK(nxt, 0, 0); ATT_DMAK(nxt, 1, 1); }
  { { const float nmh0 = -mhat;
#pragma unroll
      for (int r = 8; r < 16; ++r) pB1[r] = ATT_EX0(pB1[r]); }
    float sacc = pB0[0] + pB0[1];
#pragma unroll
    for (int r = 2; r < 16; ++r) sacc += pB0[r];
#pragma unroll
    for (int r = 0; r < 16; ++r) sacc += pB1[r];
    lsum += sacc;
    pw0 = (u32x4){ATT_PKW(pB0, 0), ATT_PKW(pB0, 2), ATT_PKW(pB0, 4), ATT_PKW(pB0, 6)}; pw1 = (u32x4){ATT_PKW(pB0, 8), ATT_PKW(pB0, 10), ATT_PKW(pB0, 12), ATT_PKW(pB0, 14)};
    pw2 = (u32x4){ATT_PKW(pB1, 0), ATT_PKW(pB1, 2), ATT_PKW(pB1, 4), ATT_PKW(pB1, 6)}; pw3 = (u32x4){ATT_PKW(pB1, 8), ATT_PKW(pB1, 10), ATT_PKW(pB1, 12), ATT_PKW(pB1, 14)};
    pv(o, (int)(lds0 + L_V) + ((lane >> 4) & 1) * 32 + (lane & 3) * 8 + (4 * hi + ((lane & 15) >> 2)) * 64 + sl_prev * VSLOT, ATT_PAF(0), ATT_PAF(1), ATT_PAF(2), ATT_PAF(3)); }
  { auto rr = __builtin_amdgcn_permlane32_swap(__float_as_uint(lsum), __float_as_uint(lsum), false, false); lsum = __uint_as_float(rr[0]) + __uint_as_float(rr[1]); }
  if (hi == 0) { wsf[32 + r32] = lsum; pol.lse_out(wid, r32, (mhat + __builtin_amdgcn_logf(lsum)) * LN2); }
  asm volatile("s_waitcnt lgkmcnt(0)" ::: "memory");
  float rli[16];
#pragma unroll
  for (int r = 0; r < 16; ++r) rli[r] = __builtin_amdgcn_rcpf(wsf[32 + crow(r, hi)]);
  { LAS bf16* stg = (LAS bf16*)(shm + L_OST) + wid * 2048;
#pragma unroll
    for (int r = 0; r < 16; ++r) { const int orow = crow(r, hi);
#pragma unroll
      for (int d0 = 0; d0 < 2; ++d0) stg[orow * 64 + d0 * 32 + r32] = (bf16)(cvtpk_s(o[d0][r] * rli[r], 0.f) & 0xffffu); }
    asm volatile("s_waitcnt lgkmcnt(0)" ::: "memory");
#pragma unroll
    for (int i = 0; i < 4; ++i) { const int row = i * 8 + (lane >> 3), ch = lane & 7; const u32x4 v = *(const LAS u32x4*)(stg + row * 64 + ch * 8); *(u32x4*)(pol.o_ptr(wid, row) + ch * 8) = v; } }
  asm volatile("s_waitcnt lgkmcnt(0)\n\ts_barrier" ::: "memory");
#undef ATT_DMAK
#undef ATT_DMAV
}
}

constexpr int NWAVES = 8, NTHREADS = NWAVES * 64;
constexpr int DM = 1024, NTOK = 65536, GTOK = 32768;
constexpr int NEXP = 16, CAP = 4096, FF = 2816;
constexpr int N_IN0 = 2048  , N_UP = 1792, K_UP = 384, N_DIL = 4608;
constexpr float LN_EPS = 1e-5f, RMS_EPS = 1e-6f, DN_ALPHA = 1.4142135623730951f;
constexpr int KSPLIT = 8;

constexpr size_t MiB = 1u << 20;
constexpr size_t WS_CTL = 0, CTL_ZERO_BYTES = 1 * MiB;
constexpr size_t WS_MODP = 1 * MiB;
constexpr size_t WS_MODF = 14 * MiB + 384 * 1024;
constexpr size_t WS_ROPE_R = 6 * MiB;
constexpr size_t WS_ROPE_H = 7 * MiB;
static_assert(13 * MiB + (size_t)N_UP * K_UP * 2 <= WS_MODF && WS_MODF + 4 * 12 * 3072 * 4 <= 15 * MiB, "adaLN table fits behind the up-projection weights");
constexpr size_t WS_WIN0 = 9 * MiB, WS_WUP = 13 * MiB, WS_WOUT0 = 15 * MiB, WS_WDIL = 17 * MiB, WS_WOUT1 = 26 * MiB;
constexpr size_t WS_AFF = 27 * MiB, WS_SLOTOF = 31 * MiB, WS_IDX = 35 * MiB, WS_GATEV = 35 * MiB + 512 * 1024;
constexpr size_t WS_W13 = 36 * MiB, WS_W2 = 212 * MiB, WS_H = 300 * MiB, WS_R = 428 * MiB;
constexpr size_t W13_L1OFF = 88 * MiB, W2_L1OFF = 44 * MiB;
constexpr size_t WS_PROJ = WS_R, WS_A2 = WS_R + 256 * MiB, WS_KPE = WS_R + 304 * MiB, WS_QKV2 = WS_R + 308 * MiB, WS_ATT = WS_R + 532 * MiB, WS_MIX = WS_R;
constexpr size_t WS_HH = WS_R, WS_YE = WS_R + 704 * MiB;
constexpr size_t WS_QKV = WS_R, WS_OG = WS_R + 576 * MiB, WS_LSE = WS_R + 768 * MiB, WS_MRG = WS_R + 774 * MiB;
constexpr size_t WS_END = WS_R + 960 * MiB;
constexpr int CW_BAR = 4096;

constexpr int RING_BYTES = 131072, LDSCTL_OFF = RING_BYTES, MISC_OFF = LDSCTL_OFF + 320, LDS_BYTES = 147456;

typedef unsigned short bf16;
typedef unsigned v4u __attribute__((ext_vector_type(4)));
typedef unsigned v2u __attribute__((ext_vector_type(2)));
typedef unsigned v2u __attribute__((ext_vector_type(2)));
typedef float f32x4 __attribute__((ext_vector_type(4)));
typedef GAS unsigned gu32;
#define RLX_AGENT __ATOMIC_RELAXED, __HIP_MEMORY_SCOPE_AGENT
#define LDS_WAIT() asm volatile("s_waitcnt lgkmcnt(0)" ::: "memory")
__device__ __forceinline__ unsigned f2bf(float f) { return att::cvtpk_s(f, 0.f) & 0xffffu; }
__device__ __forceinline__ unsigned pk2(float lo, float hi) { return att::cvtpk_s(lo, hi); }
__device__ __forceinline__ float bflo(unsigned w) { return __uint_as_float(w << 16); }
__device__ __forceinline__ float bfhi(unsigned w) { return __uint_as_float(w & 0xffff0000u); }

#define XB_TMO      128
#define XB_XCNT(j)  (256  + 64 * (j))
#define XB_XSUB(j)  (1280 + 64 * (j))
#define XB_XGEN(j)  (2304 + 64 * (j))
#define XB_TOP      3328
#define XB_TOPGEN   3392
#define XCD_BAR_WORDS 3456
#define XB_SPIN_CAP (1u << 18)
__device__ __forceinline__ unsigned xb_ld(unsigned* p)              { return __hip_atomic_load(p, __ATOMIC_RELAXED, __HIP_MEMORY_SCOPE_AGENT); }
__device__ __forceinline__ unsigned xb_add(unsigned* p, unsigned v) { return __hip_atomic_fetch_add(p, v, __ATOMIC_RELAXED, __HIP_MEMORY_SCOPE_AGENT); }
__device__ __forceinline__ unsigned xb_xcc_id() { return (unsigned)__builtin_amdgcn_s_getreg((3 << 11) | 20) & 0xFu; }
#define XB_SPIN(cond, bar) do { unsigned _sp = 0; while (cond) { __builtin_amdgcn_s_sleep(1); \
    if ((++_sp & 255u) == 0u) { if (xb_ld(&(bar)[XB_TMO])) break; if (_sp > XB_SPIN_CAP) { atomicAdd(&(bar)[XB_TMO], 1u); break; } } } } while (0)
struct XcdBarrier { unsigned* bar; unsigned x; volatile LAS unsigned* st; };
__device__ __forceinline__ XcdBarrier xcd_barrier_post(unsigned* bar, volatile LAS unsigned* st) {
    XcdBarrier b; b.bar = bar; b.x = xb_xcc_id(); b.st = st;
    if (threadIdx.x == 0) (void)xb_add(&bar[XB_XCNT(b.x)], 1u);
    return b;
}
__device__ __forceinline__ void xcd_barrier_complete(unsigned* bar, unsigned x, unsigned& nloc, unsigned& nx) {
    const unsigned G = gridDim.x * gridDim.y * gridDim.z;
    unsigned sum, cnt, mine, sp = 0u;
    for (;;) {
        sum = 0u; cnt = 0u; mine = 0u;
#pragma unroll
        for (unsigned j = 0; j < 16; ++j) { const unsigned c = xb_ld(&bar[XB_XCNT(j)]); sum += c; cnt += (c > 0u) ? 1u : 0u; mine = (j == x) ? c : mine; }
        if (sum == G) break;
        __builtin_amdgcn_s_sleep(1);
        if ((++sp & 255u) == 0u) { if (xb_ld(&bar[XB_TMO])) break; if (sp > XB_SPIN_CAP) { atomicAdd(&bar[XB_TMO], 1u); break; } }
    }
    nloc = mine > 0u ? mine : 1u; nx = cnt > 0u ? cnt : 1u;
}
__device__ __forceinline__ void xcd_barrier(const XcdBarrier& b, int wv) {
    asm volatile("s_waitcnt vmcnt(0)" ::: "memory");
    __syncthreads();
    if (opaque_tid(wv) == 0) {
        unsigned* bar = b.bar;
        __builtin_amdgcn_s_waitcnt(0);
        unsigned nloc = b.st[0], nx = b.st[1];
        if (nloc == 0u) { xcd_barrier_complete(bar, b.x, nloc, nx); b.st[0] = nloc; b.st[1] = nx; }
        const unsigned old = xb_add(&bar[XB_XSUB(b.x)], 1u);
        const unsigned gen = old / nloc;
        if (old + 1u == (gen + 1u) * nloc) {
            __builtin_amdgcn_fence(__ATOMIC_RELEASE, "agent");
            asm volatile("s_waitcnt vmcnt(0)" ::: "memory");
            const unsigned og = xb_add(&bar[XB_TOP], 1u);
            const unsigned tg = og / nx;
            if (og + 1u == (tg + 1u) * nx) xb_add(&bar[XB_TOPGEN], 1u);
            else XB_SPIN(xb_ld(&bar[XB_TOPGEN]) == tg, bar);
            __builtin_amdgcn_fence(__ATOMIC_ACQUIRE, "agent");
            xb_add(&bar[XB_XGEN(b.x)], 1u);
            asm volatile("s_waitcnt vmcnt(0)" ::: "memory");
        } else {
            XB_SPIN(xb_ld(&bar[XB_XGEN(b.x)]) == gen, bar);
            __builtin_amdgcn_fence(__ATOMIC_ACQUIRE, "agent");
            asm volatile("s_waitcnt vmcnt(0)" ::: "memory");
        }
    }
    __syncthreads();
}

struct Params {
    const float* in[25];
    float* out; unsigned char* ws;
    int ph_lo, ph_hi;
};
typedef const __attribute__((address_space(4))) Params* PP;
__device__ __forceinline__ PP params_ptr() { PP q = (PP)__builtin_amdgcn_kernarg_segment_ptr(); asm volatile("" : "+s"(q)); return q; }
__device__ __forceinline__ int tok_bidx(int t) { return t < GTOK ? (t >> 12) : 8 + ((t - GTOK) >> 13); }
__device__ __forceinline__ int tok_pos(int t) { return t < GTOK ? (t & 4095) : (t & 8191); }
__device__ __forceinline__ const float* x_in_row(PP p, int t) { return t < GTOK ? p->in[0] + (size_t)t * DM : p->in[1] + (size_t)(t - GTOK) * DM; }

template <int CTRL> __device__ __forceinline__ float dpp_f(float v) { return __int_as_float(__builtin_amdgcn_update_dpp(0, __float_as_int(v), CTRL, 0xf, 0xf, true)); }
template <int CTRL> __device__ __forceinline__ int dpp_i(int v) { return __builtin_amdgcn_update_dpp(0, v, CTRL, 0xf, 0xf, true); }
__device__ __forceinline__ float wave_sum(float v) {
    v += dpp_f<0xB1>(v); v += dpp_f<0x4E>(v); v += dpp_f<0x141>(v); v += dpp_f<0x140>(v);
    { auto rr = __builtin_amdgcn_permlane16_swap(__float_as_uint(v), __float_as_uint(v), false, false); v = __uint_as_float(rr[0]) + __uint_as_float(rr[1]); }
    { auto rr = __builtin_amdgcn_permlane32_swap(__float_as_uint(v), __float_as_uint(v), false, false); v = __uint_as_float(rr[0]) + __uint_as_float(rr[1]); }
    return v;
}
__device__ __forceinline__ int wave_sum_i(int v) {
    v += dpp_i<0xB1>(v); v += dpp_i<0x4E>(v); v += dpp_i<0x141>(v); v += dpp_i<0x140>(v);
    { auto rr = __builtin_amdgcn_permlane16_swap((unsigned)v, (unsigned)v, false, false); v = (int)(rr[0] + rr[1]); }
    { auto rr = __builtin_amdgcn_permlane32_swap((unsigned)v, (unsigned)v, false, false); v = (int)(rr[0] + rr[1]); }
    return v;
}

__device__ const float INV_R[16] = {1.0f, 0.562341332f, 0.316227764f, 0.177827939f, 0.100000001f, 0.0562341325f, 0.0316227749f, 0.0177827943f, 0.00999999978f, 0.00562341325f, 0.00316227763f, 0.00177827943f, 0.00100000005f, 0.000562341302f, 0.000316227757f, 0.00017782794f};
__device__ const float INV_H[32] = {1.0f, 0.749894202f, 0.562341332f, 0.421696514f, 0.316227764f, 0.237137377f, 0.177827939f, 0.133352146f, 0.100000001f, 0.0749894232f, 0.0562341325f, 0.0421696492f, 0.0316227749f, 0.0237137377f, 0.0177827943f, 0.013335214f, 0.00999999978f, 0.00749894232f, 0.00562341325f, 0.00421696482f, 0.00316227763f, 0.00237137382f, 0.00177827943f, 0.00133352145f, 0.00100000005f, 0.000749894185f, 0.000562341302f, 0.000421696517f, 0.000316227757f, 0.00023713737f, 0.00017782794f, 0.00013335215f};
__device__ __forceinline__ void cvt_item(const float* __restrict__ W, int ldw, int k0, int n0, bf16* WT, size_t ldk, size_t wt0, LAS float* scr, int lane, int rs = 1) {
#pragma unroll 8
    for (int i = 0; i < 32; ++i) { const int kk = 2 * i + (lane >> 5); scr[kk * 33 + (lane & 31)] = W[(size_t)(k0 + kk) * ldw + n0 + (lane & 31)]; }
    LDS_WAIT(); asm volatile("" ::: "memory");
    const int c = lane & 7;
#pragma unroll
    for (int j = 0; j < 4; ++j) { const int n = (lane >> 3) + 8 * j; const LAS float* s = scr + (8 * c) * 33 + n;
        v4u o; o.x = pk2(s[0 * 33], s[1 * 33]); o.y = pk2(s[2 * 33], s[3 * 33]); o.z = pk2(s[4 * 33], s[5 * 33]); o.w = pk2(s[6 * 33], s[7 * 33]);
        *(GAS v4u*)(WT + wt0 + (size_t)(n * rs) * ldk + 8 * c) = o; }
    LDS_WAIT(); asm volatile("" ::: "memory");
}
constexpr float W13_QS = 64.0f, W2_QS = 256.0f, YE_QS = 16.0f;
struct CvtTile { const float* W; int ldw, k0, n0; unsigned char* WT; size_t ldkb; size_t off0; float sc; bool f8; };
__device__ __forceinline__ void cvt_tile_load(const CvtTile& T, int lane, f32x4 (&w)[16]) {
    const float* src = T.W + (size_t)(T.k0 + 16 * (lane >> 4)) * T.ldw + T.n0 + 4 * (lane & 15);
#pragma unroll
    for (int i = 0; i < 16; ++i) w[i] = *(const GAS f32x4*)(src + (size_t)i * T.ldw);
}
template <bool F8> __device__ __forceinline__ void cvt_tile_store(const CvtTile& T, int lane, const f32x4 (&w)[16]) {
    const int q = lane >> 4, c = lane & 15;
#pragma unroll
    for (int j = 0; j < 4; ++j) { unsigned char* dst = T.WT + T.off0 + (size_t)(4 * c + j) * T.ldkb + (F8 ? 16 : 32) * q;
        if constexpr (F8) { v4u o; o.x = pg8::pk4_fp8(w[0][j] * T.sc, w[1][j] * T.sc, w[2][j] * T.sc, w[3][j] * T.sc); o.y = pg8::pk4_fp8(w[4][j] * T.sc, w[5][j] * T.sc, w[6][j] * T.sc, w[7][j] * T.sc);
            o.z = pg8::pk4_fp8(w[8][j] * T.sc, w[9][j] * T.sc, w[10][j] * T.sc, w[11][j] * T.sc); o.w = pg8::pk4_fp8(w[12][j] * T.sc, w[13][j] * T.sc, w[14][j] * T.sc, w[15][j] * T.sc); *(GAS v4u*)dst = o; }
        else { v4u o0, o1; o0.x = pk2(w[0][j], w[1][j]); o0.y = pk2(w[2][j], w[3][j]); o0.z = pk2(w[4][j], w[5][j]); o0.w = pk2(w[6][j], w[7][j]);
            o1.x = pk2(w[8][j], w[9][j]); o1.y = pk2(w[10][j], w[11][j]); o1.z = pk2(w[12][j], w[13][j]); o1.w = pk2(w[14][j], w[15][j]); *(GAS v4u*)dst = o0; *(GAS v4u*)(dst + 16) = o1; } }
}
__device__ __forceinline__ void cvt_tile_store_any(const CvtTile& T, int lane, const f32x4 (&w)[16]) { if (T.f8) cvt_tile_store<true>(T, lane, w); else cvt_tile_store<false>(T, lane, w); }
constexpr int MOE_TILES = NEXP * 2112;
__device__ __forceinline__ CvtTile moe_tile(PP p, int layer, int it, int ES) {
    CvtTile T; const int e = it / 2112, r = it % 2112, which = r / 704, q = r % 704;
    if (which < 2) { const int kb = q / 44, nb = q % 44; T.k0 = kb * 64; T.n0 = nb * 64; T.W = p->in[22 + which] + ((size_t)layer * NEXP + e) * (size_t)DM * FF; T.ldw = FF;
        const size_t row0 = (size_t)e * 5632 + (size_t)(T.n0 >> 7) * 256 + which * 128 + (T.n0 & 127);
        T.WT = p->ws + WS_W13 + (layer ? W13_L1OFF : 0); T.ldkb = (size_t)DM * ES; T.off0 = (row0 * DM + T.k0) * ES; T.sc = W13_QS; T.f8 = ES == 1;
    } else { const int kb = q / 16, nb = q % 16; T.k0 = kb * 64; T.n0 = nb * 64; T.W = p->in[24] + ((size_t)layer * NEXP + e) * (size_t)FF * DM; T.ldw = DM;
        T.WT = p->ws + WS_W2 + (layer ? W2_L1OFF : 0); T.ldkb = (size_t)FF; T.off0 = ((size_t)e * DM + T.n0) * FF + T.k0; T.sc = W2_QS; T.f8 = true; }
    return T;
}

__device__ __forceinline__ void p0_prologue(PP p, LAS unsigned char* lds, int vcu, int G, int tid, int lane, int wave) {
    LAS float* scr = (LAS float*)(lds + wave * 8448);
    LAS float* sc = (LAS float*)(lds + 69632);
    for (int i = tid; i < 12 * DM; i += NTHREADS) { const int b = i >> 10, k = i & 1023; const float c = b < 8 ? p->in[2][b * DM + k] : p->in[3][(b - 8) * DM + k];
        sc[i] = c / (1.0f + __expf(-c)); }
    __syncthreads();
    const int gw = vcu * NWAVES + wave, NGW = G * NWAVES;
    for (int it = gw; it < 4 * 48 * KSPLIT; it += NGW) {
        const int kc = it % KSPLIT, jb = (it / KSPLIT) % 48, mi = it / (KSPLIT * 48);
        const float* W = (mi & 1 ? p->in[17] : p->in[13]) + (size_t)(mi >> 1) * DM * 3072 + jb * 64 + lane;
        float acc[12];
#pragma unroll
        for (int b = 0; b < 12; ++b) acc[b] = 0.f;
        for (int k0 = kc * 128; k0 < kc * 128 + 128; k0 += 8) {
            float w[8];
#pragma unroll
            for (int i = 0; i < 8; ++i) w[i] = W[(size_t)(k0 + i) * 3072];
#pragma unroll
            for (int b = 0; b < 12; ++b) { const f32x4 s0 = *(const LAS f32x4*)(sc + b * DM + k0), s1 = *(const LAS f32x4*)(sc + b * DM + k0 + 4);
                acc[b] += w[0] * s0[0] + w[1] * s0[1] + w[2] * s0[2] + w[3] * s0[3] + w[4] * s1[0] + w[5] * s1[1] + w[6] * s1[2] + w[7] * s1[3]; }
        }
        float* o = (float*)(p->ws + WS_MODP) + ((size_t)(kc * 4 + mi) * 12) * 3072 + jb * 64 + lane;
#pragma unroll
        for (int b = 0; b < 12; ++b) o[(size_t)b * 3072] = acc[b];
    }
    for (int i = gw * 64 + lane; i < 8192 * 48; i += NGW * 64) {
        const int pos = i / 48, j = i % 48; const float inv = j < 16 ? INV_R[j] : INV_H[j - 16];
        const float ang = (float)pos * inv; double rev = (double)ang * 0.15915494309189535; rev -= floor(rev);
        const float rf = (float)rev; float2 cs; cs.x = __builtin_amdgcn_cosf(rf); cs.y = __builtin_amdgcn_sinf(rf);
        if (j < 16) ((float2*)(p->ws + WS_ROPE_R))[pos * 16 + j] = cs; else ((float2*)(p->ws + WS_ROPE_H))[pos * 32 + (j - 16)] = cs;
    }
    { const v4u z = {0u, 0u, 0u, 0u};
      for (int i = gw * 64 + lane; i < 12288 + 12288 + 32768; i += NGW * 64) {
        if (i < 12288) ((GAS v4u*)(p->ws + WS_WIN0 + (size_t)1952 * DM * 2))[i] = z;
        else if (i < 24576) { const int q = i - 12288, row = q >> 4, c = q & 15; *(GAS v4u*)(p->ws + WS_WUP + ((size_t)row * K_UP + 256) * 2 + c * 16) = z; }
        else { const int q = i - 24576, row = 768 + (q >> 5), c = q & 31; *(GAS v4u*)(p->ws + WS_WUP + (size_t)row * K_UP * 2 + c * 16) = z; } } }
    constexpr int I0 = 16 * 61, I1 = 4 * 24, I2 = 2 * 32, I3 = 16 * 32, I4 = 16 * 144, I5 = 8 * 32;
    for (int it = gw; it < I0 + I1 + I2 + I3 + I4 + I5; it += NGW) {
        int r = it;
        if (r < I0) { const int kb = r / 61, nb = r % 61; cvt_item(p->in[4], 1952, kb * 64, nb * 32, (bf16*)(p->ws + WS_WIN0), DM, (size_t)nb * 32 * DM + kb * 64, scr, lane); continue; } r -= I0;
        if (r < I1) { const int kb = r / 24, nb = r % 24; cvt_item(p->in[7], 768, kb * 64, nb * 32, (bf16*)(p->ws + WS_WUP), K_UP, (size_t)nb * 32 * K_UP + kb * 64, scr, lane); continue; } r -= I1;
        if (r < I2) { const int kb = r / 32, nb = r % 32; cvt_item(p->in[9], 1024, kb * 64, nb * 32, (bf16*)(p->ws + WS_WUP), K_UP, (size_t)(768 + nb * 32) * K_UP + 256 + kb * 64, scr, lane); continue; } r -= I2;
        if (r < I3) { const int kb = r / 32, nb = r % 32; cvt_item(p->in[10], 1024, kb * 64, nb * 32, (bf16*)(p->ws + WS_WOUT0), DM, (size_t)nb * 32 * DM + kb * 64, scr, lane); continue; } r -= I3;
        if (r < I4) { const int kb = r / 144, nb = r % 144, c0 = nb * 32;
            const bool qk = (c0 % 1536) < 1024; const int row0 = qk ? (c0 & ~63) + ((c0 >> 5) & 1) : c0;
            cvt_item(p->in[11], N_DIL, kb * 64, c0, (bf16*)(p->ws + WS_WDIL), DM, (size_t)row0 * DM + kb * 64, scr, lane, qk ? 2 : 1); continue; } r -= I4;
        { const int kb = r / 32, nb = r % 32; cvt_item(p->in[12], 1024, kb * 64, nb * 32, (bf16*)(p->ws + WS_WOUT1), 512, (size_t)nb * 32 * 512 + kb * 64, scr, lane); }
    }
}

__device__ __forceinline__ float mod_reduce(PP p, int mi, int b, int j) {
    float s = (mi & 1 ? p->in[18] : p->in[14])[(size_t)(mi >> 1) * 3072 + j];
    const float* mp = (const float*)(p->ws + WS_MODP) + ((size_t)mi * 12 + b) * 3072 + j;
#pragma unroll
    for (int kc = 0; kc < KSPLIT; ++kc) s += mp[(size_t)kc * 4 * 12 * 3072];
    return s;
}
template <bool FINAL> __device__ __forceinline__ void load_mod_vec(PP p, LAS float* dst, int mi, int b, int part, int tid) {
    if constexpr (FINAL) { const float* mf = (const float*)(p->ws + WS_MODF) + ((size_t)mi * 12 + b) * 3072 + part * DM; for (int j = tid; j < DM; j += NTHREADS) dst[j] = mf[j]; }
    else { for (int j = tid; j < DM; j += NTHREADS) dst[j] = mod_reduce(p, mi, b, part * DM + j); }
}
__device__ __forceinline__ void store_row_bf16(bf16* orow, const f32x4 (&v)[4], int lane) {
    GAS unsigned long long* o8 = (GAS unsigned long long*)orow + lane;
#pragma unroll
    for (int j = 0; j < 4; ++j) o8[64 * j] = (unsigned long long)pk2(v[j].x, v[j].y) | ((unsigned long long)pk2(v[j].z, v[j].w) << 32);
}

__device__ __forceinline__ void p1_modulate(PP p, LAS unsigned char* lds, int vcu, int G, int tid, int lane, int wave) {
    LAS float* vsh = (LAS float*)lds; LAS float* vsc = vsh + DM;
    for (int i = vcu * NTHREADS + tid; i < 4 * 12 * 3072; i += G * NTHREADS) ((float*)(p->ws + WS_MODF))[i] = mod_reduce(p, i / (12 * 3072), (i / 3072) % 12, i % 3072);
    for (int ch = vcu; ch < NTOK / 256; ch += G) {
        const int t0 = ch * 256, b = tok_bidx(t0);
        __syncthreads();
        load_mod_vec<false>(p, vsh, 0, b, 0, tid); load_mod_vec<false>(p, vsc, 0, b, 1, tid);
        __syncthreads();
        _Pragma("unroll 1") for (int i = 0; i < 32; ++i) { const int t = t0 + wave * 32 + i;
            const GAS f32x4* xr = (const GAS f32x4*)x_in_row(p, t) + lane; f32x4 v[4];
#pragma unroll
            for (int j = 0; j < 4; ++j) { const f32x4 x = xr[64 * j]; const f32x4 sh = *(const LAS f32x4*)(vsh + 4 * lane + 256 * j), sc = *(const LAS f32x4*)(vsc + 4 * lane + 256 * j); v[j] = x * (1.0f + sc) + sh; }
            store_row_bf16((bf16*)(p->ws + WS_H) + (size_t)t * DM, v, lane); }
    }
}

__device__ __forceinline__ void p3_mla_prep(PP p, int vcu, int G, int lane, int wave) {
    const int gw = vcu * NWAVES + wave, NGW = G * NWAVES;
    const bf16* proj = (const bf16*)(p->ws + WS_PROJ); bf16* a2 = (bf16*)(p->ws + WS_A2); bf16* kpe = (bf16*)(p->ws + WS_KPE);
    const f32x4 qn = *((const f32x4*)p->in[6] + lane); const float2 kn = *((const float2*)p->in[8] + lane);
    for (int t = gw; t < NTOK; t += NGW) {
        const bf16* row = proj + (size_t)t * N_IN0;
        const v2u ql = *(const v2u*)(row + 1536 + 4 * lane); const unsigned kl = *(const unsigned*)(row + 1792 + 2 * lane);
        const float q0 = bflo(ql.x), q1 = bfhi(ql.x), q2 = bflo(ql.y), q3 = bfhi(ql.y), k0 = bflo(kl), k1 = bfhi(kl);
        const float qs = wave_sum(q0 * q0 + q1 * q1 + q2 * q2 + q3 * q3), ks = wave_sum(k0 * k0 + k1 * k1);
        const float qr = 1.0f / sqrtf(qs * (1.0f / 256.0f) + RMS_EPS), kr = 1.0f / sqrtf(ks * (1.0f / 128.0f) + RMS_EPS);
        v2u qo; qo.x = pk2(q0 * qr * qn.x, q1 * qr * qn.y); qo.y = pk2(q2 * qr * qn.z, q3 * qr * qn.w);
        *(v2u*)(a2 + (size_t)t * K_UP + 4 * lane) = qo;
        *(unsigned*)(a2 + (size_t)t * K_UP + 256 + 2 * lane) = pk2(k0 * kr * kn.x, k1 * kr * kn.y);
        if (lane < 16) { const float x1 = bflo((unsigned)row[1920 + lane]), x2 = bflo((unsigned)row[1936 + lane]);
            const float2 cs = ((const float2*)(p->ws + WS_ROPE_R))[tok_pos(t) * 16 + lane];
            kpe[(size_t)t * 32 + lane] = (bf16)f2bf(x1 * cs.x - x2 * cs.y); kpe[(size_t)t * 32 + 16 + lane] = (bf16)f2bf(x1 * cs.y + x2 * cs.x); }
    }
}

__device__ __forceinline__ int moe1_split(int G) { return G >= 4 * NEXP ? MOE_TILES / 2 : MOE_TILES; }
__device__ __forceinline__ int moe1_split2(int G) { return G >= 4 * NEXP ? MOE_TILES - MOE_TILES / 4 : MOE_TILES; }
struct NoRider { static constexpr int NW = 1; __device__ __forceinline__ void begin(int, f32x4 (&)[1]) {} __device__ __forceinline__ int mid(int, int, int, f32x4 (&)[1]) { return 0; } __device__ __forceinline__ void end(int, f32x4 (&)[1]) {} };
template <bool F8> struct CvtRider {
    static constexpr int NW = 16;
    PP p; int layer, layer_b, ka, kb; CvtTile T; bool live;
    __device__ __forceinline__ void init(PP p_, int layer_, int ka_, int kb_, int layer_b_ = -1) { p = p_; layer = layer_; layer_b = layer_b_ < 0 ? layer_ : layer_b_; ka = ka_; kb = kb_; live = false; }
    __device__ __forceinline__ void begin(int lane, f32x4 (&w)[16]) { if (ka >= 0) { T = moe_tile(p, layer, ka, F8 ? 1 : 2); cvt_tile_load(T, lane, w); live = true; } }
    __device__ __forceinline__ int mid(int t, int NT, int lane, f32x4 (&w)[16]) { if (t == (NT >> 1) && kb >= 0) { int n = 16; if (live) { cvt_tile_store_any(T, lane, w); n += T.f8 ? 4 : 8; } T = moe_tile(p, layer_b, kb, F8 ? 1 : 2); cvt_tile_load(T, lane, w); live = true; return n; } return 0; }
    __device__ __forceinline__ void end(int lane, f32x4 (&w)[16]) { if (live) { cvt_tile_store_any(T, lane, w); live = false; } }
};
struct CvtStream {
    static constexpr int NW = 4;
    PP p; int ka, kb, nb; CvtTile T; bool live;
    __device__ __forceinline__ void init(PP p_, int ka_, int kb_) { p = p_; ka = ka_; kb = kb_; nb = 0; live = false; }
    __device__ __forceinline__ void begin(int, f32x4 (&)[4]) {}
    __device__ __forceinline__ void store(int lane, const f32x4 (&w)[4]) { const int r = lane >> 2, c4 = lane & 3, q4 = (nb - 1) & 3;
#pragma unroll
        for (int j = 0; j < 4; ++j) { unsigned char* dst = T.WT + T.off0 + (size_t)(16 * q4 + 4 * c4 + j) * T.ldkb;
            if (T.f8) *(GAS unsigned*)(dst + 4 * r) = pg8::pk4_fp8(w[0][j] * T.sc, w[1][j] * T.sc, w[2][j] * T.sc, w[3][j] * T.sc);
            else { v2u o; o.x = pk2(w[0][j], w[1][j]); o.y = pk2(w[2][j], w[3][j]); *(GAS v2u*)(dst + 8 * r) = o; } }
        live = false; }
    __device__ __forceinline__ bool pre(int s, int lane, f32x4 (&w)[4]) { if ((s & 3) != 0) return false; if (live) store(lane, w); return (nb < 4 ? ka : (nb < 8 ? kb : -1)) >= 0; }
    __device__ __forceinline__ void post(int lane, f32x4 (&w)[4]) { if ((nb & 3) == 0) T = moe_tile(p, 0, nb < 4 ? ka : kb, 1);
        const float* src = T.W + (size_t)(T.k0 + 4 * (lane >> 2)) * T.ldw + T.n0 + 16 * (nb & 3) + 4 * (lane & 3);
#pragma unroll
        for (int i = 0; i < 4; ++i) w[i] = *(const GAS f32x4*)(src + (size_t)i * T.ldw);
        ++nb; live = true; }
    __device__ __forceinline__ void end(int lane, f32x4 (&w)[4]) { if (live) store(lane, w); }
};
__device__ __forceinline__ void decode_unit(int r, int& S, int& tok0, int& h, int& within) {
    if (r < 1024) { const int bh = r >> 4; within = r & 15; S = 4096; tok0 = (bh >> 3) * 4096; h = bh & 7; }
    else { const int r2 = r - 1024, bh = r2 >> 5; within = r2 & 31; S = 8192; tok0 = GTOK + (bh >> 3) * 8192; h = bh & 7; }
}
__device__ __forceinline__ int clampi(int v, int lo, int hi) { return v < lo ? lo : (v > hi ? hi : v); }
using att::bf16x8; using att::f32x16;
__device__ __forceinline__ void rope8(bf16x8& a, bf16x8& b, const float2* cs) {
#pragma unroll
    for (int j = 0; j < 8; ++j) { const float x1 = att::bf2f(a[j]), x2 = att::bf2f(b[j]); const float2 c = cs[j];
        a[j] = (short)f2bf(x1 * c.x - x2 * c.y); b[j] = (short)f2bf(x1 * c.y + x2 * c.x); }
}

struct PolNA {
    static constexpr int NLSE = 0; static constexpr int ND0 = 4; static constexpr bool FUSED = false; static constexpr float SC = 1.0f;
    __device__ __forceinline__ void mask(f32x16&, f32x16&, int, int, int, int) const {}
    const att::bf16* proj; att::bf16* out; const LAS float* tab; int tok0, h, R4, rows, kr_lo, nt;
    __device__ __forceinline__ void init(int r, const unsigned char* ws, const LAS float* tab_all) {
        int S, within; decode_unit(r, S, tok0, h, within); R4 = within; rows = S >> 6;
        kr_lo = clampi(4 * R4 - 4, 0, rows - 8); nt = clampi(4 * R4 - 1, 0, rows - 8) + 8 - kr_lo;
        proj = (const att::bf16*)(ws + WS_PROJ); out = (att::bf16*)(ws + WS_ATT); tab = tab_all + h * 465; }
    __device__ __forceinline__ int ntiles() const { return nt; }
    __device__ __forceinline__ const att::bf16* q_ptr(int wid, int r32) const { return proj + (size_t)(tok0 + (4 * R4 + (wid >> 1)) * 64 + (wid & 1) * 32 + r32) * N_IN0 + h * 64; }
    __device__ __forceinline__ void q_fix(bf16x8 (&)[ND0], int, int, int) const {}
    __device__ __forceinline__ const void* k_src(int t, int wid, int lane) const { return proj + (size_t)(tok0 + (kr_lo + t) * 64 + lane) * N_IN0 + 512 + h * 64 + wid * 8; }
    __device__ __forceinline__ const void* k2_src(int, int, int) const { return nullptr; }
    __device__ __forceinline__ const void* v_src(int t, int wid, int lane) const { return proj + (size_t)(tok0 + (kr_lo + t) * 64 + 16 * (wid & 3) + (lane >> 2)) * N_IN0 + 1024 + h * 64 + (wid >> 2) * 32 + (lane & 3) * 8; }
    __device__ __forceinline__ bool needs(int t, int wid) const { const int r = 4 * R4 + (wid >> 1), r0 = clampi(r - 4, 0, rows - 8), kr = kr_lo + t; return kr >= r0 && kr < r0 + 8; }
    __device__ __forceinline__ bool variant(int wid) const { return (wid & 1) != 0; }
    static constexpr __device__ bool dead(int var, int half, int i) { return var == 0 ? (half == 1 && i >= 4) : (half == 0 && i < 12); }
    static constexpr __device__ int live4(int var) { return var == 0 ? 0 : 12; }
    static constexpr __device__ int kslo(int var) { return var == 0 ? 0 : 1; }
    static constexpr __device__ int kshi(int var) { return var == 0 ? 3 : 4; }
    template <int VAR> __device__ __forceinline__ void transform_v(f32x16& p0, f32x16& p1, int t, int wid, int r32, int hi) const {
        const int r = 4 * R4 + (wid >> 1), qc = (wid & 1) * 32 + r32, c0 = clampi(qc - 8, 0, 48);
        const LAS float* trow = tab + (kr_lo + t - r + 7) * 31 + (15 - qc);
        const LAS float* th = trow + 4 * hi; const unsigned u0 = (unsigned)(4 * hi - c0);
#pragma unroll
        for (int i = 0; i < 16; ++i) { const int kq = (i & 3) + 8 * (i >> 2);
            if (!dead(VAR, 0, i)) { const float b_ = th[kq]; const float f_ = __builtin_fmaf(p0[i], 0.125f * att::LOG2E, b_); p0[i] = (u0 + (unsigned)kq < 16u) ? f_ : -INFINITY; }
            if (!dead(VAR, 1, i)) { const float b_ = th[kq + 32]; const float f_ = __builtin_fmaf(p1[i], 0.125f * att::LOG2E, b_); p1[i] = (u0 + (unsigned)(kq + 32) < 16u) ? f_ : -INFINITY; } }
    }
    __device__ __forceinline__ att::bf16* o_ptr(int wid, int row) const { return out + (size_t)(tok0 + (4 * R4 + (wid >> 1)) * 64 + (wid & 1) * 32 + row) * DM + h * 64; }
    __device__ __forceinline__ void lse_out(int, int, float) const {}
};
struct PolMLA {
    static constexpr int NLSE = 0; static constexpr int ND0 = 6; static constexpr bool FUSED = true; static constexpr float SC = 0.10206207261596577f * att::LOG2E;
    __device__ __forceinline__ void mask(f32x16&, f32x16&, int, int, int, int) const {}
    const att::bf16* qkv2; const att::bf16* kpe; att::bf16* out; const float2* rope; int tok0, h, qt, S;
    __device__ __forceinline__ void init(int r, const unsigned char* ws) { int within; decode_unit(r, S, tok0, h, within); qt = within;
        qkv2 = (const att::bf16*)(ws + WS_QKV2); kpe = (const att::bf16*)(ws + WS_KPE); out = (att::bf16*)(ws + WS_ATT); rope = (const float2*)(ws + WS_ROPE_R); }
    __device__ __forceinline__ int ntiles() const { return S >> 6; }
    __device__ __forceinline__ const att::bf16* q_ptr(int wid, int r32) const { return qkv2 + (size_t)(tok0 + qt * 256 + wid * 32 + r32) * N_UP + h * 96; }
    __device__ __forceinline__ void q_fix(bf16x8 (&qr)[ND0], int wid, int r32, int hi) const { rope8(qr[4], qr[5], rope + (size_t)(qt * 256 + wid * 32 + r32) * 16 + 8 * hi); }
    __device__ __forceinline__ const void* k_src(int t, int wid, int lane) const { return qkv2 + (size_t)(tok0 + t * 64 + lane) * N_UP + 768 + h * 128 + wid * 8; }
    static constexpr int KSTRIDE = 64 * N_UP * 2, K2STRIDE = 64 * 32 * 2;
    __device__ __forceinline__ const unsigned char* k_base() const { return (const unsigned char*)(qkv2 + (size_t)tok0 * N_UP + 768 + h * 128); }
    __device__ __forceinline__ const unsigned char* k2_base() const { return (const unsigned char*)(kpe + (size_t)tok0 * 32); }
    static __device__ __forceinline__ unsigned k_lofs(int wid, int lane) { return (unsigned)(lane * N_UP + wid * 8) * 2u; }
    static __device__ __forceinline__ unsigned k2_lofs(int wid, int lane) { return (unsigned)(lane * 32 + wid * 8) * 2u; }
    static __device__ __forceinline__ unsigned v_lofs(int wid, int lane) { return (unsigned)((16 * (wid & 3) + (lane >> 2)) * N_UP + 64 + (wid >> 2) * 32 + (lane & 3) * 8) * 2u; }
    __device__ __forceinline__ const void* k2_src(int t, int wid, int lane) const { return kpe + (size_t)(tok0 + t * 64 + lane) * 32 + wid * 8; }
    __device__ __forceinline__ const void* v_src(int t, int wid, int lane) const { return qkv2 + (size_t)(tok0 + t * 64 + 16 * (wid & 3) + (lane >> 2)) * N_UP + 768 + h * 128 + 64 + (wid >> 2) * 32 + (lane & 3) * 8; }
    __device__ __forceinline__ bool needs(int, int) const { return true; }
    __device__ __forceinline__ void transform(f32x16&, f32x16&, int, int, int, int) const {}
    __device__ __forceinline__ att::bf16* o_ptr(int wid, int row) const { return out + (size_t)(tok0 + qt * 256 + wid * 32 + row) * DM + 512 + h * 64; }
    __device__ __forceinline__ void lse_out(int, int, float) const {}
};
struct PolDil {
    static constexpr int NLSE = 1;   static constexpr int ND0 = 4; static constexpr bool FUSED = true; static constexpr float SC = 0.125f * att::LOG2E;
    const att::bf16* qkv; att::bf16* og; float* lse; const float2* rope; int gi, d, tok0, h, rho, blk, ks, t_lo, nt, rbase;
    __device__ __forceinline__ void init(int r, int gi_, const unsigned char* ws) { int S, within; decode_unit(r, S, tok0, h, within); gi = gi_; d = 1 << (2 * gi);
        const int Ssub = S / d, nblk = Ssub >> 8; rho = within / nblk; blk = within % nblk; ks = 256 * blk - 64; t_lo = ks < 0 ? 1 : 0; rbase = tok0 + rho * Ssub;
        int t_hi = (Ssub - ks) >> 6; if (t_hi > 6) t_hi = 6; nt = t_hi - t_lo;
        qkv = (const att::bf16*)(ws + WS_QKV); og = (att::bf16*)(ws + WS_OG) + (size_t)gi * NTOK * 512; lse = (float*)(ws + WS_LSE) + (size_t)gi * NTOK * 8; rope = (const float2*)(ws + WS_ROPE_H); }
    __device__ __forceinline__ int ntiles() const { return nt; }
    __device__ __forceinline__ int qtok(int wid, int row) const { return tok0 + (256 * blk + 32 * wid + row) * d + rho; }
    __device__ __forceinline__ const att::bf16* q_ptr(int wid, int r32) const { return qkv + (size_t)(rbase + 256 * blk + 32 * wid + r32) * N_DIL + gi * 1536 + h * 64; }
    __device__ __forceinline__ void q_fix(bf16x8 (&)[ND0], int, int, int) const {}
    __device__ __forceinline__ const void* k_src(int t, int wid, int lane) const { return qkv + (size_t)(rbase + ks + 64 * (t + t_lo) + lane) * N_DIL + gi * 1536 + 512 + h * 64 + wid * 8; }
    __device__ __forceinline__ const void* k2_src(int, int, int) const { return nullptr; }
    __device__ __forceinline__ const void* v_src(int t, int wid, int lane) const { return qkv + (size_t)(rbase + ks + 64 * (t + t_lo) + 16 * (wid & 3) + (lane >> 2)) * N_DIL + gi * 1536 + 1024 + h * 64 + (wid >> 2) * 32 + (lane & 3) * 8; }
    __device__ __forceinline__ bool needs(int t, int wid) const { const int kt0 = ks + 64 * (t + t_lo), q0 = 256 * blk + 32 * wid; return kt0 + 63 >= q0 - 64 && kt0 <= q0 + 95; }
    __device__ __forceinline__ void transform(f32x16&, f32x16&, int, int, int, int) const {}
    __device__ __forceinline__ void mask(f32x16& p0, f32x16& p1, int t, int wid, int r32, int hi) const {
        const int rel0 = ks + 64 * (t + t_lo) - (256 * blk + 32 * wid);
        if (rel0 == 0 || rel0 == -32) return;
        const unsigned base = (unsigned)(rel0 - r32 + 64 + 4 * hi);
#pragma unroll
        for (int i = 0; i < 16; ++i) { const unsigned c = (unsigned)((i & 3) + 8 * (i >> 2));
            p0[i] = (base + c <= 128u) ? p0[i] : -INFINITY; p1[i] = (base + c + 32u <= 128u) ? p1[i] : -INFINITY; }
    }
    __device__ __forceinline__ att::bf16* o_ptr(int wid, int row) const { return og + (size_t)qtok(wid, row) * 512 + h * 64; }
    __device__ __forceinline__ void lse_out(int wid, int r32, float v) const { lse[(size_t)qtok(wid, r32) * 8 + h] = v; }
};


constexpr int DS_SLOT = 32768, DS_KB = 16384, DS_OST = 3 * DS_SLOT;
static_assert(DS_OST + 8 * 4096 <= RING_BYTES, "dilated attention LDS");
__device__ __forceinline__ void dil_unit_init(PolDil& P_, int n, int NU, int vcu, int G, const unsigned char* ws) {
    const bool ok = n >= 0 && n < NU; const int u = ok ? vcu + n * G : vcu;
    P_.init(u & 2047, u >> 11, ws); if (!ok) P_.nt = 0;
}
__device__ __forceinline__ void dil_skew(int wv, PP p, LAS unsigned char* shm, int vcu, int G) {
    using namespace att;
    const unsigned char* ws = p->ws;
    const int tid = opaque_tid(wv), lane = tid & 63, r32 = lane & 31, hi = lane >> 5; const int wid = __builtin_amdgcn_readfirstlane(tid >> 6);
    const int j = wid >> 1;
    const unsigned lds0 = (unsigned)(uintptr_t)shm;
    LAS float* wsf = (LAS float*)(shm + DS_OST + wid * 4096);
    int NU = 0; for (int u = vcu; u < 3 * 2048; u += G) ++NU;
    PolDil pPrev, pCur, pNext; dil_unit_init(pPrev, -1, NU, vcu, G, ws); dil_unit_init(pCur, 0, NU, vcu, G, ws); dil_unit_init(pNext, 1, NU, vcu, G, ws);
#define DS_DMA(PL, i, sl) do { int t_ = (i) - (PL).t_lo; const int tm_ = (PL).nt > 0 ? (PL).nt - 1 : 0; t_ = t_ < 0 ? 0 : (t_ > tm_ ? tm_ : t_); \
      const unsigned b_ = (unsigned)__builtin_amdgcn_readfirstlane(lds0 + (sl) * DS_SLOT + ((i) >= 3 ? DS_KB : 0) + wid * 1024); \
      glds16((PL).k_src(t_, wid, lane), b_); glds16((PL).v_src(t_, wid, lane), b_ + 8192u); } while (0)
    bf16x8 qr[4], qn[4];
    { const bf16* qp = pCur.q_ptr(wid, r32);
#pragma unroll
      for (int d0 = 0; d0 < 4; ++d0) qr[d0] = *reinterpret_cast<const bf16x8*>(qp + d0 * 16 + hi * 8); }
#pragma unroll
    for (int d0 = 0; d0 < 4; ++d0) qn[d0] = qr[d0];
    DS_DMA(pCur, 0, 0); DS_DMA(pPrev, 3, 0); DS_DMA(pCur, 1, 1); DS_DMA(pPrev, 4, 1);
    float m = -1e30f, lsum = 0.f; f32x16 o[2]; o[0] = f32x16{}; o[1] = f32x16{};
    const int vlane = ((lane >> 4) & 1) * 32 + (lane & 3) * 8 + (4 * hi + ((lane & 15) >> 2)) * 64;
    ATT_WAIT_BAR(4);
    int s_cur = 0, x_prev = 0;
#define DS_STEP(r) do { \
    { const int sl2 = s_cur >= 1 ? s_cur - 1 : 2; \
      if ((r) == 0) { DS_DMA(pCur, 2, sl2); DS_DMA(pPrev, 5, sl2); } else if ((r) == 1) { DS_DMA(pNext, 0, sl2); DS_DMA(pCur, 3, sl2); } else { DS_DMA(pNext, 1, sl2); DS_DMA(pCur, 4, sl2); } } \
    const bool inA = j <= (r); const PolDil own = inA ? pCur : pPrev; const int i = inA ? (r) : 3 + (r); const int k = i - j; int x_cur = 0; \
    const bool live = own.nt > 0; \
    if (live && k == 0) { m = -1e30f; lsum = 0.f; o[0] = f32x16{}; o[1] = f32x16{}; \
      const PolDil suc = inA ? pNext : pCur; \
      if (suc.nt > 0) { const bf16* qp = suc.q_ptr(wid, r32); \
        _Pragma("unroll") for (int d0 = 0; d0 < 4; ++d0) qn[d0] = *reinterpret_cast<const bf16x8*>(qp + d0 * 16 + hi * 8); \
        x_cur = 4; } } \
    if (live && i >= own.t_lo && i < own.t_lo + own.nt) { \
      const LAS unsigned char* kt = shm + s_cur * DS_SLOT + (inA ? 0 : DS_KB); \
      f32x16 p0 = f32x16{}, p1 = f32x16{}; \
      qkt<4>(p0, p1, kt, qr, r32, hi); \
      { const int rel0 = own.ks + 64 * i - (256 * own.blk + 32 * wid);        \
        if (!(rel0 == 0 || rel0 == -32)) { const unsigned base = (unsigned)(rel0 - r32 + 64 + 4 * hi); \
          _Pragma("unroll") for (int ii = 0; ii < 16; ++ii) { const unsigned c = (unsigned)((ii & 3) + 8 * (ii >> 2)); \
            p0[ii] = (base + c <= 128u) ? p0[ii] : -INFINITY; p1[ii] = (base + c + 32u <= 128u) ? p1[ii] : -INFINITY; } } } \
      const float rm = rowmax(p0, p1) * PolDil::SC; \
      const bool grow = rm > m + THR; \
      if (__any(grow)) { const float mn = grow ? rm : m; const float f = __builtin_amdgcn_exp2f(m - mn); m = mn; lsum *= f; \
        if (hi == 0) wsf[r32] = f; \
        asm volatile("s_waitcnt lgkmcnt(0)" ::: "memory"); \
        _Pragma("unroll") for (int rr = 0; rr < 16; ++rr) { const float ff = wsf[crow(rr, hi)]; o[0][rr] *= ff; o[1][rr] *= ff; } } \
      float sacc = 0.f; \
      _Pragma("unroll") for (int rr = 0; rr < 16; ++rr) { p0[rr] = __builtin_amdgcn_exp2f(__builtin_fmaf(p0[rr], PolDil::SC, -m)); p1[rr] = __builtin_amdgcn_exp2f(__builtin_fmaf(p1[rr], PolDil::SC, -m)); sacc += p0[rr]; sacc += p1[rr]; } \
      lsum += sacc; \
      u32x4 pw0, pw1, pw2, pw3; \
      pw0 = (u32x4){cvtpk_s(p0[0], p0[1]), cvtpk_s(p0[2], p0[3]), cvtpk_s(p0[4], p0[5]), cvtpk_s(p0[6], p0[7])}; \
      pw1 = (u32x4){cvtpk_s(p0[8], p0[9]), cvtpk_s(p0[10], p0[11]), cvtpk_s(p0[12], p0[13]), cvtpk_s(p0[14], p0[15])}; \
      pw2 = (u32x4){cvtpk_s(p1[0], p1[1]), cvtpk_s(p1[2], p1[3]), cvtpk_s(p1[4], p1[5]), cvtpk_s(p1[6], p1[7])}; \
      pw3 = (u32x4){cvtpk_s(p1[8], p1[9]), cvtpk_s(p1[10], p1[11]), cvtpk_s(p1[12], p1[13]), cvtpk_s(p1[14], p1[15])}; \
      ATT_SBAR(); \
      pv(o, (int)lds0 + s_cur * DS_SLOT + (inA ? 0 : DS_KB) + 8192 + vlane, __builtin_bit_cast(bf16x8, pw0), __builtin_bit_cast(bf16x8, pw1), __builtin_bit_cast(bf16x8, pw2), __builtin_bit_cast(bf16x8, pw3)); } \
    if (live && k == 2) {                                             \
      float ls = lsum; { auto rr = __builtin_amdgcn_permlane32_swap(__float_as_uint(ls), __float_as_uint(ls), false, false); ls = __uint_as_float(rr[0]) + __uint_as_float(rr[1]); } \
      if (hi == 0) { wsf[32 + r32] = ls; own.lse_out(wid, r32, (m + __builtin_amdgcn_logf(ls)) * LN2); } \
      asm volatile("s_waitcnt lgkmcnt(0)" ::: "memory"); \
      float rli[16]; \
      _Pragma("unroll") for (int rr = 0; rr < 16; ++rr) rli[rr] = __builtin_amdgcn_rcpf(wsf[32 + crow(rr, hi)]); \
      asm volatile("s_waitcnt lgkmcnt(0)" ::: "memory"); \
      LAS bf16* stg = (LAS bf16*)(shm + DS_OST) + wid * 2048; \
      _Pragma("unroll") for (int rr = 0; rr < 16; ++rr) { const int orow = crow(rr, hi); \
        _Pragma("unroll") for (int d0 = 0; d0 < 2; ++d0) stg[orow * 64 + d0 * 32 + r32] = (bf16)(cvtpk_s(o[d0][rr] * rli[rr], 0.f) & 0xffffu); } \
      asm volatile("s_waitcnt lgkmcnt(0)" ::: "memory"); \
      _Pragma("unroll") for (int q4 = 0; q4 < 4; ++q4) { const int row = q4 * 8 + (lane >> 3), ch = lane & 7; const u32x4 v = *(const LAS u32x4*)(stg + row * 64 + ch * 8); *(u32x4*)(own.o_ptr(wid, row) + ch * 8) = v; } \
      x_cur = 5; \
      asm volatile("" : "+v"(qn[0]), "+v"(qn[1]), "+v"(qn[2]), "+v"(qn[3]));        \
      _Pragma("unroll") for (int d0 = 0; d0 < 4; ++d0) qr[d0] = qn[d0]; } \
    { const int xs = x_prev + x_cur;                                  \
      if (xs == 4) ATT_WAIT_BAR(8); else if (xs == 5) ATT_WAIT_BAR(9); else if (xs == 9) ATT_WAIT_BAR(13); else ATT_WAIT_BAR(4); }        \
    x_prev = x_cur; s_cur = (s_cur == 2) ? 0 : s_cur + 1; \
    } while (0)
#pragma unroll 1
    for (int a = 0; a <= NU; ++a) {
        DS_STEP(0); DS_STEP(1); DS_STEP(2);
        pPrev = pCur; pCur = pNext; dil_unit_init(pNext, a + 2, NU, vcu, G, ws);
    }
    ATT_WAIT_BAR(0);
#undef DS_STEP
#undef DS_DMA
}

__device__ __forceinline__ void pc_post_mixer(PP p, int layer, LAS unsigned char* lds, int vcu, int G, int tid, int lane, int wave) {
    constexpr int PST = 1028;
    LAS float* vec = (LAS float*)lds; LAS float* panel = (LAS float*)(lds + 20480); LAS float* part = panel + 16 * PST;
    static_assert(20480 + 16 * PST * 4 + 8 * 16 * 16 * 4 <= 131072, "post-mixer LDS map");
    const float* wrg = p->in[21] + (size_t)layer * DM * NEXP;
    float wreg[8][4];
#pragma unroll
    for (int s_ = 0; s_ < 8; ++s_)
#pragma unroll
        for (int jj = 0; jj < 4; ++jj) wreg[s_][jj] = wrg[(size_t)(128 * wave + 16 * s_ + 4 * (lane >> 4) + jj) * NEXP + (lane & 15)];
    __syncthreads();
    for (int i = tid; i < DM; i += NTHREADS) { vec[3 * DM + i] = p->in[15][layer * DM + i]; vec[4 * DM + i] = p->in[16][layer * DM + i]; }
    const bf16* mix = (const bf16*)(p->ws + WS_MIX);
    for (int ch = vcu; ch < NTOK / 256; ch += G) {
        const int t0 = ch * 256, b = tok_bidx(t0), tw = t0 + wave * 32;
        __syncthreads();
        load_mod_vec<true>(p, vec, 2 * layer, b, 2, tid); load_mod_vec<true>(p, vec + DM, 2 * layer + 1, b, 0, tid); load_mod_vec<true>(p, vec + 2 * DM, 2 * layer + 1, b, 1, tid);
        __syncthreads();
#define PC_LOAD(X, M, r_) do { const int t_ = tw + (r_); const GAS f32x4* xr_ = (const GAS f32x4*)(layer == 0 ? x_in_row(p, t_) : p->out + (size_t)t_ * DM) + lane; const GAS v2u* mr_ = (const GAS v2u*)(mix + (size_t)t_ * DM) + lane; \
            _Pragma("unroll") for (int j_ = 0; j_ < 4; ++j_) { X[j_] = xr_[64 * j_]; M[j_] = mr_[64 * j_]; } } while (0)
#define PC_PART1(X, M, r_, slot_) do { const int t = tw + (r_); \
            LAS float* vec_ = vec; asm volatile("" : "+v"(vec_));     \
            f32x4 v[4]; float s = 0.f; \
            _Pragma("unroll") for (int j = 0; j < 4; ++j) { const f32x4 x = X[j]; const v2u m2 = M[j]; const f32x4 gt = *(const LAS f32x4*)(vec_ + 4 * lane + 256 * j); \
                const f32x4 o = {bflo(m2.x), bfhi(m2.x), bflo(m2.y), bfhi(m2.y)}; v[j] = x * DN_ALPHA + gt * o; s += (v[j].x + v[j].y) + (v[j].z + v[j].w); } \
            if ((r_) + 2 < 32) PC_LOAD(X, M, (r_) + 2); \
            const float mean = wave_sum(s) * (1.f / DM); float s2 = 0.f; \
            _Pragma("unroll") for (int j = 0; j < 4; ++j) { v[j] = v[j] - mean; s2 += (v[j].x * v[j].x + v[j].y * v[j].y) + (v[j].z * v[j].z + v[j].w * v[j].w); } \
            const float rstd = 1.f / sqrtf(wave_sum(s2) * (1.f / DM) + LN_EPS); \
            GAS f32x4* orow = (GAS f32x4*)(p->out + (size_t)t * DM) + lane; \
            _Pragma("unroll") for (int j = 0; j < 4; ++j) { const int c = 4 * lane + 256 * j; \
                const f32x4 g = *(const LAS f32x4*)(vec_ + 3 * DM + c), bb = *(const LAS f32x4*)(vec_ + 4 * DM + c), sh = *(const LAS f32x4*)(vec_ + DM + c), sc = *(const LAS f32x4*)(vec_ + 2 * DM + c); \
                const f32x4 x1 = v[j] * rstd * g + bb; orow[64 * j] = x1; const f32x4 hh = x1 * (1.0f + sc) + sh; v[j] = hh; \
                *(LAS f32x4*)(panel + (slot_) * PST + c) = hh; } \
            { GAS unsigned* o4 = (GAS unsigned*)(p->ws + WS_H + (size_t)t * DM) + lane;        \
                _Pragma("unroll") for (int j = 0; j < 4; ++j) o4[64 * j] = pg8::pk4_fp8(v[j].x, v[j].y, v[j].z, v[j].w); } \
            } while (0)
#define PC_PART2(r_, slot_) do { const int t = tw + (r_); const int e_ = lane & 15, pg_ = lane >> 4; \
            float lg = part[((pg_) * 16 + (slot_)) * 16 + e_] + part[((pg_ + 4) * 16 + (slot_)) * 16 + e_]; \
            { auto rr = __builtin_amdgcn_permlane16_swap(__float_as_uint(lg), __float_as_uint(lg), false, false); lg = __uint_as_float(rr[0]) + __uint_as_float(rr[1]); } \
            { auto rr = __builtin_amdgcn_permlane32_swap(__float_as_uint(lg), __float_as_uint(lg), false, false); lg = __uint_as_float(rr[0]) + __uint_as_float(rr[1]); } \
            float mx = lg; mx = fmaxf(mx, dpp_f<0xB1>(mx)); mx = fmaxf(mx, dpp_f<0x4E>(mx)); mx = fmaxf(mx, dpp_f<0x141>(mx)); mx = fmaxf(mx, dpp_f<0x140>(mx)); \
            const float ex = __expf(lg - mx); float den = ex; den += dpp_f<0xB1>(den); den += dpp_f<0x4E>(den); den += dpp_f<0x141>(den); den += dpp_f<0x140>(den); \
            float af_ = ex / den; af_ = (af_ >= 0.f && af_ <= 1.f) ? af_ : 0.f;        \
            if (lane < NEXP) ((float*)(p->ws + WS_AFF))[((size_t)(t >> 15) * NEXP + lane) * GTOK + (t & (GTOK - 1))] = af_; } while (0)
        f32x4 xa[4], xb[4]; v2u ma[4], mb[4];
        PC_LOAD(xa, ma, 0); PC_LOAD(xb, mb, 1);
        _Pragma("unroll 1") for (int i = 0; i < 32; i += 2) {
            PC_PART1(xa, ma, i, 2 * wave); PC_PART1(xb, mb, i + 1, 2 * wave + 1);
            asm volatile("s_waitcnt lgkmcnt(0)\n\ts_barrier" ::: "memory");
            { pg8::f32x4 D = {0.f, 0.f, 0.f, 0.f}; const LAS float* brow = panel + (lane & 15) * PST + 128 * wave + 4 * (lane >> 4);
#pragma unroll
              for (int s_ = 0; s_ < 8; ++s_) { const f32x4 hv = *(const LAS f32x4*)(brow + 16 * s_);
                  D = __builtin_amdgcn_mfma_f32_16x16x4f32(wreg[s_][0], hv.x, D, 0, 0, 0); D = __builtin_amdgcn_mfma_f32_16x16x4f32(wreg[s_][1], hv.y, D, 0, 0, 0);
                  D = __builtin_amdgcn_mfma_f32_16x16x4f32(wreg[s_][2], hv.z, D, 0, 0, 0); D = __builtin_amdgcn_mfma_f32_16x16x4f32(wreg[s_][3], hv.w, D, 0, 0, 0); }
              *(LAS f32x4*)(part + ((wave * 16 + (lane & 15)) * 16 + 4 * (lane >> 4))) = (f32x4){D[0], D[1], D[2], D[3]}; }
            asm volatile("s_waitcnt lgkmcnt(0)\n\ts_barrier" ::: "memory");
            PC_PART2(i, 2 * wave); PC_PART2(i + 1, 2 * wave + 1);
        }
#undef PC_LOAD
#undef PC_PART1
#undef PC_PART2
    }
}

__device__ __forceinline__ void topk_phase(PP p, LAS unsigned char* lds, int tid, int lane, int wave) {
    LAS int* red = (LAS int*)lds;
    for (int prob = blockIdx.x; prob < 2 * NEXP; prob += gridDim.x) {
        const float* a = (const float*)(p->ws + WS_AFF) + (size_t)prob * GTOK + tid * 64;
        unsigned v[64];
#pragma unroll
        for (int i = 0; i < 16; ++i) { const v4u x = ((const GAS v4u*)a)[i]; v[4 * i] = x.x; v[4 * i + 1] = x.y; v[4 * i + 2] = x.z; v[4 * i + 3] = x.w; }
        unsigned prefix = 0u;
        __syncthreads();
#pragma unroll 1
        for (int bit = 30; bit >= 0; --bit) {
            const unsigned cand = prefix | (1u << bit); int c = 0;
#pragma unroll
            for (int i = 0; i < 64; ++i) c += (int)((cand - 1u - v[i]) >> 31);
            c = wave_sum_i(c);
            if (lane == 0) red[(bit & 1) * 8 + wave] = c;
            __syncthreads();
            int tot = 0;
#pragma unroll
            for (int w = 0; w < 8; ++w) tot += red[(bit & 1) * 8 + w];
            if (tot >= CAP) prefix = cand;
        }
        const unsigned T = prefix;
        unsigned cg = 0u, ce = 0u;
#pragma unroll
        for (int i = 0; i < 64; ++i) { cg += (v[i] > T) ? 1u : 0u; ce += (v[i] == T) ? 1u : 0u; if ((i & 7) == 7) __builtin_amdgcn_sched_barrier(0); }
        const unsigned pack = cg | (ce << 16); unsigned x = pack;
#pragma unroll
        for (int o = 1; o < 64; o <<= 1) { const unsigned y = (unsigned)__builtin_amdgcn_ds_bpermute(((lane - o) & 63) << 2, (int)x); if (lane >= o) x += y; }
        if (lane == 63) red[32 + wave] = (int)x;
        __syncthreads();
        unsigned off = 0u, tot = 0u;
#pragma unroll
        for (int w = 0; w < 8; ++w) { const unsigned tw = (unsigned)red[32 + w]; tot += tw; off += (w < wave) ? tw : 0u; }
        const unsigned excl = x - pack + off;
        unsigned gt_before = excl & 0xffffu, eq_before = excl >> 16; const unsigned need_eq = (unsigned)CAP - (tot & 0xffffu);
        int* idx = (int*)(p->ws + WS_IDX) + (size_t)prob * CAP; float* gv = (float*)(p->ws + WS_GATEV) + (size_t)prob * CAP;
        int so[64];
#pragma unroll
        for (int i = 0; i < 64; ++i) {
            const bool isg = v[i] > T, ise = v[i] == T; const bool sel = isg || (ise && eq_before < need_eq);
            const unsigned slot = gt_before + (eq_before < need_eq ? eq_before : need_eq);
            if (sel) { idx[slot] = (prob >> 4) * GTOK + tid * 64 + i; gv[slot] = __uint_as_float(v[i]); }
            so[i] = sel ? (int)slot : -1; gt_before += isg ? 1u : 0u; eq_before += ise ? 1u : 0u; if ((i & 7) == 7) __builtin_amdgcn_sched_barrier(0); }
        GAS v4u* sp = (GAS v4u*)((int*)(p->ws + WS_SLOTOF) + (size_t)prob * GTOK + tid * 64);
#pragma unroll
        for (int i = 0; i < 16; ++i) { v4u w; w.x = (unsigned)so[4 * i]; w.y = (unsigned)so[4 * i + 1]; w.z = (unsigned)so[4 * i + 2]; w.w = (unsigned)so[4 * i + 3]; sp[i] = w; }
        __syncthreads();
    }
}

__device__ __forceinline__ f32x4 pd_fp8x4(unsigned w) { const auto lo = __builtin_amdgcn_cvt_pk_f32_fp8((int)w, false), hi = __builtin_amdgcn_cvt_pk_f32_fp8((int)w, true); return (f32x4){lo[0], lo[1], hi[0], hi[1]}; }
__device__ __forceinline__ void pd_post_moe(PP p, int layer, LAS unsigned char* lds, int vcu, int G, int tid, int lane, int wave) {
    LAS float* vec = (LAS float*)lds;
    LAS int* st_slot = (LAS int*)(lds + 32768) + wave * 1024;
    LAS float* st_gate = (LAS float*)(st_slot + 512);
    __syncthreads();
    for (int i = tid; i < DM; i += NTHREADS) { vec[DM + i] = p->in[19][layer * DM + i]; vec[2 * DM + i] = p->in[20][layer * DM + i]; }
    const unsigned char* ye = p->ws + WS_YE;
    for (int ch = vcu; ch < NTOK / 256; ch += G) {
        const int t0 = ch * 256, b = tok_bidx(t0), g = t0 >> 15, tw = t0 + wave * 32;
        __syncthreads();
        load_mod_vec<true>(p, vec, 2 * layer + 1, b, 2, tid);
        if (layer == 0) { load_mod_vec<true>(p, vec + 3 * DM, 2, b, 0, tid); load_mod_vec<true>(p, vec + 4 * DM, 2, b, 1, tid); }
        { const int sub = lane >> 4, e = lane & 15;
          const int* so = (const int*)(p->ws + WS_SLOTOF) + ((size_t)g * NEXP + e) * GTOK + (tw & (GTOK - 1)); const float* gvp = (const float*)(p->ws + WS_GATEV) + ((size_t)g * NEXP + e) * CAP;
          int s8[8]; float g8[8];
#pragma unroll
          for (int j = 0; j < 8; ++j) s8[j] = so[4 * j + sub];
#pragma unroll
          for (int j = 0; j < 8; ++j) g8[j] = gvp[s8[j] < 0 ? 0 : s8[j]];
#pragma unroll
          for (int j = 0; j < 8; ++j) { const float gg = s8[j] >= 0 ? g8[j] * (1.0f / YE_QS) : 0.f; st_slot[(4 * j + sub) * 16 + e] = s8[j]; st_gate[(4 * j + sub) * 16 + e] = gg; } }
        __syncthreads();
        const unsigned char* yeg = ye + (size_t)g * NEXP * CAP * DM;
#define PD_STAGE(S_, i_) do { const int t_ = tw + (i_); int sl_ = -1; float gv_ = 0.f; if (lane < NEXP) { sl_ = st_slot[(i_) * 16 + lane]; gv_ = st_gate[(i_) * 16 + lane]; } \
            unsigned mk_ = (unsigned)__ballot(sl_ >= 0); \
            _Pragma("unroll") for (int k_ = 0; k_ < 4; ++k_) { const unsigned char* rp_ = yeg; float g_ = 0.f; \
                if (mk_) { const int e_ = __builtin_ctz(mk_); mk_ &= mk_ - 1u; const int s_ = __builtin_amdgcn_readlane(sl_, e_); g_ = __int_as_float(__builtin_amdgcn_readlane(__float_as_int(gv_), e_)); rp_ = yeg + ((size_t)e_ * CAP + s_) * DM; } \
                g##S_[k_] = g_; const GAS unsigned* yr_ = (const GAS unsigned*)rp_ + lane; _Pragma("unroll") for (int j_ = 0; j_ < 4; ++j_) y##S_[k_][j_] = yr_[64 * j_]; } \
            slot##S_ = sl_; gval##S_ = gv_; rest##S_ = mk_; \
            const GAS f32x4* xr_ = (const GAS f32x4*)(p->out + (size_t)t_ * DM) + lane; _Pragma("unroll") for (int j_ = 0; j_ < 4; ++j_) x##S_[j_] = xr_[64 * j_]; } while (0)
#define PD_ROW(S_, i_) do { const int t = tw + (i_); \
            LAS float* vec_ = vec; asm volatile("" : "+v"(vec_)); \
            f32x4 y[4]; \
            _Pragma("unroll") for (int j = 0; j < 4; ++j) { y[j] = (f32x4){0.f, 0.f, 0.f, 0.f}; \
                _Pragma("unroll") for (int k = 0; k < 4; ++k) y[j] += pd_fp8x4(y##S_[k][j]) * g##S_[k]; } \
            { unsigned rest = rest##S_; while (rest) { const int e = __builtin_ctz(rest); rest &= rest - 1u;            \
                const int sl = __builtin_amdgcn_readlane(slot##S_, e); const float gv = __int_as_float(__builtin_amdgcn_readlane(__float_as_int(gval##S_), e)); \
                const GAS unsigned* yr = (const GAS unsigned*)(yeg + ((size_t)e * CAP + sl) * DM) + lane; \
                _Pragma("unroll") for (int j = 0; j < 4; ++j) y[j] += pd_fp8x4(yr[64 * j]) * gv; } } \
            GAS f32x4* xr = (GAS f32x4*)(p->out + (size_t)t * DM) + lane; \
            f32x4 v[4]; float s = 0.f; \
            _Pragma("unroll") for (int j = 0; j < 4; ++j) { const f32x4 gt = *(const LAS f32x4*)(vec_ + 4 * lane + 256 * j); v[j] = x##S_[j] * DN_ALPHA + gt * y[j]; s += (v[j].x + v[j].y) + (v[j].z + v[j].w); } \
            if ((i_) + 2 < 32) PD_STAGE(S_, (i_) + 2); \
            const float mean = wave_sum(s) * (1.f / DM); float s2 = 0.f; \
            _Pragma("unroll") for (int j = 0; j < 4; ++j) { v[j] = v[j] - mean; s2 += (v[j].x * v[j].x + v[j].y * v[j].y) + (v[j].z * v[j].z + v[j].w * v[j].w); } \
            const float rstd = 1.f / sqrtf(wave_sum(s2) * (1.f / DM) + LN_EPS); \
            _Pragma("unroll") for (int j = 0; j < 4; ++j) { const int c = 4 * lane + 256 * j; const f32x4 gg = *(const LAS f32x4*)(vec_ + DM + c), bb = *(const LAS f32x4*)(vec_ + 2 * DM + c); \
                const f32x4 x2 = v[j] * rstd * gg + bb; xr[64 * j] = x2; \
                if (layer == 0) { const f32x4 sh = *(const LAS f32x4*)(vec_ + 3 * DM + c), sc = *(const LAS f32x4*)(vec_ + 4 * DM + c); v[j] = x2 * (1.0f + sc) + sh; } } \
            if (layer == 0) store_row_bf16((bf16*)(p->ws + WS_H) + (size_t)t * DM, v, lane); } while (0)
        f32x4 xA[4], xB[4]; unsigned yA[4][4], yB[4][4]; float gA[4], gB[4]; int slotA = -1, slotB = -1; float gvalA = 0.f, gvalB = 0.f; unsigned restA = 0u, restB = 0u;
        PD_STAGE(A, 0); PD_STAGE(B, 1);
        _Pragma("unroll 1") for (int i = 0; i < 32; i += 2) { PD_ROW(A, i); PD_ROW(B, i + 1); }
#undef PD_STAGE
#undef PD_ROW
    }
}

__device__ __forceinline__ void merge_phase(PP p, int vcu, int G, int lane, int wave) {
    const int gw = vcu * NWAVES + wave, NGW = G * NWAVES;
    const bf16* og = (const bf16*)(p->ws + WS_OG); const float* lse = (const float*)(p->ws + WS_LSE); bf16* mrg = (bf16*)(p->ws + WS_MRG);
    for (int t = gw; t < NTOK; t += NGW) {
        const int h = lane >> 3;
        const float l0 = lse[(size_t)t * 8 + h], l1 = lse[(size_t)NTOK * 8 + (size_t)t * 8 + h], l2 = lse[(size_t)2 * NTOK * 8 + (size_t)t * 8 + h];
        const float mx = fmaxf(l0, fmaxf(l1, l2)); float w0 = __expf(l0 - mx), w1 = __expf(l1 - mx), w2 = __expf(l2 - mx); const float inv = 1.0f / (w0 + w1 + w2); w0 *= inv; w1 *= inv; w2 *= inv;
        const v4u a = *((const GAS v4u*)(og + (size_t)t * 512) + lane), b = *((const GAS v4u*)(og + (size_t)NTOK * 512 + (size_t)t * 512) + lane), c = *((const GAS v4u*)(og + (size_t)2 * NTOK * 512 + (size_t)t * 512) + lane);
        v4u o;
#define MRG1(f) o.f = pk2(w0 * bflo(a.f) + w1 * bflo(b.f) + w2 * bflo(c.f), w0 * bfhi(a.f) + w1 * bfhi(b.f) + w2 * bfhi(c.f))
        MRG1(x); MRG1(y); MRG1(z); MRG1(w);
#undef MRG1
        *((GAS v4u*)(mrg + (size_t)t * 512) + lane) = o;
    }
}

__global__ void __launch_bounds__(NTHREADS, 2) fwd_kernel(Params p_unused) {
    extern __shared__ __attribute__((aligned(16))) unsigned char lds_raw[];
    LAS unsigned char* lds = (LAS unsigned char*)lds_raw;
    const int G = gridDim.x; const int bx = blockIdx.x; const int vcu = (G % 8 == 0) ? (bx % 8) * (G / 8) + bx / 8 : bx;
    int wv = __builtin_amdgcn_readfirstlane((int)threadIdx.x >> 6); asm volatile("" : "+s"(wv));
    { const int tid = opaque_tid(wv); for (int u = tid; u < (LDS_BYTES - LDSCTL_OFF) / 4; u += NTHREADS) ((LAS unsigned*)(lds + LDSCTL_OFF))[u] = 0u; }
    __syncthreads();
    XcdBarrier bar = xcd_barrier_post((unsigned*)(params_ptr()->ws + WS_CTL) + CW_BAR, (volatile LAS unsigned*)(lds + MISC_OFF) + 8);
    int ph = 0;
#ifdef TM_MASK
    unsigned long long tm_prev = __builtin_amdgcn_s_memrealtime(), tm_acc = 0ull;
#define TSTAMP(cls) do { const unsigned long long _n = __builtin_amdgcn_s_memrealtime(); if ((TM_MASK >> (cls)) & 1u) tm_acc += _n - tm_prev; tm_prev = _n; } while (0)
#else
#define TSTAMP(cls) do { } while (0)
#endif
#define SEAM() do { ++ph; if (ph >= params_ptr()->ph_hi) return; if (ph > params_ptr()->ph_lo) xcd_barrier(bar, wv); } while (0)
#define RUN (ph >= params_ptr()->ph_lo)
#define TL() const PP p = params_ptr(); unsigned char* ws = p->ws; (void)ws; const int tid = opaque_tid(wv), lane = tid & 63, wave = wv; (void)lane; (void)wave

    if (RUN) { TL(); p0_prologue(p, lds, vcu, G, tid, lane, wave); } SEAM(); TSTAMP(0);
    if (RUN) { TL(); p1_modulate(p, lds, vcu, G, tid, lane, wave); } SEAM(); TSTAMP(1);

    for (int layer = 0; layer < 2; ++layer) {
        if (layer == 0) {
            if (RUN) { const PP p = params_ptr(); unsigned char* ws = p->ws; pg8::Gemm g{(const bf16*)(ws + WS_H), (const bf16*)(ws + WS_WIN0), NTOK, N_IN0, DM}; pg8::StaticOrder S; S.init(NTOK, N_IN0, G, bx, 0);
              pg8::EpiBf16 E{(bf16*)(ws + WS_PROJ), N_IN0}; pg8::gemm_phase(wv, lds, g, S, E); } SEAM(); TSTAMP(2);
            if (RUN) { TL(); p3_mla_prep(p, vcu, G, lane, wave); } SEAM(); TSTAMP(3);
            if (RUN) { const PP p = params_ptr(); unsigned char* ws = p->ws; pg8::Gemm g{(const bf16*)(ws + WS_A2), (const bf16*)(ws + WS_WUP), NTOK, N_UP, K_UP}; pg8::StaticOrder S; S.init(NTOK, N_UP, G, bx, 0);
              pg8::EpiBf16 E{(bf16*)(ws + WS_QKV2), N_UP}; pg8::gemm_phase(wv, lds, g, S, E); } SEAM(); TSTAMP(4);
            if (RUN) { TL(); LAS float* tab = (LAS float*)(lds + att::L_TAB);
              __syncthreads();
              for (int i = tid; i < 8 * 465; i += NTHREADS) tab[i] = p->in[5][i] * att::LOG2E;
              __syncthreads();
              const int nk = (MOE_TILES - vcu + G - 1) / G; int nmla = 0; for (int r = vcu; r < 2048; r += G) ++nmla;
              { PolNA cur, nx; bool pre = false; int u = 0;
                for (int r = vcu; r < 2048; r += G, ++u) { if (u == 0) cur.init(r, ws, tab); const bool hn = r + G < 2048; if (hn) nx.init(r + G, ws, tab);
                  CvtRider<true> rd; const int k = nmla * 16 + u * 8 + wv, k1 = u * 8 + wv;
                  rd.init(p, 0, k < nk ? k * G + vcu : -1, k1 * G + vcu < moe1_split(G) ? k1 * G + vcu : -1, 1); att::attn_unit(wv, cur, lds, rd, nx, hn, pre); pre = hn; cur = nx; } } TSTAMP(5);
              { PolMLA cur, nx; bool pre = false; int u = 0;
                for (int r = vcu; r < 2048; r += G, ++u) { if (u == 0) cur.init(r, ws); const bool hn = r + G < 2048; if (hn) nx.init(r + G, ws);
                  CvtStream rd; const int k = (u * 8 + wv) * 2; rd.init(p, k < nk ? k * G + vcu : -1, k + 1 < nk ? (k + 1) * G + vcu : -1); att::attn_unit_pipe(wv, cur, lds, rd, nx, hn, pre); pre = hn; cur = nx; } }
              { const int lane2 = opaque_tid(wv) & 63;
                for (int k = nmla * 16 + nmla * 8 + wv; k < nk; k += 8) { const CvtTile T = moe_tile(p, 0, k * G + vcu, 1); f32x4 w[16]; cvt_tile_load(T, lane2, w); cvt_tile_store_any(T, lane2, w); } } } SEAM(); TSTAMP(6);
            if (RUN) { const PP p = params_ptr(); unsigned char* ws = p->ws; pg8::Gemm g{(const bf16*)(ws + WS_ATT), (const bf16*)(ws + WS_WOUT0), NTOK, DM, DM}; pg8::StaticOrder S; S.init(NTOK, DM, G, bx, 0);
              pg8::EpiBf16 E{(bf16*)(ws + WS_MIX), DM}; pg8::gemm_phase(wv, lds, g, S, E); } SEAM(); TSTAMP(7);
        } else {
            if (RUN) { const PP p = params_ptr(); unsigned char* ws = p->ws; pg8::Gemm g{(const bf16*)(ws + WS_H), (const bf16*)(ws + WS_WDIL), NTOK, N_DIL, DM}; pg8::StaticOrder S; S.init(NTOK, N_DIL, G, bx, 0);
              pg8::EpiBf16Dil E{(bf16*)(ws + WS_QKV), N_DIL, (const float2*)(ws + WS_ROPE_H)}; pg8::gemm_phase(wv, lds, g, S, E); } SEAM(); TSTAMP(14);
            if (RUN) { const PP p = params_ptr(); unsigned char* ws = p->ws; __syncthreads();
              const int nk = (moe1_split(G) - vcu + G - 1) / G; int nna = 0; for (int r = vcu; r < 2048; r += G) ++nna; const int it = nna;
              dil_skew(wv, p, lds, vcu, G);
              { const int lane = opaque_tid(wv) & 63; for (int k = it * 8 + wv; k < nk; k += 8) { const CvtTile T = moe_tile(p, 1, k * G + vcu, 1); f32x4 w[16]; cvt_tile_load(T, lane, w); cvt_tile_store<true>(T, lane, w); } } } SEAM(); TSTAMP(16);
            if (RUN) { TL(); merge_phase(p, vcu, G, lane, wave); } SEAM(); TSTAMP(17);
            if (RUN) { const PP p = params_ptr(); unsigned char* ws = p->ws; pg8::Gemm g{(const bf16*)(ws + WS_MRG), (const bf16*)(ws + WS_WOUT1), NTOK, DM, 512}; pg8::StaticOrder S; S.init(NTOK, DM, G, bx, 0);
              pg8::EpiBf16 E{(bf16*)(ws + WS_MIX), DM}; pg8::gemm_phase(wv, lds, g, S, E); } SEAM(); TSTAMP(18);
        }
        if (RUN) { TL(); if (layer == 0) pc_post_mixer(p, 0, lds, vcu, G, tid, lane, wave); else pc_post_mixer(p, 1, lds, vcu, G, tid, lane, wave); } SEAM(); TSTAMP(8);
        if (RUN) { TL(); topk_phase(p, lds, tid, lane, wave);
          if (bx >= 2 * NEXP) {
            const int it_end = layer == 0 ? moe1_split2(G) : MOE_TILES;
            for (int it = (layer == 0 ? moe1_split(G) : moe1_split2(G)) + (bx - 2 * NEXP) * 8 + wave; it < it_end; it += (G - 2 * NEXP) * 8) { const CvtTile T = moe_tile(p, 1, it, 1); f32x4 w[16]; cvt_tile_load(T, lane, w); cvt_tile_store<true>(T, lane, w); } } } SEAM(); TSTAMP(9);
        { constexpr int MR = 2 * NEXP * CAP;
            if (RUN) { const PP p = params_ptr(); unsigned char* ws = p->ws; pg8::StaticOrder S; S.init(MR, 2 * FF, G, bx, 1); const int* ix = (const int*)(ws + WS_IDX);
              { pg8::Gemm g{(const bf16*)(ws + WS_H), (const bf16*)(ws + WS_W13 + (layer ? W13_L1OFF : 0)), MR, 2 * FF, DM};
                  pg8::EpiSwiGluF8 E{ws + WS_HH, FF, 1.0f / W13_QS}; pg8::gemm_phase<pg8::EpiSwiGluF8, pg8::StaticOrder, true, true>(wv, lds, g, S, E, ix); } } SEAM(); TSTAMP(11);
            if (RUN) { const PP p = params_ptr(); unsigned char* ws = p->ws; pg8::Gemm g{(const bf16*)(ws + WS_HH), (const bf16*)(ws + WS_W2 + (layer ? W2_L1OFF : 0)), MR, DM, FF}; pg8::StaticOrder S; S.init(MR, DM, G, bx, 1);
              { pg8::EpiF8S E{ws + WS_YE, DM, YE_QS / W2_QS}; pg8::gemm_phase<pg8::EpiF8S, pg8::StaticOrder, false, true>(wv, lds, g, S, E); } } SEAM(); TSTAMP(12);
        }
        if (RUN) { TL(); pd_post_moe(p, layer, lds, vcu, G, tid, lane, wave);
        }
        if (layer == 0) SEAM();
        TSTAMP(13);
    }
#ifdef TM_MASK
    if (blockIdx.x == 0) { const unsigned long long t0 = __builtin_amdgcn_s_memrealtime(); while (__builtin_amdgcn_s_memrealtime() - t0 < TM_AMP * tm_acc) __builtin_amdgcn_s_sleep(8); }
#endif
#undef TL
#undef SEAM
}


extern "C" void kernel_launch(void* const* d_in, const int* in_sizes, int n_in, void* d_out, int out_size, void* d_ws, size_t ws_size, hipStream_t stream) {
    static int grid = 0;
    if (grid == 0) {
        if (n_in != 25 || out_size != NTOK * DM || ws_size < WS_END) { fprintf(stderr, "kernel_launch: unexpected shapes (n_in %d, out %d, ws %zu, need %zu); nothing launched\n", n_in, out_size, ws_size, (size_t)WS_END); grid = -1; return; }
        int dev = 0, cus = 0, per_cu = 0;
        if (hipGetDevice(&dev) != hipSuccess || hipDeviceGetAttribute(&cus, hipDeviceAttributeMultiprocessorCount, dev) != hipSuccess) { grid = -1; return; }
        if (hipFuncSetAttribute((const void*)fwd_kernel, hipFuncAttributeMaxDynamicSharedMemorySize, LDS_BYTES) != hipSuccess) { fprintf(stderr, "kernel_launch: hipFuncSetAttribute failed\n"); grid = -1; return; }
        if (hipOccupancyMaxActiveBlocksPerMultiprocessor(&per_cu, (const void*)fwd_kernel, NTHREADS, LDS_BYTES) != hipSuccess || per_cu < 1) fprintf(stderr, "kernel_launch: occupancy query reports %d\n", per_cu);
        (void)hipGetLastError();
        grid = cus;
    }
    if (grid < 0) return;
    if (hipMemsetAsync((char*)d_ws + WS_CTL, 0, CTL_ZERO_BYTES, stream) != hipSuccess) return;
    Params p{};
    for (int i = 0; i < 25; ++i) p.in[i] = (const float*)d_in[i];
    p.out = (float*)d_out; p.ws = (unsigned char*)d_ws;
#ifndef PH_HI
#define PH_HI 1000
#endif
    p.ph_lo = 0; p.ph_hi = PH_HI;
    hipLaunchKernelGGL(fwd_kernel, dim3(grid), dim3(NTHREADS), LDS_BYTES, stream, p);
    const hipError_t le = hipPeekAtLastError();
    if (le != hipSuccess) fprintf(stderr, "kernel_launch: launch failed: %s\n", hipGetErrorName(le));
}
```

```cpp
#include <hip/hip_runtime.h>
#include <hip/hip_bf16.h>
#include <cstdio>
#include <cstdint>
#include <cmath>

#define LAS __attribute__((address_space(3)))
#define GAS __attribute__((address_space(1)))
__device__ __forceinline__ int opaque_tid(int wv) { unsigned z = 0u; asm volatile("" : "+v"(z)); return wv * 64 + (int)__builtin_amdgcn_mbcnt_hi(~0u, __builtin_amdgcn_mbcnt_lo(~0u, z)); }

namespace pg8 {
typedef unsigned short bf16_t;
typedef short bf16x8 __attribute__((ext_vector_type(8)));
typedef float f32x4 __attribute__((ext_vector_type(4)));
typedef unsigned u32x4 __attribute__((ext_vector_type(4)));
typedef int i32x4 __attribute__((ext_vector_type(4)));
typedef int i32x8 __attribute__((ext_vector_type(8)));
typedef unsigned u32x2 __attribute__((ext_vector_type(2)));
constexpr int BM = 256, BK = 64, HALF = 128, HTB = HALF * BK * 2, STAGE_BYTES = 8 * HTB, NXCD = 8, WGM = 8;

__host__ __device__ __forceinline__ int lds_byte(int r, int c) { const int st = (r >> 4) * 2 + (c >> 5), rr = r & 15, cc = c & 31, ob = rr * 64 + cc * 2; return st * 1024 + (ob ^ (((ob >> 9) & 1) << 5)); }
__host__ __device__ __forceinline__ void stage_rc(int b, int& R, int& C) { const int st = b / 1024, sb = b % 1024, swz = sb ^ (((sb >> 9) & 1) << 5); R = (st >> 1) * 16 + swz / 64; C = (st & 1) * 32 + (swz % 64) / 2; }
__host__ __device__ __forceinline__ int perm32(int rho) { const int n = rho >> 4, i = rho & 15; return 8 * (i >> 2) + 4 * n + (i & 3); }

struct Unit { int pm, pn, pb; };
struct Gemm { const bf16_t* A; const bf16_t* Bt; int M, N, K; };

struct StaticOrder {
    int nM, nN, nwg, G, c, ne;
    __device__ void init(int M, int N, int G_, int c_, int ne_) { nM = M / BM; nN = N / BM; nwg = nM * nN; G = G_; c = c_; ne = ne_; }
    __device__ bool next(int i, Unit& u) const {
        const long L = (long)i * G + c; if (L >= nwg) return false;
        int wgid = (int)L; { const int q = nwg / NXCD, r = nwg % NXCD, xcd = wgid % NXCD, off = wgid / NXCD; wgid = (xcd < r ? xcd * (q + 1) : r * (q + 1) + (xcd - r) * q) + off; }
        const int nig = WGM * nN, gid = wgid / nig, fm = gid * WGM, gsz = (nM - fm) < WGM ? (nM - fm) : WGM;
        u.pm = fm + ((wgid % nig) % gsz); u.pn = (wgid % nig) / gsz; u.pb = ne ? ((u.pm >> 4) & 15) * nN + u.pn : u.pn; return true;
    }
};

__device__ __forceinline__ unsigned cvt_pk_bf16(float lo, float hi) { unsigned r; asm volatile("v_cvt_pk_bf16_f32 %0, %1, %2" : "=v"(r) : "v"(lo), "v"(hi)); return r; }

struct EpiBf16 {
    static constexpr bool PERM = true;
    bf16_t* O; int ldc;
    __device__ __forceinline__ void operator()(const f32x4 (&acc)[2][2][4][2], const Unit& u, int wr, int wc, int fr, int fq) const {
        const int row0 = u.pm * BM + wr * 64 + fr; const int col0 = u.pn * BM + wc * 32 + 8 * fq;
#pragma unroll
        for (int ai = 0; ai < 2; ++ai)
#pragma unroll
            for (int m = 0; m < 4; ++m) { bf16_t* rowp = O + (size_t)(row0 + ai * HALF + m * 16) * ldc + col0;
#pragma unroll
                for (int bj = 0; bj < 2; ++bj) { const f32x4 v0 = acc[ai][bj][m][0], v1 = acc[ai][bj][m][1];
                    u32x4 w; w.x = cvt_pk_bf16(v0[0], v0[1]); w.y = cvt_pk_bf16(v0[2], v0[3]); w.z = cvt_pk_bf16(v1[0], v1[1]); w.w = cvt_pk_bf16(v1[2], v1[3]);
                    *(u32x4*)(rowp + bj * HALF) = w; } }
    }
};
__device__ __forceinline__ unsigned pk4_fp8(float a, float b, float c, float d) { int w = __builtin_amdgcn_cvt_pk_fp8_f32(a, b, 0, false); w = __builtin_amdgcn_cvt_pk_fp8_f32(c, d, w, true); return (unsigned)w; }
struct EpiBf16S {
    static constexpr bool PERM = true;
    bf16_t* O; int ldc; float sc;
    __device__ __forceinline__ void operator()(const f32x4 (&acc)[2][2][4][2], const Unit& u, int wr, int wc, int fr, int fq) const {
        const int row0 = u.pm * BM + wr * 64 + fr; const int col0 = u.pn * BM + wc * 32 + 8 * fq;
#pragma unroll
        for (int ai = 0; ai < 2; ++ai)
#pragma unroll
            for (int m = 0; m < 4; ++m) { bf16_t* rowp = O + (size_t)(row0 + ai * HALF + m * 16) * ldc + col0;
#pragma unroll
                for (int bj = 0; bj < 2; ++bj) { const f32x4 v0 = acc[ai][bj][m][0] * sc, v1 = acc[ai][bj][m][1] * sc;
                    u32x4 w; w.x = cvt_pk_bf16(v0[0], v0[1]); w.y = cvt_pk_bf16(v0[2], v0[3]); w.z = cvt_pk_bf16(v1[0], v1[1]); w.w = cvt_pk_bf16(v1[2], v1[3]);
                    *(u32x4*)(rowp + bj * HALF) = w; } }
    }
};
struct EpiF8S {
    static constexpr bool PERM = true;
    unsigned char* O; int ldc; float sc;
    __device__ __forceinline__ void operator()(const f32x4 (&acc)[2][2][4][2], const Unit& u, int wr, int wc, int fr, int fq) const {
        const int row0 = u.pm * BM + wr * 64 + fr; const int col0 = u.pn * BM + wc * 32 + 8 * fq;
#pragma unroll
        for (int ai = 0; ai < 2; ++ai)
#pragma unroll
            for (int m = 0; m < 4; ++m) { unsigned char* rowp = O + (size_t)(row0 + ai * HALF + m * 16) * ldc + col0;
#pragma unroll
                for (int bj = 0; bj < 2; ++bj) { const f32x4 v0 = acc[ai][bj][m][0] * sc, v1 = acc[ai][bj][m][1] * sc;
                    u32x2 w; w.x = pk4_fp8(v0[0], v0[1], v0[2], v0[3]); w.y = pk4_fp8(v1[0], v1[1], v1[2], v1[3]);
                    *(u32x2*)(rowp + bj * HALF) = w; } }
    }
};
__device__ __forceinline__ int dil_row(int t, int gi) { const int lg = t < 32768 ? 12 : 13, S1 = (1 << lg) - 1, pos = t & S1, d2 = 2 * gi; return (t & ~S1) + ((pos & ((1 << d2) - 1)) << (lg - d2)) + (pos >> d2); }
struct EpiBf16Dil {
    static constexpr bool PERM = true;
    bf16_t* O; int ldc; const float2* rope;
    __device__ __forceinline__ void operator()(const f32x4 (&acc)[2][2][4][2], const Unit& u, int wr, int wc, int fr, int fq) const {
        const int row0 = u.pm * BM + wr * 64 + fr; const int col0 = u.pn * BM + wc * 32 + 8 * fq; const int gi = u.pn / 6; const bool qk = (u.pn % 6) < 4;
        if (qk) {
            const int i0 = (col0 & 63) >> 1;
            f32x4 c01[2][4], c23[2][4];
#pragma unroll
            for (int ai = 0; ai < 2; ++ai)
#pragma unroll
                for (int m = 0; m < 4; ++m) { const int t = row0 + ai * HALF + m * 16; const float2* cs = rope + (size_t)(t < 32768 ? (t & 4095) : (t & 8191)) * 32 + i0;
                    c01[ai][m] = *(const f32x4*)cs; c23[ai][m] = *(const f32x4*)(cs + 2); }
#pragma unroll
            for (int ai = 0; ai < 2; ++ai)
#pragma unroll
                for (int m = 0; m < 4; ++m) { const int t = row0 + ai * HALF + m * 16; bf16_t* rowp = O + (size_t)dil_row(t, gi) * ldc + col0; const f32x4 ca = c01[ai][m], cb = c23[ai][m];
#pragma unroll
                    for (int bj = 0; bj < 2; ++bj) { const f32x4 v0 = acc[ai][bj][m][0], v1 = acc[ai][bj][m][1];
                        const f32x4 r0 = {v0[0] * ca[0] - v0[1] * ca[1], v0[0] * ca[1] + v0[1] * ca[0], v0[2] * ca[2] - v0[3] * ca[3], v0[2] * ca[3] + v0[3] * ca[2]};
                        const f32x4 r1 = {v1[0] * cb[0] - v1[1] * cb[1], v1[0] * cb[1] + v1[1] * cb[0], v1[2] * cb[2] - v1[3] * cb[3], v1[2] * cb[3] + v1[3] * cb[2]};
                        u32x4 w; w.x = cvt_pk_bf16(r0[0], r0[1]); w.y = cvt_pk_bf16(r0[2], r0[3]); w.z = cvt_pk_bf16(r1[0], r1[1]); w.w = cvt_pk_bf16(r1[2], r1[3]);
                        *(u32x4*)(rowp + bj * HALF) = w; } }
        } else {
#pragma unroll
            for (int ai = 0; ai < 2; ++ai)
#pragma unroll
                for (int m = 0; m < 4; ++m) { const int t = row0 + ai * HALF + m * 16; bf16_t* rowp = O + (size_t)dil_row(t, gi) * ldc + col0;
#pragma unroll
                    for (int bj = 0; bj < 2; ++bj) { const f32x4 v0 = acc[ai][bj][m][0], v1 = acc[ai][bj][m][1];
                        u32x4 w; w.x = cvt_pk_bf16(v0[0], v0[1]); w.y = cvt_pk_bf16(v0[2], v0[3]); w.z = cvt_pk_bf16(v1[0], v1[1]); w.w = cvt_pk_bf16(v1[2], v1[3]);
                        *(u32x4*)(rowp + bj * HALF) = w; } }
        }
    }
};
__device__ __forceinline__ float silu_f(float g) { return g * __builtin_amdgcn_rcpf(1.0f + __builtin_amdgcn_exp2f(-1.4426950408889634f * g)); }
struct EpiSwiGlu {
    static constexpr bool PERM = true;
    bf16_t* O; int ldc;
    __device__ __forceinline__ void operator()(const f32x4 (&acc)[2][2][4][2], const Unit& u, int wr, int wc, int fr, int fq) const {
        const int row0 = u.pm * BM + wr * 64 + fr; const int col0 = u.pn * HALF + wc * 32 + 8 * fq;
#pragma unroll
        for (int ai = 0; ai < 2; ++ai)
#pragma unroll
            for (int m = 0; m < 4; ++m) { bf16_t* rowp = O + (size_t)(row0 + ai * HALF + m * 16) * ldc + col0;
                const f32x4 g0 = acc[ai][0][m][0], g1 = acc[ai][0][m][1], u0 = acc[ai][1][m][0], u1 = acc[ai][1][m][1];
                u32x4 w; w.x = cvt_pk_bf16(silu_f(g0[0]) * u0[0], silu_f(g0[1]) * u0[1]); w.y = cvt_pk_bf16(silu_f(g0[2]) * u0[2], silu_f(g0[3]) * u0[3]);
                w.z = cvt_pk_bf16(silu_f(g1[0]) * u1[0], silu_f(g1[1]) * u1[1]); w.w = cvt_pk_bf16(silu_f(g1[2]) * u1[2], silu_f(g1[3]) * u1[3]);
                *(u32x4*)rowp = w; }
    }
};

struct EpiSwiGluF8 {
    static constexpr bool PERM = true;
    unsigned char* O; int ldc; float sc;
    __device__ __forceinline__ void operator()(const f32x4 (&acc)[2][2][4][2], const Unit& u, int wr, int wc, int fr, int fq) const {
        const int row0 = u.pm * BM + wr * 64 + fr; const int col0 = u.pn * HALF + wc * 32 + 8 * fq;
#pragma unroll
        for (int ai = 0; ai < 2; ++ai)
#pragma unroll
            for (int m = 0; m < 4; ++m) { unsigned char* rowp = O + (size_t)(row0 + ai * HALF + m * 16) * ldc + col0;
                const f32x4 g0 = acc[ai][0][m][0] * sc, g1 = acc[ai][0][m][1] * sc, u0 = acc[ai][1][m][0] * sc, u1 = acc[ai][1][m][1] * sc;
                u32x2 w; w.x = pk4_fp8(silu_f(g0[0]) * u0[0], silu_f(g0[1]) * u0[1], silu_f(g0[2]) * u0[2], silu_f(g0[3]) * u0[3]);
                w.y = pk4_fp8(silu_f(g1[0]) * u1[0], silu_f(g1[1]) * u1[1], silu_f(g1[2]) * u1[2], silu_f(g1[3]) * u1[3]);
                *(u32x2*)rowp = w; }
    }
};

template <class Epi, class Sched, bool GATHER = false, bool F8 = false>
__device__ __forceinline__ void gemm_phase(int wv, LAS unsigned char* lds, const Gemm g, const Sched& S, const Epi& E, const int* aidx = nullptr) {
    const int tid = opaque_tid(wv), wid = __builtin_amdgcn_readfirstlane(tid >> 6), lane = tid & 63, wr = wid >> 2, wc = wid & 3, fr = lane & 15, fq = lane >> 4;
    const int K = g.K; const unsigned RB = F8 ? (unsigned)K : 2u * (unsigned)K;
    const int nt = (int)(RB / 128u);
    const size_t kstep = (size_t)(BK * 2);
    const size_t hstep = (size_t)HALF * RB;
    const size_t tstep = 2 * hstep;
    unsigned vG[2][2], voffB[2];
#pragma unroll
    for (int i = 0; i < 2; ++i) { int R, C; stage_rc(tid * 16 + i * 8192, R, C); const int Rb = Epi::PERM ? ((R & ~31) + perm32(R & 31)) : R;
        vG[0][i] = (unsigned)R * RB + (unsigned)C * 2u; vG[1][i] = vG[0][i] + (unsigned)hstep; voffB[i] = (unsigned)Rb * RB + (unsigned)C * 2u; }
    const unsigned ldsw = (unsigned)wid * 1024u;
    const int aoff = lds_byte(wr * 64 + fr, fq * 8), boff = lds_byte(wc * 32 + fr, fq * 8);
    LAS int* itab = (LAS int*)(lds + STAGE_BYTES + 1024);
#define PG8_SA(b, h) (((b) * 2 + (h)) * HTB)
#define PG8_SB(b, h) ((4 + (b) * 2 + (h)) * HTB)
#define PG8_STAGE2(bufoff, gbase, o0, o1) do { \
        __builtin_amdgcn_global_load_lds((const unsigned*)((const char*)(gbase) + (o0)), (LAS unsigned*)(lds + (bufoff) + ldsw), 16, 0, 0); \
        __builtin_amdgcn_global_load_lds((const unsigned*)((const char*)(gbase) + (o1)), (LAS unsigned*)(lds + (bufoff) + ldsw + 8192), 16, 0, 0); } while (0)
#define PG8_STAGE(bufoff, gbase, voff) PG8_STAGE2(bufoff, gbase, (voff)[0], (voff)[1])
#define PG8_LD8(p_) __builtin_shufflevector(*(const LAS i32x4*)(p_), *(const LAS i32x4*)((p_) + 1024), 0, 1, 2, 3, 4, 5, 6, 7)
#define PG8_LDA(dst, b, h) do { if constexpr (F8) { _Pragma("unroll") for (int m = 0; m < 4; ++m) dst##8[m] = PG8_LD8(lds + PG8_SA(b, h) + aoff + m * 2048); } \
        else { _Pragma("unroll") for (int m = 0; m < 4; ++m) _Pragma("unroll") for (int k = 0; k < 2; ++k) dst[m][k] = *(const LAS bf16x8*)(lds + PG8_SA(b, h) + aoff + m * 2048 + k * 1024); } } while (0)
#define PG8_LDB(dst, b, h) do { if constexpr (F8) { _Pragma("unroll") for (int n = 0; n < 2; ++n) dst##8[n] = PG8_LD8(lds + PG8_SB(b, h) + boff + n * 2048); } \
        else { _Pragma("unroll") for (int n = 0; n < 2; ++n) _Pragma("unroll") for (int k = 0; k < 2; ++k) dst[n][k] = *(const LAS bf16x8*)(lds + PG8_SB(b, h) + boff + n * 2048 + k * 1024); } } while (0)
#define PG8_MMA(ai, bj, At, Bt) do { __builtin_amdgcn_s_setprio(1); \
        if constexpr (F8) { _Pragma("unroll") for (int m = 0; m < 4; ++m) _Pragma("unroll") for (int n = 0; n < 2; ++n) \
            asm volatile("v_mfma_f32_16x16x128_f8f6f4 %0, %1, %2, %0" : "+v"(acc[ai][bj][m][n]) : "v"(Bt##8[n]), "v"(At##8[m])); } \
        else { _Pragma("unroll") for (int m = 0; m < 4; ++m) _Pragma("unroll") for (int n = 0; n < 2; ++n) _Pragma("unroll") for (int k = 0; k < 2; ++k) \
            acc[ai][bj][m][n] = __builtin_amdgcn_mfma_f32_16x16x32_bf16(Bt[n][k], At[m][k], acc[ai][bj][m][n], 0, 0, 0); } __builtin_amdgcn_s_setprio(0); } while (0)
#define PG8_WAIT_V(n) asm volatile("s_waitcnt vmcnt(" #n ")" ::: "memory")
#define PG8_WAIT_L(n) asm volatile("s_waitcnt lgkmcnt(" #n ")" ::: "memory")
#define PG8_BAR __builtin_amdgcn_s_barrier()
#define PG8_SCHED __builtin_amdgcn_sched_barrier(0)
    Unit cur, nxt; int ui = 0; int sl_nx = 1, sl_n2 = 2;
    if (!S.next(0, cur)) return;
    if constexpr (GATHER) {
        Unit u1; const bool h1 = S.next(1, u1);
        if (tid < 256) { itab[tid] = aidx[cur.pm * BM + tid]; if (h1) itab[256 + tid] = aidx[u1.pm * BM + tid]; }
        __syncthreads();
#pragma unroll
        for (int h = 0; h < 2; ++h)
#pragma unroll
            for (int i = 0; i < 2; ++i) { int R, C; stage_rc(tid * 16 + i * 8192, R, C); vG[h][i] = (unsigned)itab[h * HALF + R] * RB + (unsigned)C * 2u; }
    }
    f32x4 acc[2][2][4][2];
#pragma unroll
    for (int a = 0; a < 2; ++a)
#pragma unroll
        for (int b = 0; b < 2; ++b)
#pragma unroll
            for (int m = 0; m < 4; ++m)
#pragma unroll
                for (int n = 0; n < 2; ++n) acc[a][b][m][n] = (f32x4){0.f, 0.f, 0.f, 0.f};
    bf16x8 At[4][2], B0[2][2], B1[2][2]; i32x8 At8[4], B08[2], B18[2];
    const char* cA = GATHER ? (const char*)g.A : (const char*)g.A + (size_t)cur.pm * tstep; const char* cB = (const char*)g.Bt + (size_t)cur.pb * tstep;
    PG8_STAGE(PG8_SB(0, 0), cB, voffB); PG8_STAGE(PG8_SB(0, 1), cB + hstep, voffB); PG8_STAGE(PG8_SA(0, 0), cA, vG[0]); PG8_STAGE(PG8_SA(0, 1), cA, vG[1]);
    if (wr == 1) PG8_BAR;
    PG8_WAIT_V(2); PG8_BAR;
    PG8_STAGE(PG8_SB(1, 0), cB + kstep, voffB); PG8_STAGE(PG8_SA(1, 0), cA + kstep, vG[0]); PG8_STAGE(PG8_SB(1, 1), cB + hstep + kstep, voffB);
    PG8_WAIT_V(6); PG8_BAR;
    for (;;) {
        const bool has_next = S.next(ui + 1, nxt);
        const char* nA = GATHER ? cA : (has_next ? (const char*)g.A + (size_t)nxt.pm * tstep : cA); const char* nB = has_next ? (const char*)g.Bt + (size_t)nxt.pb * tstep : cB;
        if constexpr (GATHER) { Unit u2;
            if (wid == 0 && S.next(ui + 2, u2)) {
                int lo_ = lane; asm volatile("" : "+v"(lo_));
                const int* src = aidx + (size_t)u2.pm * BM + lo_; LAS int* dst = itab + sl_n2 * 256;
#pragma unroll
                for (int q = 0; q < 4; ++q) __builtin_amdgcn_global_load_lds((const unsigned*)(src + q * 64), (LAS unsigned*)(dst + q * 64), 4, 0, 0); } }
        for (int t = 0; t < nt; t += 2) {
            const bool last = (t == nt - 2);
            const char* a1 = cA + (size_t)(t + 1) * kstep;
            const char* a2 = last ? nA : cA + (size_t)(t + 2) * kstep; const char* b2 = last ? nB : cB + (size_t)(t + 2) * kstep;
            const char* a3 = a2 + kstep; const char* b3 = b2 + kstep;
            unsigned o00 = vG[0][0], o01 = vG[0][1], o10 = vG[1][0], o11 = vG[1][1];
            if constexpr (GATHER) { if (last && has_next) { const LAS int* tb = itab + sl_nx * 256; int R0, C0, R1, C1; stage_rc((lane + wid * 64) * 16, R0, C0); stage_rc((lane + wid * 64) * 16 + 8192, R1, C1);
                o00 = (unsigned)tb[R0] * RB + (unsigned)C0 * 2u; o01 = (unsigned)tb[R1] * RB + (unsigned)C1 * 2u; o10 = (unsigned)tb[HALF + R0] * RB + (unsigned)C0 * 2u; o11 = (unsigned)tb[HALF + R1] * RB + (unsigned)C1 * 2u; } }
            PG8_LDB(B0, 0, 0); PG8_LDB(B1, 0, 1); PG8_SCHED; PG8_LDA(At, 0, 0); PG8_STAGE(PG8_SA(1, 1), a1, vG[1]);
            PG8_WAIT_V(8); PG8_WAIT_L(0); PG8_BAR; PG8_MMA(0, 0, At, B0); PG8_MMA(0, 1, At, B1); PG8_BAR; PG8_SCHED;
            PG8_LDA(At, 0, 1); PG8_STAGE(PG8_SB(0, 0), b2, voffB); PG8_STAGE(PG8_SB(0, 1), b2 + hstep, voffB); PG8_STAGE2(PG8_SA(0, 0), a2, o00, o01);
            PG8_WAIT_V(8); PG8_WAIT_L(0); PG8_BAR; PG8_MMA(1, 0, At, B0); PG8_MMA(1, 1, At, B1); PG8_BAR; PG8_SCHED;
            PG8_LDB(B0, 1, 0); PG8_LDB(B1, 1, 1); PG8_SCHED; PG8_LDA(At, 1, 0); PG8_STAGE2(PG8_SA(0, 1), a2, o10, o11);
            PG8_WAIT_V(8); PG8_WAIT_L(0); PG8_BAR; PG8_MMA(0, 0, At, B0); PG8_MMA(0, 1, At, B1); PG8_BAR; PG8_SCHED;
            PG8_LDA(At, 1, 1); PG8_STAGE(PG8_SB(1, 0), b3, voffB); PG8_STAGE(PG8_SB(1, 1), b3 + hstep, voffB); PG8_STAGE2(PG8_SA(1, 0), a3, o00, o01);
            PG8_WAIT_V(8); PG8_WAIT_L(0); PG8_BAR; PG8_MMA(1, 0, At, B0); PG8_MMA(1, 1, At, B1); PG8_BAR; PG8_SCHED;
        }
        if (wr == 0) PG8_BAR;
        if constexpr (F8) asm volatile("s_nop 15\n\ts_nop 15" ::: "memory");
        E(acc, cur, wr, wc, fr, fq);
        if (!has_next) break;
#pragma unroll
        for (int a = 0; a < 2; ++a)
#pragma unroll
            for (int b = 0; b < 2; ++b)
#pragma unroll
                for (int m = 0; m < 4; ++m)
#pragma unroll
                    for (int n = 0; n < 2; ++n) acc[a][b][m][n] = (f32x4){0.f, 0.f, 0.f, 0.f};
        cur = nxt; cA = nA; cB = nB; ++ui;
        { const int t3 = sl_nx; sl_nx = sl_n2; sl_n2 = (sl_n2 == 2) ? 0 : sl_n2 + 1; (void)t3; }
        if constexpr (GATHER) { const LAS int* tb = itab + ((sl_nx == 0) ? 2 : sl_nx - 1) * 256;
#pragma unroll
            for (int h = 0; h < 2; ++h)
#pragma unroll
                for (int i = 0; i < 2; ++i) { int R, C; stage_rc((lane + wid * 64) * 16 + i * 8192, R, C); vG[h][i] = (unsigned)tb[h * HALF + R] * RB + (unsigned)C * 2u; } }
        if (wr == 1) PG8_BAR;
    }
    PG8_WAIT_V(0);
    PG8_BAR;
#undef PG8_SA
#undef PG8_SB
#undef PG8_STAGE
#undef PG8_STAGE2
#undef PG8_LDA
#undef PG8_LDB
#undef PG8_MMA
#undef PG8_LD8
#undef PG8_WAIT_V
#undef PG8_WAIT_L
#undef PG8_BAR
#undef PG8_SCHED
}
}

namespace att {
typedef unsigned short bf16;
typedef short bf16x8 __attribute__((ext_vector_type(8)));
typedef short s16x4 __attribute__((ext_vector_type(4)));
typedef float f32x16 __attribute__((ext_vector_type(16)));
typedef unsigned u32x4 __attribute__((ext_vector_type(4)));
typedef float f32x4 __attribute__((ext_vector_type(4)));
typedef float f32x2_t __attribute__((ext_vector_type(2)));
typedef __bf16 bf16x2_t __attribute__((ext_vector_type(2)));
constexpr int NSLOT = 3, KSLOT = 12288, VSLOT = 8192;
constexpr int L_K = 0, L_V = NSLOT * KSLOT, L_WS = L_V + NSLOT * VSLOT, L_OST = L_WS + 8 * 64 * 4, L_TAB = 114688, L_END = L_TAB + 8 * 465 * 4;
static_assert(L_OST + 8 * 4096 <= L_TAB, "attention LDS");
static_assert(L_END <= 131072, "attention LDS");
constexpr int N_KSL = 8192, N_V = 4 * N_KSL, N_WS = N_V + 4 * VSLOT, N_OST = N_WS + 8 * 64 * 4;
static_assert(N_OST + 8 * 4096 <= L_TAB, "neighbourhood attention LDS");
constexpr float LOG2E = 1.4426950408889634f, LN2 = 0.6931471805599453f;
constexpr float THR = 8.0f;
__device__ __forceinline__ int crow(int r, int hi) { return (r & 3) + 8 * (r >> 2) + 4 * hi; }
#define ATT_SBAR() __builtin_amdgcn_sched_barrier(0)
__device__ __forceinline__ void glds16(const void* gsrc, unsigned lds_dst) { unsigned keep;
  asm volatile("s_mov_b32 %0, m0\n\ts_mov_b32 m0, %2\n\ts_nop 0\n\tglobal_load_lds_dwordx4 %1, off\n\ts_mov_b32 m0, %0" : "=&s"(keep) : "v"(gsrc), "s"(lds_dst) : "memory"); }
__device__ __forceinline__ void glds16s(unsigned vofs, const void* sbase, unsigned lds_dst) { unsigned keep;
  asm volatile("s_mov_b32 %0, m0\n\ts_mov_b32 m0, %3\n\ts_nop 0\n\tglobal_load_lds_dwordx4 %1, %2\n\ts_mov_b32 m0, %0" : "=&s"(keep) : "v"(vofs), "s"(sbase), "s"(lds_dst) : "memory"); }
__device__ __forceinline__ float max3f(float a, float b, float c) { float r; asm("v_max3_f32 %0, %1, %2, %3" : "=v"(r) : "v"(a), "v"(b), "v"(c)); return r; }
__device__ __forceinline__ unsigned cvtpk_s(float lo, float hi) { f32x2_t v = {lo, hi}; bf16x2_t b = __builtin_convertvector(v, bf16x2_t); return __builtin_bit_cast(unsigned, b); }
__device__ __forceinline__ float bf2f(short s) { return __uint_as_float(((unsigned)(unsigned short)s) << 16); }
#define ATT_WAIT_BAR(N) asm volatile("s_waitcnt vmcnt(" #N ") lgkmcnt(0)\n\ts_barrier" ::: "memory")

template <int ND0> __device__ __forceinline__ void qkt(f32x16& p0, f32x16& p1, const LAS unsigned char* Kslot, const bf16x8* qr, int r32, int hi) {
  const LAS unsigned char* kb = Kslot + hi * 1024 + r32 * 16;
#pragma unroll
  for (int d0 = 0; d0 < ND0; ++d0) {
    const bf16x8 b0 = *(const LAS bf16x8*)(kb + d0 * 2048);
    const bf16x8 b1 = *(const LAS bf16x8*)(kb + d0 * 2048 + 512);
    p0 = __builtin_amdgcn_mfma_f32_32x32x16_bf16(b0, qr[d0], p0, 0, 0, 0); p1 = __builtin_amdgcn_mfma_f32_32x32x16_bf16(b1, qr[d0], p1, 0, 0, 0); }
}
__device__ __forceinline__ float rowmax(const f32x16& p0, const f32x16& p1) {
  float a = max3f(p0[0], p0[1], p1[0]), b = max3f(p0[2], p0[3], p1[1]); a = max3f(a, p1[2], p1[3]);
#pragma unroll
  for (int r = 4; r < 16; r += 4) { a = max3f(a, p0[r], p0[r + 1]); b = max3f(b, p0[r + 2], p0[r + 3]); a = max3f(a, p1[r], p1[r + 1]); b = max3f(b, p1[r + 2], p1[r + 3]); }
  const float m = fmaxf(a, b);
  auto rr = __builtin_amdgcn_permlane32_swap(__float_as_uint(m), __float_as_uint(m), false, false);
  return fmaxf(__uint_as_float(rr[0]), __uint_as_float(rr[1]));
}
__device__ __forceinline__ void pv(f32x16* o, int vb, bf16x8 pa0, bf16x8 pa1, bf16x8 pa2, bf16x8 pa3) {
#pragma unroll
  for (int d0 = 0; d0 < 2; ++d0) { s16x4 lo[4], hi[4];
#pragma unroll
    for (int ks = 0; ks < 4; ++ks) {
      asm volatile("ds_read_b64_tr_b16 %0,%1 offset:%c2" : "=&v"(lo[ks]) : "v"(vb), "i"(d0 * 4096 + ks * 1024) : "memory");
      asm volatile("ds_read_b64_tr_b16 %0,%1 offset:%c2" : "=&v"(hi[ks]) : "v"(vb), "i"(d0 * 4096 + ks * 1024 + 512) : "memory"); }
    asm volatile("s_waitcnt lgkmcnt(0)" ::: "memory"); ATT_SBAR();
#define ATT_PK(k) (bf16x8){lo[k][0], lo[k][1], lo[k][2], lo[k][3], hi[k][0], hi[k][1], hi[k][2], hi[k][3]}
    o[d0] = __builtin_amdgcn_mfma_f32_32x32x16_bf16(pa0, ATT_PK(0), o[d0], 0, 0, 0);
    o[d0] = __builtin_amdgcn_mfma_f32_32x32x16_bf16(pa1, ATT_PK(1), o[d0], 0, 0, 0);
    o[d0] = __builtin_amdgcn_mfma_f32_32x32x16_bf16(pa2, ATT_PK(2), o[d0], 0, 0, 0);
    o[d0] = __builtin_amdgcn_mfma_f32_32x32x16_bf16(pa3, ATT_PK(3), o[d0], 0, 0, 0);
#undef ATT_PK
  }
}

template <int KLO, int KHI> __device__ __forceinline__ void pv_r(f32x16* o, int vb, bf16x8 pa0, bf16x8 pa1, bf16x8 pa2, bf16x8 pa3) {
#pragma unroll
  for (int d0 = 0; d0 < 2; ++d0) { s16x4 lo[4], hi[4];
#pragma unroll
    for (int ks = KLO; ks < KHI; ++ks) {
      asm volatile("ds_read_b64_tr_b16 %0,%1 offset:%c2" : "=&v"(lo[ks]) : "v"(vb), "i"(d0 * 4096 + ks * 1024) : "memory");
      asm volatile("ds_read_b64_tr_b16 %0,%1 offset:%c2" : "=&v"(hi[ks]) : "v"(vb), "i"(d0 * 4096 + ks * 1024 + 512) : "memory"); }
    asm volatile("s_waitcnt lgkmcnt(0)" ::: "memory"); ATT_SBAR();
#define ATT_PK(k) (bf16x8){lo[k][0], lo[k][1], lo[k][2], lo[k][3], hi[k][0], hi[k][1], hi[k][2], hi[k][3]}
    if (KLO <= 0 && 0 < KHI) o[d0] = __builtin_amdgcn_mfma_f32_32x32x16_bf16(pa0, ATT_PK(0), o[d0], 0, 0, 0);
    if (KLO <= 1 && 1 < KHI) o[d0] = __builtin_amdgcn_mfma_f32_32x32x16_bf16(pa1, ATT_PK(1), o[d0], 0, 0, 0);
    if (KLO <= 2 && 2 < KHI) o[d0] = __builtin_amdgcn_mfma_f32_32x32x16_bf16(pa2, ATT_PK(2), o[d0], 0, 0, 0);
    if (KLO <= 3 && 3 < KHI) o[d0] = __builtin_amdgcn_mfma_f32_32x32x16_bf16(pa3, ATT_PK(3), o[d0], 0, 0, 0);
#undef ATT_PK
  }
}
template <class P, int VAR> __device__ __forceinline__ float rowmax_v(const f32x16& p0, const f32x16& p1) {
  const f32x16& F = (VAR == 0) ? p0 : p1; const f32x16& H = (VAR == 0) ? p1 : p0; constexpr int o = P::live4(VAR);
  float a = max3f(F[0], F[1], F[2]), b = max3f(F[3], F[4], F[5]); a = max3f(a, F[6], F[7]); b = max3f(b, F[8], F[9]); a = max3f(a, F[10], F[11]); b = max3f(b, F[12], F[13]); a = max3f(a, F[14], F[15]);
  b = max3f(b, H[o], H[o + 1]); a = max3f(a, H[o + 2], H[o + 3]);
  const float m = fmaxf(a, b);
  auto rr = __builtin_amdgcn_permlane32_swap(__float_as_uint(m), __float_as_uint(m), false, false);
  return fmaxf(__uint_as_float(rr[0]), __uint_as_float(rr[1]));
}
template <class P, class R> __device__ __forceinline__ void attn_unit(int wv, const P& pol, LAS unsigned char* shm, R& rider, const P& nxt, bool has_nxt, bool pre) {
  constexpr int ND0 = P::ND0;
  const int tid = opaque_tid(wv), lane = tid & 63, r32 = lane & 31, hi = lane >> 5; const int wid = __builtin_amdgcn_readfirstlane(tid >> 6);
  const unsigned lds0 = (unsigned)(uintptr_t)shm;
  static_assert(ND0 == 4, "this unit's ring is laid out for qk dim 64 (8 KiB K tiles): four slots, requests three tiles ahead");
  LAS float* wsf = (LAS float*)(shm + N_WS) + wid * 64;
  const int NT = pol.ntiles();
  const bool three = (ND0 == 6) && (wid < 4);
#define ATT_DMA_P(PL, t, slot) do { \
    glds16((PL).k_src((t), wid, lane), (unsigned)__builtin_amdgcn_readfirstlane(lds0 + (slot) * N_KSL + wid * 1024)); \
    glds16((PL).v_src((t), wid, lane), (unsigned)__builtin_amdgcn_readfirstlane(lds0 + N_V + (slot) * VSLOT + wid * 1024)); } while (0)
#define ATT_DMA(t, slot) ATT_DMA_P(pol, t, slot)
  if (!pre) { ATT_DMA(0, 0); ATT_DMA(1, 1); ATT_DMA(2, 2); }
  bf16x8 qr[ND0];
  { const bf16* qp = pol.q_ptr(wid, r32);
#pragma unroll
    for (int d0 = 0; d0 < ND0; ++d0) qr[d0] = *reinterpret_cast<const bf16x8*>(qp + d0 * 16 + hi * 8); }
  pol.q_fix(qr, wid, r32, hi);
  float m = -1e30f, lsum = 0.f; f32x16 o[2]; o[0] = f32x16{}; o[1] = f32x16{};
  const int vb0 = (int)(lds0 + N_V) + ((lane >> 4) & 1) * 32 + (lane & 3) * 8 + (4 * hi + ((lane & 15) >> 2)) * 64;
  ATT_WAIT_BAR(0);
  f32x4 rw[R::NW]; rider.begin(lane, rw);
  int s_cur = 0, s_n3 = 3;
  for (int t = 0; t < NT; ++t) {
    if (t + 3 < NT) ATT_DMA(t + 3, s_n3);
    const int xr = rider.mid(t, NT, lane, rw);
    if (pol.needs(t, wid)) {
#define ATT_BODY(VAR) do { \
      f32x16 p0 = f32x16{}, p1 = f32x16{}; \
      qkt<ND0>(p0, p1, shm + s_cur * N_KSL, qr, r32, hi); \
      pol.template transform_v<VAR>(p0, p1, t, wid, r32, hi); \
      const float rm = rowmax_v<P, VAR>(p0, p1); \
      const bool grow = rm > m + THR; \
      if (__any(grow)) { \
        const float mn = grow ? rm : m; const float f = __builtin_amdgcn_exp2f(m - mn); m = mn; lsum *= f; \
        if (hi == 0) wsf[r32] = f; \
        asm volatile("s_waitcnt lgkmcnt(0)" ::: "memory"); \
        _Pragma("unroll") for (int r = 0; r < 16; ++r) { const float ff = wsf[crow(r, hi)]; o[0][r] *= ff; o[1][r] *= ff; } } \
      float sacc = 0.f; \
      _Pragma("unroll") for (int r = 0; r < 16; ++r) { \
        if (!P::dead(VAR, 0, r)) { p0[r] = __builtin_amdgcn_exp2f(p0[r] - m); sacc += p0[r]; } else p0[r] = 0.f; \
        if (!P::dead(VAR, 1, r)) { p1[r] = __builtin_amdgcn_exp2f(p1[r] - m); sacc += p1[r]; } else p1[r] = 0.f; } \
      lsum += sacc; \
      u32x4 pw0, pw1, pw2, pw3; \
      pw0 = (u32x4){cvtpk_s(p0[0], p0[1]), cvtpk_s(p0[2], p0[3]), cvtpk_s(p0[4], p0[5]), cvtpk_s(p0[6], p0[7])}; \
      pw1 = (u32x4){cvtpk_s(p0[8], p0[9]), cvtpk_s(p0[10], p0[11]), cvtpk_s(p0[12], p0[13]), cvtpk_s(p0[14], p0[15])}; \
      pw2 = (u32x4){cvtpk_s(p1[0], p1[1]), cvtpk_s(p1[2], p1[3]), cvtpk_s(p1[4], p1[5]), cvtpk_s(p1[6], p1[7])}; \
      pw3 = (u32x4){cvtpk_s(p1[8], p1[9]), cvtpk_s(p1[10], p1[11]), cvtpk_s(p1[12], p1[13]), cvtpk_s(p1[14], p1[15])}; \
      ATT_SBAR(); \
      pv_r<P::kslo(VAR), P::kshi(VAR)>(o, vb0 + s_cur * VSLOT, __builtin_bit_cast(bf16x8, pw0), __builtin_bit_cast(bf16x8, pw1), __builtin_bit_cast(bf16x8, pw2), __builtin_bit_cast(bf16x8, pw3)); \
      } while (0)
      if (pol.variant(wid)) ATT_BODY(1); else ATT_BODY(0);
#undef ATT_BODY
    }
    if (xr == 16 && t + 3 < NT) ATT_WAIT_BAR(20); else if (xr == 20 && t + 3 < NT) ATT_WAIT_BAR(24);
    else if (t + 3 < NT) ATT_WAIT_BAR(4); else if (t + 2 < NT) ATT_WAIT_BAR(2); else ATT_WAIT_BAR(0);
    s_cur = (s_cur + 1) & 3; s_n3 = (s_n3 + 1) & 3;
  }
  rider.end(lane, rw);
  if (has_nxt) { ATT_DMA_P(nxt, 0, 0); ATT_DMA_P(nxt, 1, 1); ATT_DMA_P(nxt, 2, 2); }
  { auto rr = __builtin_amdgcn_permlane32_swap(__float_as_uint(lsum), __float_as_uint(lsum), false, false); lsum = __uint_as_float(rr[0]) + __uint_as_float(rr[1]); }
  if (hi == 0) { wsf[32 + r32] = lsum; pol.lse_out(wid, r32, (m + __builtin_amdgcn_logf(lsum)) * LN2); }
  asm volatile("s_waitcnt lgkmcnt(0)" ::: "memory");
  float rli[16];
#pragma unroll
  for (int r = 0; r < 16; ++r) rli[r] = __builtin_amdgcn_rcpf(wsf[32 + crow(r, hi)]);
  { LAS bf16* stg = (LAS bf16*)(shm + N_OST) + wid * 2048;
#pragma unroll
    for (int r = 0; r < 16; ++r) { const int orow = crow(r, hi);
#pragma unroll
      for (int d0 = 0; d0 < 2; ++d0) stg[orow * 64 + d0 * 32 + r32] = (bf16)(cvtpk_s(o[d0][r] * rli[r], 0.f) & 0xffffu); }
    asm volatile("s_waitcnt lgkmcnt(0)" ::: "memory");
#pragma unroll
    for (int i = 0; i < 4; ++i) { const int row = i * 8 + (lane >> 3), ch = lane & 7; const u32x4 v = *(const LAS u32x4*)(stg + row * 64 + ch * 8); *(u32x4*)(pol.o_ptr(wid, row) + ch * 8) = v; } }
  asm volatile("s_waitcnt lgkmcnt(0)\n\ts_barrier" ::: "memory");
#undef ATT_DMA
#undef ATT_DMA_P
}

typedef short v4i16_t __attribute__((ext_vector_type(4)));
__device__ __forceinline__ s16x4 vtr(const LAS unsigned char* p) { return __builtin_bit_cast(s16x4, __builtin_amdgcn_ds_read_tr16_b64_v4i16((LAS v4i16_t*)p)); }
#define ATT_PIN(x) asm volatile("" : "+v"(x))
#define ATT_MFMA(a, b, c) __builtin_amdgcn_mfma_f32_32x32x16_bf16(a, b, c, 0, 0, 0)
template <class P, class R> __device__ __forceinline__ void attn_unit_pipe(int wv, const P& pol, LAS unsigned char* shm, R& rider, const P& nxt, bool has_nxt, bool pre) {
  static_assert(P::ND0 == 6 && P::FUSED, "dense pipelined unit: qk dim 96, scale folded into the exponent");
  const int tid = opaque_tid(wv), lane = tid & 63, r32 = lane & 31, hi = lane >> 5; const int wid = __builtin_amdgcn_readfirstlane(tid >> 6);
  const unsigned lds0 = (unsigned)(uintptr_t)shm;
  LAS float* wsf = (LAS float*)(shm + L_WS) + wid * 64;
  const int NT = pol.ntiles();
  const bool three = wid < 4;
  const unsigned kofs = P::k_lofs(wid, lane), k2ofs = P::k2_lofs(wid, lane), vofs = P::v_lofs(wid, lane);
  const unsigned kdst = (unsigned)__builtin_amdgcn_readfirstlane(lds0 + L_K + wid * 1024), vdst = (unsigned)__builtin_amdgcn_readfirstlane(lds0 + L_V + wid * 1024);
#define ATT_DMAK(PL, t, slot) do { glds16s(kofs, (PL).k_base() + (size_t)(t) * P::KSTRIDE, kdst + (slot) * KSLOT); \
    if (three) glds16s(k2ofs, (PL).k2_base() + (size_t)(t) * P::K2STRIDE, kdst + 8192 + (slot) * KSLOT); } while (0)
#define ATT_DMAV(PL, t, slot) glds16s(vofs, (PL).k_base() + (size_t)(t) * P::KSTRIDE, vdst + (slot) * VSLOT)
  if (!pre) { ATT_DMAK(pol, 0, 0); ATT_DMAK(pol, 1, 1); }
  bf16x8 qr[6];
  { const bf16* qp = pol.q_ptr(wid, r32);
#pragma unroll
    for (int d0 = 0; d0 < 6; ++d0) qr[d0] = *reinterpret_cast<const bf16x8*>(qp + d0 * 16 + hi * 8); }
  pol.q_fix(qr, wid, r32, hi);
  ATT_DMAV(pol, 0, 0);
  float mhat = 0.f, lsum = 0.f; f32x16 o[2]; o[0] = f32x16{}; o[1] = f32x16{};
  const LAS unsigned char* vp0 = shm + L_V + ((lane >> 4) & 1) * 32 + (lane & 3) * 8 + (4 * hi + ((lane & 15) >> 2)) * 64;
  const LAS unsigned char* kp0 = shm + L_K + hi * 1024 + r32 * 16;
  f32x16 pA0, pA1, pB0, pB1; u32x4 pw0, pw1, pw2, pw3; bool resc = false, rl = false;
  asm volatile("s_waitcnt vmcnt(1) lgkmcnt(0)\n\ts_barrier" ::: "memory");
  f32x4 rw[R::NW]; rider.begin(lane, rw);
  int sl_prev = 2, sl_cur = 0, sl_next = 1;
#define ATT_ROT() do { const int t_ = sl_prev; sl_prev = sl_cur; sl_cur = sl_next; sl_next = t_; } while (0)
#define ATT_KF(i) (*(const LAS bf16x8*)(kp_ + ((i) >> 1) * 2048 + ((i) & 1) * 512))
#define ATT_EX(v) __builtin_amdgcn_exp2f(__builtin_fmaf((v), P::SC, nmh))
#define ATT_RESC() do { if (resc) { _Pragma("unroll") for (int d_ = 0; d_ < 2; ++d_) _Pragma("unroll") for (int r = 0; r < 16; ++r) o[d_][r] *= wsf[crow(r, hi)]; } } while (0)
  ATT_DMAK(pol, 2, 2); ATT_DMAV(pol, 1, 1);
  { const LAS unsigned char* kp_ = kp0; pA0 = f32x16{}; pA1 = f32x16{};
#pragma unroll
    for (int d0 = 0; d0 < 6; ++d0) { const bf16x8 b0 = ATT_KF(2 * d0), b1 = ATT_KF(2 * d0 + 1); pA0 = ATT_MFMA(b0, qr[d0], pA0); pA1 = ATT_MFMA(b1, qr[d0], pA1); }
    const float rm = rowmax(pA0, pA1); mhat = rm * P::SC; const float nmh = -mhat;
#pragma unroll
    for (int r = 0; r < 16; ++r) pA0[r] = ATT_EX(pA0[r]);
#pragma unroll
    for (int r = 0; r < 8; ++r) pA1[r] = ATT_EX(pA1[r]); }
  if (three) ATT_WAIT_BAR(3); else ATT_WAIT_BAR(2);
  ATT_ROT();
#define ATT_PKW(X, i) cvtpk_s(X[i], X[(i) + 1])
#define ATT_PAF(k) __builtin_bit_cast(bf16x8, pw##k)
#define ATT_VFR(v) (bf16x8){v##l[0], v##l[1], v##l[2], v##l[3], v##h[0], v##h[1], v##h[2], v##h[3]}
#define ATT_VRD(v, f) do { v##l = vtr(vp_ + ((f) >> 2) * 4096 + ((f) & 3) * 1024); v##h = vtr(vp_ + ((f) >> 2) * 4096 + ((f) & 3) * 1024 + 512); } while (0)
#define ATT_GAPE(LD, MF, X, i) do { LD; MF; X[i] = ATT_EX0(X[i]); X[(i) + 1] = ATT_EX0(X[(i) + 1]); ATT_PIN(X); ATT_SBAR(); } while (0)
#define ATT_GAPA(LD, MF, a0, a1, a2, a3, W0, W1, PW) do { LD; MF; sacc += a0; sacc += a1; sacc += a2; sacc += a3; W0; W1; ATT_PIN(PW); ATT_PIN(sacc); ATT_SBAR(); } while (0)
#define ATT_GAPB(LD, MF, X, a, Y, b, Z, c) do { LD; MF; X[a] = ATT_EX(X[a]); Y[b] = ATT_EX(Y[b]); Z[c] = ATT_EX(Z[c]); ATT_PIN(X); ATT_PIN(Z); ATT_SBAR(); } while (0)
#define ATT_EX0(v) __builtin_amdgcn_exp2f(__builtin_fmaf((v), P::SC, nmh0))
#define ATT_STEP(C0, C1, P0, P1, s, GK, GV) do { ATT_SBAR(); \
    rl = rider.pre((s), lane, rw);                                  \
    if (GK) ATT_DMAK(pol, (s) + 2, sl_prev); if (GV) ATT_DMAV(pol, (s) + 1, sl_next); \
    if (rl) rider.post(lane, rw);                                   \
    const LAS unsigned char* kp_ = kp0 + sl_cur * KSLOT; const LAS unsigned char* vp_ = vp0 + sl_prev * VSLOT; const float nmh0 = -mhat; \
    bf16x8 k0 = ATT_KF(0), k1 = ATT_KF(1), k2; s16x4 vAl, vAh, vBl, vBh, vCl, vCh; ATT_SBAR(); \
    ATT_GAPE(k2 = ATT_KF(2),  C0 = ATT_MFMA(k0, qr[0], f32x16{}), P1, 8); \
    ATT_GAPE(k0 = ATT_KF(3),  C1 = ATT_MFMA(k1, qr[0], f32x16{}), P1, 10); \
    ATT_GAPE(k1 = ATT_KF(4),  C0 = ATT_MFMA(k2, qr[1], C0),       P1, 12); \
    ATT_GAPE(k2 = ATT_KF(5),  C1 = ATT_MFMA(k0, qr[1], C1),       P1, 14); \
    float sacc = P0[0] + P0[1]; \
    ATT_GAPA(k0 = ATT_KF(6),  C0 = ATT_MFMA(k1, qr[2], C0),       P0[2], P0[3], P0[4], P0[5],     pw0[0] = ATT_PKW(P0, 0),  pw0[1] = ATT_PKW(P0, 2),  pw0); \
    ATT_GAPA(k1 = ATT_KF(7),  C1 = ATT_MFMA(k2, qr[2], C1),       P0[6], P0[7], P0[8], P0[9],     pw0[2] = ATT_PKW(P0, 4),  pw0[3] = ATT_PKW(P0, 6),  pw0); \
    ATT_GAPA(k2 = ATT_KF(8),  C0 = ATT_MFMA(k0, qr[3], C0),       P0[10], P0[11], P0[12], P0[13], pw1[0] = ATT_PKW(P0, 8),  pw1[1] = ATT_PKW(P0, 10), pw1); \
    ATT_GAPA(k0 = ATT_KF(9),  C1 = ATT_MFMA(k1, qr[3], C1),       P0[14], P0[15], P1[0], P1[1],   pw1[2] = ATT_PKW(P0, 12), pw1[3] = ATT_PKW(P0, 14), pw1); \
    ATT_GAPA(k1 = ATT_KF(10), C0 = ATT_MFMA(k2, qr[4], C0),       P1[2], P1[3], P1[4], P1[5],     pw2[0] = ATT_PKW(P1, 0),  pw2[1] = ATT_PKW(P1, 2),  pw2); \
    ATT_GAPA(k2 = ATT_KF(11), C1 = ATT_MFMA(k0, qr[4], C1),       P1[6], P1[7], P1[8], P1[9],     pw2[2] = ATT_PKW(P1, 4),  pw2[3] = ATT_PKW(P1, 6),  pw2); \
    ATT_GAPA(ATT_VRD(vA, 0),  C0 = ATT_MFMA(k1, qr[5], C0),       P1[10], P1[11], P1[12], P1[13], pw3[0] = ATT_PKW(P1, 8),  pw3[1] = ATT_PKW(P1, 10), pw3); \
    ATT_GAPA(ATT_VRD(vB, 4),  C1 = ATT_MFMA(k2, qr[5], C1),       P1[14], P1[15], 0.f, 0.f,       pw3[2] = ATT_PKW(P1, 12), pw3[3] = ATT_PKW(P1, 14), pw3); \
    lsum += sacc; \
    { const float rm = __builtin_fmaf(rowmax(C0, C1), P::SC, -mhat); resc = false;                                        \
      if (__builtin_expect(__any(rm > THR), 0)) { const float dl = __builtin_fmaxf(rm, 0.f); mhat += dl;                   \
          const float f = __builtin_amdgcn_exp2f(-dl); lsum *= f; if (hi == 0) wsf[r32] = f; resc = true; } } \
    const float nmh = -mhat; ATT_SBAR(); \
    ATT_GAPB(ATT_VRD(vC, 1), o[0] = ATT_MFMA(ATT_PAF(0), ATT_VFR(vA), o[0]), C0, 0,  C0, 1,  C0, 2); \
    ATT_GAPB(ATT_VRD(vA, 5), o[1] = ATT_MFMA(ATT_PAF(0), ATT_VFR(vB), o[1]), C0, 3,  C0, 4,  C0, 5); \
    ATT_GAPB(ATT_VRD(vB, 2), o[0] = ATT_MFMA(ATT_PAF(1), ATT_VFR(vC), o[0]), C0, 6,  C0, 7,  C0, 8); \
    ATT_GAPB(ATT_VRD(vC, 6), o[1] = ATT_MFMA(ATT_PAF(1), ATT_VFR(vA), o[1]), C0, 9,  C0, 10, C0, 11); \
    ATT_GAPB(ATT_VRD(vA, 3), o[0] = ATT_MFMA(ATT_PAF(2), ATT_VFR(vB), o[0]), C0, 12, C0, 13, C0, 14); \
    ATT_GAPB(ATT_VRD(vB, 7), o[1] = ATT_MFMA(ATT_PAF(2), ATT_VFR(vC), o[1]), C0, 15, C1, 0,  C1, 1); \
    ATT_GAPB((void)0,        o[0] = ATT_MFMA(ATT_PAF(3), ATT_VFR(vA), o[0]), C1, 2,  C1, 3,  C1, 4); \
    ATT_GAPB((void)0,        o[1] = ATT_MFMA(ATT_PAF(3), ATT_VFR(vB), o[1]), C1, 5,  C1, 6,  C1, 7); \
    } while (0)
#define ATT_WAIT23() do { if (rl) { if (three) ATT_WAIT_BAR(7); else ATT_WAIT_BAR(6); } else { if (three) ATT_WAIT_BAR(3); else ATT_WAIT_BAR(2); } } while (0)
  int t = 1;
  for (; t + 3 < NT; t += 2) {
    ATT_STEP(pB0, pB1, pA0, pA1, t, true, true);      ATT_WAIT23(); ATT_RESC(); ATT_ROT();
    ATT_STEP(pA0, pA1, pB0, pB1, t + 1, true, true);  ATT_WAIT23(); ATT_RESC(); ATT_ROT();
  }
  ATT_STEP(pB0, pB1, pA0, pA1, t, true, true);        ATT_WAIT23();    ATT_RESC(); ATT_ROT();
  ATT_STEP(pA0, pA1, pB0, pB1, t + 1, false, true);   ATT_WAIT_BAR(1); ATT_RESC(); ATT_ROT();
  ATT_STEP(pB0, pB1, pA0, pA1, t + 2, false, false);  ATT_WAIT_BAR(0); ATT_RESC(); ATT_ROT();
  rider.end(lane, rw);
  if (has_nxt) { ATT_DMAK(nxt, 0, 0); ATT_DMAK(nxt, 1, 1); }
  { { const float nmh0 = -mhat;
#pragma unroll
      for (int r = 8; r < 16; ++r) pB1[r] = ATT_EX0(pB1[r]); }
    float sacc = pB0[0] + pB0[1];
#pragma unroll
    for (int r = 2; r < 16; ++r) sacc += pB0[r];
#pragma unroll
    for (int r = 0; r < 16; ++r) sacc += pB1[r];
    lsum += sacc;
    pw0 = (u32x4){ATT_PKW(pB0, 0), ATT_PKW(pB0, 2), ATT_PKW(pB0, 4), ATT_PKW(pB0, 6)}; pw1 = (u32x4){ATT_PKW(pB0, 8), ATT_PKW(pB0, 10), ATT_PKW(pB0, 12), ATT_PKW(pB0, 14)};
    pw2 = (u32x4){ATT_PKW(pB1, 0), ATT_PKW(pB1, 2), ATT_PKW(pB1, 4), ATT_PKW(pB1, 6)}; pw3 = (u32x4){ATT_PKW(pB1, 8), ATT_PKW(pB1, 10), ATT_PKW(pB1, 12), ATT_PKW(pB1, 14)};
    pv(o, (int)(lds0 + L_V) + ((lane >> 4) & 1) * 32 + (lane & 3) * 8 + (4 * hi + ((lane & 15) >> 2)) * 64 + sl_prev * VSLOT, ATT_PAF(0), ATT_PAF(1), ATT_PAF(2), ATT_PAF(3)); }
  { auto rr = __builtin_amdgcn_permlane32_swap(__float_as_uint(lsum), __float_as_uint(lsum), false, false); lsum = __uint_as_float(rr[0]) + __uint_as_float(rr[1]); }
  if (hi == 0) { wsf[32 + r32] = lsum; pol.lse_out(wid, r32, (mhat + __builtin_amdgcn_logf(lsum)) * LN2); }
  asm volatile("s_waitcnt lgkmcnt(0)" ::: "memory");
  float rli[16];
#pragma unroll
  for (int r = 0; r < 16; ++r) rli[r] = __builtin_amdgcn_rcpf(wsf[32 + crow(r, hi)]);
  { LAS bf16* stg = (LAS bf16*)(shm + L_OST) + wid * 2048;
#pragma unroll
    for (int r = 0; r < 16; ++r) { const int orow = crow(r, hi);
#pragma unroll
      for (int d0 = 0; d0 < 2; ++d0) stg[orow * 64 + d0 * 32 + r32] = (bf16)(cvtpk_s(o[d0][r] * rli[r], 0.f) & 0xffffu); }
    asm volatile("s_waitcnt lgkmcnt(0)" ::: "memory");
#pragma unroll
    for (int i = 0; i < 4; ++i) { const int row = i * 8 + (lane >> 3), ch = lane & 7; const u32x4 v = *(const LAS u32x4*)(stg + row * 64 + ch * 8); *(u32x4*)(pol.o_ptr(wid, row) + ch * 8) = v; } }
  asm volatile("s_waitcnt lgkmcnt(0)\n\ts_barrier" ::: "memory");
#undef ATT_DMAK
#undef ATT_DMAV
}
}

constexpr int NWAVES = 8, NTHREADS = NWAVES * 64;
constexpr int DM = 1024, NTOK = 65536, GTOK = 32768;
constexpr int NEXP = 16, CAP = 4096, FF = 2816;
constexpr int N_IN0 = 2048  , N_UP = 1792, K_UP = 384, N_DIL = 4608;
constexpr float LN_EPS = 1e-5f, RMS_EPS = 1e-6f, DN_ALPHA = 1.4142135623730951f;
constexpr int KSPLIT = 8;

constexpr size_t MiB = 1u << 20;
constexpr size_t WS_CTL = 0, CTL_ZERO_BYTES = 1 * MiB;
constexpr size_t WS_MODP = 1 * MiB;
constexpr size_t WS_MODF = 14 * MiB + 384 * 1024;
constexpr size_t WS_ROPE_R = 6 * MiB;
constexpr size_t WS_ROPE_H = 7 * MiB;
static_assert(13 * MiB + (size_t)N_UP * K_UP * 2 <= WS_MODF && WS_MODF + 4 * 12 * 3072 * 4 <= 15 * MiB, "adaLN table fits behind the up-projection weights");
constexpr size_t WS_WIN0 = 9 * MiB, WS_WUP = 13 * MiB, WS_WOUT0 = 15 * MiB, WS_WDIL = 17 * MiB, WS_WOUT1 = 26 * MiB;
constexpr size_t WS_AFF = 27 * MiB, WS_SLOTOF = 31 * MiB, WS_IDX = 35 * MiB, WS_GATEV = 35 * MiB + 512 * 1024;
constexpr size_t WS_W13 = 36 * MiB, WS_W2 = 212 * MiB, WS_H = 300 * MiB, WS_R = 428 * MiB;
constexpr size_t W13_L1OFF = 88 * MiB, W2_L1OFF = 44 * MiB;
constexpr size_t WS_PROJ = WS_R, WS_A2 = WS_R + 256 * MiB, WS_KPE = WS_R + 304 * MiB, WS_QKV2 = WS_R + 308 * MiB, WS_ATT = WS_R + 532 * MiB, WS_MIX = WS_R;
constexpr size_t WS_HH = WS_R, WS_YE = WS_R + 704 * MiB;
constexpr size_t WS_QKV = WS_R, WS_OG = WS_R + 576 * MiB, WS_LSE = WS_R + 768 * MiB, WS_MRG = WS_R + 774 * MiB;
constexpr size_t WS_END = WS_R + 960 * MiB;
constexpr int CW_BAR = 4096;

constexpr int RING_BYTES = 131072, LDSCTL_OFF = RING_BYTES, MISC_OFF = LDSCTL_OFF + 320, LDS_BYTES = 147456;

typedef unsigned short bf16;
typedef unsigned v4u __attribute__((ext_vector_type(4)));
typedef unsigned v2u __attribute__((ext_vector_type(2)));
typedef unsigned v2u __attribute__((ext_vector_type(2)));
typedef float f32x4 __attribute__((ext_vector_type(4)));
typedef GAS unsigned gu32;
#define RLX_AGENT __ATOMIC_RELAXED, __HIP_MEMORY_SCOPE_AGENT
#define LDS_WAIT() asm volatile("s_waitcnt lgkmcnt(0)" ::: "memory")
__device__ __forceinline__ unsigned f2bf(float f) { return att::cvtpk_s(f, 0.f) & 0xffffu; }
__device__ __forceinline__ unsigned pk2(float lo, float hi) { return att::cvtpk_s(lo, hi); }
__device__ __forceinline__ float bflo(unsigned w) { return __uint_as_float(w << 16); }
__device__ __forceinline__ float bfhi(unsigned w) { return __uint_as_float(w & 0xffff0000u); }

#define XB_TMO      128
#define XB_XCNT(j)  (256  + 64 * (j))
#define XB_XSUB(j)  (1280 + 64 * (j))
#define XB_XGEN(j)  (2304 + 64 * (j))
#define XB_TOP      3328
#define XB_TOPGEN   3392
#define XCD_BAR_WORDS 3456
#define XB_SPIN_CAP (1u << 18)
__device__ __forceinline__ unsigned xb_ld(unsigned* p)              { return __hip_atomic_load(p, __ATOMIC_RELAXED, __HIP_MEMORY_SCOPE_AGENT); }
__device__ __forceinline__ unsigned xb_add(unsigned* p, unsigned v) { return __hip_atomic_fetch_add(p, v, __ATOMIC_RELAXED, __HIP_MEMORY_SCOPE_AGENT); }
__device__ __forceinline__ unsigned xb_xcc_id() { return (unsigned)__builtin_amdgcn_s_getreg((3 << 11) | 20) & 0xFu; }
#define XB_SPIN(cond, bar) do { unsigned _sp = 0; while (cond) { __builtin_amdgcn_s_sleep(1); \
    if ((++_sp & 255u) == 0u) { if (xb_ld(&(bar)[XB_TMO])) break; if (_sp > XB_SPIN_CAP) { atomicAdd(&(bar)[XB_TMO], 1u); break; } } } } while (0)
struct XcdBarrier { unsigned* bar; unsigned x; volatile LAS unsigned* st; };
__device__ __forceinline__ XcdBarrier xcd_barrier_post(unsigned* bar, volatile LAS unsigned* st) {
    XcdBarrier b; b.bar = bar; b.x = xb_xcc_id(); b.st = st;
    if (threadIdx.x == 0) (void)xb_add(&bar[XB_XCNT(b.x)], 1u);
    return b;
}
__device__ __forceinline__ void xcd_barrier_complete(unsigned* bar, unsigned x, unsigned& nloc, unsigned& nx) {
    const unsigned G = gridDim.x * gridDim.y * gridDim.z;
    unsigned sum, cnt, mine, sp = 0u;
    for (;;) {
        sum = 0u; cnt = 0u; mine = 0u;
#pragma unroll
        for (unsigned j = 0; j < 16; ++j) { const unsigned c = xb_ld(&bar[XB_XCNT(j)]); sum += c; cnt += (c > 0u) ? 1u : 0u; mine = (j == x) ? c : mine; }
        if (sum == G) break;
        __builtin_amdgcn_s_sleep(1);
        if ((++sp & 255u) == 0u) { if (xb_ld(&bar[XB_TMO])) break; if (sp > XB_SPIN_CAP) { atomicAdd(&bar[XB_TMO], 1u); break; } }
    }
    nloc = mine > 0u ? mine : 1u; nx = cnt > 0u ? cnt : 1u;
}
__device__ __forceinline__ void xcd_barrier(const XcdBarrier& b, int wv) {
    asm volatile("s_waitcnt vmcnt(0)" ::: "memory");
    __syncthreads();
    if (opaque_tid(wv) == 0) {
        unsigned* bar = b.bar;
        __builtin_amdgcn_s_waitcnt(0);
        unsigned nloc = b.st[0], nx = b.st[1];
        if (nloc == 0u) { xcd_barrier_complete(bar, b.x, nloc, nx); b.st[0] = nloc; b.st[1] = nx; }
        const unsigned old = xb_add(&bar[XB_XSUB(b.x)], 1u);
        const unsigned gen = old / nloc;
        if (old + 1u == (gen + 1u) * nloc) {
            __builtin_amdgcn_fence(__ATOMIC_RELEASE, "agent");
            asm volatile("s_waitcnt vmcnt(0)" ::: "memory");
            const unsigned og = xb_add(&bar[XB_TOP], 1u);
            const unsigned tg = og / nx;
            if (og + 1u == (tg + 1u) * nx) xb_add(&bar[XB_TOPGEN], 1u);
            else XB_SPIN(xb_ld(&bar[XB_TOPGEN]) == tg, bar);
            __builtin_amdgcn_fence(__ATOMIC_ACQUIRE, "agent");
            xb_add(&bar[XB_XGEN(b.x)], 1u);
            asm volatile("s_waitcnt vmcnt(0)" ::: "memory");
        } else {
            XB_SPIN(xb_ld(&bar[XB_XGEN(b.x)]) == gen, bar);
            __builtin_amdgcn_fence(__ATOMIC_ACQUIRE, "agent");
            asm volatile("s_waitcnt vmcnt(0)" ::: "memory");
        }
    }
    __syncthreads();
}

struct Params {
    const float* in[25];
    float* out; unsigned char* ws;
    int ph_lo, ph_hi;
};
typedef const __attribute__((address_space(4))) Params* PP;
__device__ __forceinline__ PP params_ptr() { PP q = (PP)__builtin_amdgcn_kernarg_segment_ptr(); asm volatile("" : "+s"(q)); return q; }
__device__ __forceinline__ int tok_bidx(int t) { return t < GTOK ? (t >> 12) : 8 + ((t - GTOK) >> 13); }
__device__ __forceinline__ int tok_pos(int t) { return t < GTOK ? (t & 4095) : (t & 8191); }
__device__ __forceinline__ const float* x_in_row(PP p, int t) { return t < GTOK ? p->in[0] + (size_t)t * DM : p->in[1] + (size_t)(t - GTOK) * DM; }

template <int CTRL> __device__ __forceinline__ float dpp_f(float v) { return __int_as_float(__builtin_amdgcn_update_dpp(0, __float_as_int(v), CTRL, 0xf, 0xf, true)); }
template <int CTRL> __device__ __forceinline__ int dpp_i(int v) { return __builtin_amdgcn_update_dpp(0, v, CTRL, 0xf, 0xf, true); }
__device__ __forceinline__ float wave_sum(float v) {
    v += dpp_f<0xB1>(v); v += dpp_f<0x4E>(v); v += dpp_f<0x141>(v); v += dpp_f<0x140>(v);
    { auto rr = __builtin_amdgcn_permlane16_swap(__float_as_uint(v), __float_as_uint(v), false, false); v = __uint_as_float(rr[0]) + __uint_as_float(rr[1]); }
    { auto rr = __builtin_amdgcn_permlane32_swap(__float_as_uint(v), __float_as_uint(v), false, false); v = __uint_as_float(rr[0]) + __uint_as_float(rr[1]); }
    return v;
}
__device__ __forceinline__ int wave_sum_i(int v) {
    v += dpp_i<0xB1>(v); v += dpp_i<0x4E>(v); v += dpp_i<0x141>(v); v += dpp_i<0x140>(v);
    { auto rr = __builtin_amdgcn_permlane16_swap((unsigned)v, (unsigned)v, false, false); v = (int)(rr[0] + rr[1]); }
    { auto rr = __builtin_amdgcn_permlane32_swap((unsigned)v, (unsigned)v, false, false); v = (int)(rr[0] + rr[1]); }
    return v;
}

__device__ const float INV_R[16] = {1.0f, 0.562341332f, 0.316227764f, 0.177827939f, 0.100000001f, 0.0562341325f, 0.0316227749f, 0.0177827943f, 0.00999999978f, 0.00562341325f, 0.00316227763f, 0.00177827943f, 0.00100000005f, 0.000562341302f, 0.000316227757f, 0.00017782794f};
__device__ const float INV_H[32] = {1.0f, 0.749894202f, 0.562341332f, 0.421696514f, 0.316227764f, 0.237137377f, 0.177827939f, 0.133352146f, 0.100000001f, 0.0749894232f, 0.0562341325f, 0.0421696492f, 0.0316227749f, 0.0237137377f, 0.0177827943f, 0.013335214f, 0.00999999978f, 0.00749894232f, 0.00562341325f, 0.00421696482f, 0.00316227763f, 0.00237137382f, 0.00177827943f, 0.00133352145f, 0.00100000005f, 0.000749894185f, 0.000562341302f, 0.000421696517f, 0.000316227757f, 0.00023713737f, 0.00017782794f, 0.00013335215f};
__device__ __forceinline__ void cvt_item(const float* __restrict__ W, int ldw, int k0, int n0, bf16* WT, size_t ldk, size_t wt0, LAS float* scr, int lane, int rs = 1) {
#pragma unroll 8
    for (int i = 0; i < 32; ++i) { const int kk = 2 * i + (lane >> 5); scr[kk * 33 + (lane & 31)] = W[(size_t)(k0 + kk) * ldw + n0 + (lane & 31)]; }
    LDS_WAIT(); asm volatile("" ::: "memory");
    const int c = lane & 7;
#pragma unroll
    for (int j = 0; j < 4; ++j) { const int n = (lane >> 3) + 8 * j; const LAS float* s = scr + (8 * c) * 33 + n;
        v4u o; o.x = pk2(s[0 * 33], s[1 * 33]); o.y = pk2(s[2 * 33], s[3 * 33]); o.z = pk2(s[4 * 33], s[5 * 33]); o.w = pk2(s[6 * 33], s[7 * 33]);
        *(GAS v4u*)(WT + wt0 + (size_t)(n * rs) * ldk + 8 * c) = o; }
    LDS_WAIT(); asm volatile("" ::: "memory");
}
constexpr float W13_QS = 64.0f, W2_QS = 256.0f, YE_QS = 16.0f;
struct CvtTile { const float* W; int ldw, k0, n0; unsigned char* WT; size_t ldkb; size_t off0; float sc; bool f8; };
__device__ __forceinline__ void cvt_tile_load(const CvtTile& T, int lane, f32x4 (&w)[16]) {
    const float* src = T.W + (size_t)(T.k0 + 16 * (lane >> 4)) * T.ldw + T.n0 + 4 * (lane & 15);
#pragma unroll
    for (int i = 0; i < 16; ++i) w[i] = *(const GAS f32x4*)(src + (size_t)i * T.ldw);
}
template <bool F8> __device__ __forceinline__ void cvt_tile_store(const CvtTile& T, int lane, const f32x4 (&w)[16]) {
    const int q = lane >> 4, c = lane & 15;
#pragma unroll
    for (int j = 0; j < 4; ++j) { unsigned char* dst = T.WT + T.off0 + (size_t)(4 * c + j) * T.ldkb + (F8 ? 16 : 32) * q;
        if constexpr (F8) { v4u o; o.x = pg8::pk4_fp8(w[0][j] * T.sc, w[1][j] * T.sc, w[2][j] * T.sc, w[3][j] * T.sc); o.y = pg8::pk4_fp8(w[4][j] * T.sc, w[5][j] * T.sc, w[6][j] * T.sc, w[7][j] * T.sc);
            o.z = pg8::pk4_fp8(w[8][j] * T.sc, w[9][j] * T.sc, w[10][j] * T.sc, w[11][j] * T.sc); o.w = pg8::pk4_fp8(w[12][j] * T.sc, w[13][j] * T.sc, w[14][j] * T.sc, w[15][j] * T.sc); *(GAS v4u*)dst = o; }
        else { v4u o0, o1; o0.x = pk2(w[0][j], w[1][j]); o0.y = pk2(w[2][j], w[3][j]); o0.z = pk2(w[4][j], w[5][j]); o0.w = pk2(w[6][j], w[7][j]);
            o1.x = pk2(w[8][j], w[9][j]); o1.y = pk2(w[10][j], w[11][j]); o1.z = pk2(w[12][j], w[13][j]); o1.w = pk2(w[14][j], w[15][j]); *(GAS v4u*)dst = o0; *(GAS v4u*)(dst + 16) = o1; } }
}
__device__ __forceinline__ void cvt_tile_store_any(const CvtTile& T, int lane, const f32x4 (&w)[16]) { if (T.f8) cvt_tile_store<true>(T, lane, w); else cvt_tile_store<false>(T, lane, w); }
constexpr int MOE_TILES = NEXP * 2112;
__device__ __forceinline__ CvtTile moe_tile(PP p, int layer, int it, int ES) {
    CvtTile T; const int e = it / 2112, r = it % 2112, which = r / 704, q = r % 704;
    if (which < 2) { const int kb = q / 44, nb = q % 44; T.k0 = kb * 64; T.n0 = nb * 64; T.W = p->in[22 + which] + ((size_t)layer * NEXP + e) * (size_t)DM * FF; T.ldw = FF;
        const size_t row0 = (size_t)e * 5632 + (size_t)(T.n0 >> 7) * 256 + which * 128 + (T.n0 & 127);
        T.WT = p->ws + WS_W13 + (layer ? W13_L1OFF : 0); T.ldkb = (size_t)DM * ES; T.off0 = (row0 * DM + T.k0) * ES; T.sc = W13_QS; T.f8 = ES == 1;
    } else { const int kb = q / 16, nb = q % 16; T.k0 = kb * 64; T.n0 = nb * 64; T.W = p->in[24] + ((size_t)layer * NEXP + e) * (size_t)FF * DM; T.ldw = DM;
        T.WT = p->ws + WS_W2 + (layer ? W2_L1OFF : 0); T.ldkb = (size_t)FF; T.off0 = ((size_t)e * DM + T.n0) * FF + T.k0; T.sc = W2_QS; T.f8 = true; }
    return T;
}

__device__ __forceinline__ void p0_prologue(PP p, LAS unsigned char* lds, int vcu, int G, int tid, int lane, int wave) {
    LAS float* scr = (LAS float*)(lds + wave * 8448);
    LAS float* sc = (LAS float*)(lds + 69632);
    for (int i = tid; i < 12 * DM; i += NTHREADS) { const int b = i >> 10, k = i & 1023; const float c = b < 8 ? p->in[2][b * DM + k] : p->in[3][(b - 8) * DM + k];
        sc[i] = c / (1.0f + __expf(-c)); }
    __syncthreads();
    const int gw = vcu * NWAVES + wave, NGW = G * NWAVES;
    for (int it = gw; it < 4 * 48 * KSPLIT; it += NGW) {
        const int kc = it % KSPLIT, jb = (it / KSPLIT) % 48, mi = it / (KSPLIT * 48);
        const float* W = (mi & 1 ? p->in[17] : p->in[13]) + (size_t)(mi >> 1) * DM * 3072 + jb * 64 + lane;
        float acc[12];
#pragma unroll
        for (int b = 0; b < 12; ++b) acc[b] = 0.f;
        for (int k0 = kc * 128; k0 < kc * 128 + 128; k0 += 8) {
            float w[8];
#pragma unroll
            for (int i = 0; i < 8; ++i) w[i] = W[(size_t)(k0 + i) * 3072];
#pragma unroll
            for (int b = 0; b < 12; ++b) { const f32x4 s0 = *(const LAS f32x4*)(sc + b * DM + k0), s1 = *(const LAS f32x4*)(sc + b * DM + k0 + 4);
                acc[b] += w[0] * s0[0] + w[1] * s0[1] + w[2] * s0[2] + w[3] * s0[3] + w[4] * s1[0] + w[5] * s1[1] + w[6] * s1[2] + w[7] * s1[3]; }
        }
        float* o = (float*)(p->ws + WS_MODP) + ((size_t)(kc * 4 + mi) * 12) * 3072 + jb * 64 + lane;
#pragma unroll
        for (int b = 0; b < 12; ++b) o[(size_t)b * 3072] = acc[b];
    }
    for (int i = gw * 64 + lane; i < 8192 * 48; i += NGW * 64) {
        const int pos = i / 48, j = i % 48; const float inv = j < 16 ? INV_R[j] : INV_H[j - 16];
        const float ang = (float)pos * inv; double rev = (double)ang * 0.15915494309189535; rev -= floor(rev);
        const float rf = (float)rev; float2 cs; cs.x = __builtin_amdgcn_cosf(rf); cs.y = __builtin_amdgcn_sinf(rf);
        if (j < 16) ((float2*)(p->ws + WS_ROPE_R))[pos * 16 + j] = cs; else ((float2*)(p->ws + WS_ROPE_H))[pos * 32 + (j - 16)] = cs;
    }
    { const v4u z = {0u, 0u, 0u, 0u};
      for (int i = gw * 64 + lane; i < 12288 + 12288 + 32768; i += NGW * 64) {
        if (i < 12288) ((GAS v4u*)(p->ws + WS_WIN0 + (size_t)1952 * DM * 2))[i] = z;
        else if (i < 24576) { const int q = i - 12288, row = q >> 4, c = q & 15; *(GAS v4u*)(p->ws + WS_WUP + ((size_t)row * K_UP + 256) * 2 + c * 16) = z; }
        else { const int q = i - 24576, row = 768 + (q >> 5), c = q & 31; *(GAS v4u*)(p->ws + WS_WUP + (size_t)row * K_UP * 2 + c * 16) = z; } } }
    constexpr int I0 = 16 * 61, I1 = 4 * 24, I2 = 2 * 32, I3 = 16 * 32, I4 = 16 * 144, I5 = 8 * 32;
    for (int it = gw; it < I0 + I1 + I2 + I3 + I4 + I5; it += NGW) {
        int r = it;
        if (r < I0) { const int kb = r / 61, nb = r % 61; cvt_item(p->in[4], 1952, kb * 64, nb * 32, (bf16*)(p->ws + WS_WIN0), DM, (size_t)nb * 32 * DM + kb * 64, scr, lane); continue; } r -= I0;
        if (r < I1) { const int kb = r / 24, nb = r % 24; cvt_item(p->in[7], 768, kb * 64, nb * 32, (bf16*)(p->ws + WS_WUP), K_UP, (size_t)nb * 32 * K_UP + kb * 64, scr, lane); continue; } r -= I1;
        if (r < I2) { const int kb = r / 32, nb = r % 32; cvt_item(p->in[9], 1024, kb * 64, nb * 32, (bf16*)(p->ws + WS_WUP), K_UP, (size_t)(768 + nb * 32) * K_UP + 256 + kb * 64, scr, lane); continue; } r -= I2;
        if (r < I3) { const int kb = r / 32, nb = r % 32; cvt_item(p->in[10], 1024, kb * 64, nb * 32, (bf16*)(p->ws + WS_WOUT0), DM, (size_t)nb * 32 * DM + kb * 64, scr, lane); continue; } r -= I3;
        if (r < I4) { const int kb = r / 144, nb = r % 144, c0 = nb * 32;
            const bool qk = (c0 % 1536) < 1024; const int row0 = qk ? (c0 & ~63) + ((c0 >> 5) & 1) : c0;
            cvt_item(p->in[11], N_DIL, kb * 64, c0, (bf16*)(p->ws + WS_WDIL), DM, (size_t)row0 * DM + kb * 64, scr, lane, qk ? 2 : 1); continue; } r -= I4;
        { const int kb = r / 32, nb = r % 32; cvt_item(p->in[12], 1024, kb * 64, nb * 32, (bf16*)(p->ws + WS_WOUT1), 512, (size_t)nb * 32 * 512 + kb * 64, scr, lane); }
    }
}

__device__ __forceinline__ float mod_reduce(PP p, int mi, int b, int j) {
    float s = (mi & 1 ? p->in[18] : p->in[14])[(size_t)(mi >> 1) * 3072 + j];
    const float* mp = (const float*)(p->ws + WS_MODP) + ((size_t)mi * 12 + b) * 3072 + j;
#pragma unroll
    for (int kc = 0; kc < KSPLIT; ++kc) s += mp[(size_t)kc * 4 * 12 * 3072];
    return s;
}
template <bool FINAL> __device__ __forceinline__ void load_mod_vec(PP p, LAS float* dst, int mi, int b, int part, int tid) {
    if constexpr (FINAL) { const float* mf = (const float*)(p->ws + WS_MODF) + ((size_t)mi * 12 + b) * 3072 + part * DM; for (int j = tid; j < DM; j += NTHREADS) dst[j] = mf[j]; }
    else { for (int j = tid; j < DM; j += NTHREADS) dst[j] = mod_reduce(p, mi, b, part * DM + j); }
}
__device__ __forceinline__ void store_row_bf16(bf16* orow, const f32x4 (&v)[4], int lane) {
    GAS unsigned long long* o8 = (GAS unsigned long long*)orow + lane;
#pragma unroll
    for (int j = 0; j < 4; ++j) o8[64 * j] = (unsigned long long)pk2(v[j].x, v[j].y) | ((unsigned long long)pk2(v[j].z, v[j].w) << 32);
}

__device__ __forceinline__ void p1_modulate(PP p, LAS unsigned char* lds, int vcu, int G, int tid, int lane, int wave) {
    LAS float* vsh = (LAS float*)lds; LAS float* vsc = vsh + DM;
    for (int i = vcu * NTHREADS + tid; i < 4 * 12 * 3072; i += G * NTHREADS) ((float*)(p->ws + WS_MODF))[i] = mod_reduce(p, i / (12 * 3072), (i / 3072) % 12, i % 3072);
    for (int ch = vcu; ch < NTOK / 256; ch += G) {
        const int t0 = ch * 256, b = tok_bidx(t0);
        __syncthreads();
        load_mod_vec<false>(p, vsh, 0, b, 0, tid); load_mod_vec<false>(p, vsc, 0, b, 1, tid);
        __syncthreads();
        _Pragma("unroll 1") for (int i = 0; i < 32; ++i) { const int t = t0 + wave * 32 + i;
            const GAS f32x4* xr = (const GAS f32x4*)x_in_row(p, t) + lane; f32x4 v[4];
#pragma unroll
            for (int j = 0; j < 4; ++j) { const f32x4 x = xr[64 * j]; const f32x4 sh = *(const LAS f32x4*)(vsh + 4 * lane + 256 * j), sc = *(const LAS f32x4*)(vsc + 4 * lane + 256 * j); v[j] = x * (1.0f + sc) + sh; }
            store_row_bf16((bf16*)(p->ws + WS_H) + (size_t)t * DM, v, lane); }
    }
}

__device__ __forceinline__ void p3_mla_prep(PP p, int vcu, int G, int lane, int wave) {
    const int gw = vcu * NWAVES + wave, NGW = G * NWAVES;
    const bf16* proj = (const bf16*)(p->ws + WS_PROJ); bf16* a2 = (bf16*)(p->ws + WS_A2); bf16* kpe = (bf16*)(p->ws + WS_KPE);
    const f32x4 qn = *((const f32x4*)p->in[6] + lane); const float2 kn = *((const float2*)p->in[8] + lane);
    const int l16 = lane & 15;
#pragma unroll 1
    for (int t0 = gw; t0 < NTOK; t0 += 4 * NGW) {
        typedef float v2f __attribute__((ext_vector_type(2)));
        v2u ql[4]; unsigned kl[4], x1r[4], x2r[4]; v2f cs[4];
#pragma unroll
        for (int i = 0; i < 4; ++i) { const int tt = t0 + i * NGW, t = tt < NTOK ? tt : t0; const bf16* row = proj + (size_t)t * N_IN0;
            ql[i] = *(const GAS v2u*)(row + 1536 + 4 * lane); kl[i] = *(const GAS unsigned*)(row + 1792 + 2 * lane);
            x1r[i] = (unsigned)*(const GAS bf16*)(row + 1920 + l16); x2r[i] = (unsigned)*(const GAS bf16*)(row + 1936 + l16);
            cs[i] = ((const GAS v2f*)(p->ws + WS_ROPE_R))[tok_pos(t) * 16 + l16]; }
#pragma unroll
        for (int i = 0; i < 4; ++i) { const int t = t0 + i * NGW; if (t >= NTOK) break;
            const float q0 = bflo(ql[i].x), q1 = bfhi(ql[i].x), q2 = bflo(ql[i].y), q3 = bfhi(ql[i].y), k0 = bflo(kl[i]), k1 = bfhi(kl[i]);
            const float qs = wave_sum(q0 * q0 + q1 * q1 + q2 * q2 + q3 * q3), ks = wave_sum(k0 * k0 + k1 * k1);
            const float qr = 1.0f / sqrtf(qs * (1.0f / 256.0f) + RMS_EPS), kr = 1.0f / sqrtf(ks * (1.0f / 128.0f) + RMS_EPS);
            v2u qo; qo.x = pk2(q0 * qr * qn.x, q1 * qr * qn.y); qo.y = pk2(q2 * qr * qn.z, q3 * qr * qn.w);
            *(v2u*)(a2 + (size_t)t * K_UP + 4 * lane) = qo;
            *(unsigned*)(a2 + (size_t)t * K_UP + 256 + 2 * lane) = pk2(k0 * kr * kn.x, k1 * kr * kn.y);
            if (lane < 16) { const float x1 = bflo(x1r[i]), x2 = bflo(x2r[i]);
                kpe[(size_t)t * 32 + lane] = (bf16)f2bf(x1 * cs[i][0] - x2 * cs[i][1]); kpe[(size_t)t * 32 + 16 + lane] = (bf16)f2bf(x1 * cs[i][1] + x2 * cs[i][0]); } }
    }
}

__device__ __forceinline__ int moe1_split(int G) { return G >= 4 * NEXP ? MOE_TILES / 2 : MOE_TILES; }
__device__ __forceinline__ int moe1_split2(int G) { return G >= 4 * NEXP ? MOE_TILES - MOE_TILES / 4 : MOE_TILES; }
struct NoRider { static constexpr int NW = 1; __device__ __forceinline__ void begin(int, f32x4 (&)[1]) {} __device__ __forceinline__ int mid(int, int, int, f32x4 (&)[1]) { return 0; } __device__ __forceinline__ void end(int, f32x4 (&)[1]) {} };
template <bool F8> struct CvtRider {
    static constexpr int NW = 16;
    PP p; int layer, layer_b, ka, kb; CvtTile T; bool live;
    __device__ __forceinline__ void init(PP p_, int layer_, int ka_, int kb_, int layer_b_ = -1) { p = p_; layer = layer_; layer_b = layer_b_ < 0 ? layer_ : layer_b_; ka = ka_; kb = kb_; live = false; }
    __device__ __forceinline__ void begin(int lane, f32x4 (&w)[16]) { if (ka >= 0) { T = moe_tile(p, layer, ka, F8 ? 1 : 2); cvt_tile_load(T, lane, w); live = true; } }
    __device__ __forceinline__ int mid(int t, int NT, int lane, f32x4 (&w)[16]) { if (t == (NT >> 1) && kb >= 0) { int n = 16; if (live) { cvt_tile_store_any(T, lane, w); n += T.f8 ? 4 : 8; } T = moe_tile(p, layer_b, kb, F8 ? 1 : 2); cvt_tile_load(T, lane, w); live = true; return n; } return 0; }
    __device__ __forceinline__ void end(int lane, f32x4 (&w)[16]) { if (live) { cvt_tile_store_any(T, lane, w); live = false; } }
};
struct CvtStream {
    static constexpr int NW = 4;
    PP p; int ka, kb, nb; CvtTile T; bool live;
    __device__ __forceinline__ void init(PP p_, int ka_, int kb_) { p = p_; ka = ka_; kb = kb_; nb = 0; live = false; }
    __device__ __forceinline__ void begin(int, f32x4 (&)[4]) {}
    __device__ __forceinline__ void store(int lane, const f32x4 (&w)[4]) { const int r = lane >> 2, c4 = lane & 3, q4 = (nb - 1) & 3;
#pragma unroll
        for (int j = 0; j < 4; ++j) { unsigned char* dst = T.WT + T.off0 + (size_t)(16 * q4 + 4 * c4 + j) * T.ldkb;
            if (T.f8) *(GAS unsigned*)(dst + 4 * r) = pg8::pk4_fp8(w[0][j] * T.sc, w[1][j] * T.sc, w[2][j] * T.sc, w[3][j] * T.sc);
            else { v2u o; o.x = pk2(w[0][j], w[1][j]); o.y = pk2(w[2][j], w[3][j]); *(GAS v2u*)(dst + 8 * r) = o; } }
        live = false; }
    __device__ __forceinline__ bool pre(int s, int lane, f32x4 (&w)[4]) { if ((s & 3) != 0) return false; if (live) store(lane, w); return (nb < 4 ? ka : (nb < 8 ? kb : -1)) >= 0; }
    __device__ __forceinline__ void post(int lane, f32x4 (&w)[4]) { if ((nb & 3) == 0) T = moe_tile(p, 0, nb < 4 ? ka : kb, 1);
        const float* src = T.W + (size_t)(T.k0 + 4 * (lane >> 2)) * T.ldw + T.n0 + 16 * (nb & 3) + 4 * (lane & 3);
#pragma unroll
        for (int i = 0; i < 4; ++i) w[i] = *(const GAS f32x4*)(src + (size_t)i * T.ldw);
        ++nb; live = true; }
    __device__ __forceinline__ void end(int lane, f32x4 (&w)[4]) { if (live) store(lane, w); }
};
__device__ __forceinline__ void decode_unit(int r, int& S, int& tok0, int& h, int& within) {
    if (r < 1024) { const int bh = r >> 4; within = r & 15; S = 4096; tok0 = (bh >> 3) * 4096; h = bh & 7; }
    else { const int r2 = r - 1024, bh = r2 >> 5; within = r2 & 31; S = 8192; tok0 = GTOK + (bh >> 3) * 8192; h = bh & 7; }
}
__device__ __forceinline__ int clampi(int v, int lo, int hi) { return v < lo ? lo : (v > hi ? hi : v); }
using att::bf16x8; using att::f32x16;
__device__ __forceinline__ void rope8(bf16x8& a, bf16x8& b, const float2* cs) {
#pragma unroll
    for (int j = 0; j < 8; ++j) { const float x1 = att::bf2f(a[j]), x2 = att::bf2f(b[j]); const float2 c = cs[j];
        a[j] = (short)f2bf(x1 * c.x - x2 * c.y); b[j] = (short)f2bf(x1 * c.y + x2 * c.x); }
}

struct PolNA {
    static constexpr int NLSE = 0; static constexpr int ND0 = 4; static constexpr bool FUSED = false; static constexpr float SC = 1.0f;
    __device__ __forceinline__ void mask(f32x16&, f32x16&, int, int, int, int) const {}
    const att::bf16* proj; att::bf16* out; const LAS float* tab; int tok0, h, R4, rows, kr_lo, nt;
    __device__ __forceinline__ void init(int r, const unsigned char* ws, const LAS float* tab_all) {
        int S, within; decode_unit(r, S, tok0, h, within); R4 = within; rows = S >> 6;
        kr_lo = clampi(4 * R4 - 4, 0, rows - 8); nt = clampi(4 * R4 - 1, 0, rows - 8) + 8 - kr_lo;
        proj = (const att::bf16*)(ws + WS_PROJ); out = (att::bf16*)(ws + WS_ATT); tab = tab_all + h * 465; }
    __device__ __forceinline__ int ntiles() const { return nt; }
    __device__ __forceinline__ const att::bf16* q_ptr(int wid, int r32) const { return proj + (size_t)(tok0 + (4 * R4 + (wid >> 1)) * 64 + (wid & 1) * 32 + r32) * N_IN0 + h * 64; }
    __device__ __forceinline__ void q_fix(bf16x8 (&)[ND0], int, int, int) const {}
    __device__ __forceinline__ const void* k_src(int t, int wid, int lane) const { return proj + (size_t)(tok0 + (kr_lo + t) * 64 + lane) * N_IN0 + 512 + h * 64 + wid * 8; }
    __device__ __forceinline__ const void* k2_src(int, int, int) const { return nullptr; }
    __device__ __forceinline__ const void* v_src(int t, int wid, int lane) const { return proj + (size_t)(tok0 + (kr_lo + t) * 64 + 16 * (wid & 3) + (lane >> 2)) * N_IN0 + 1024 + h * 64 + (wid >> 2) * 32 + (lane & 3) * 8; }
    __device__ __forceinline__ bool needs(int t, int wid) const { const int r = 4 * R4 + (wid >> 1), r0 = clampi(r - 4, 0, rows - 8), kr = kr_lo + t; return kr >= r0 && kr < r0 + 8; }
    __device__ __forceinline__ bool variant(int wid) const { return (wid & 1) != 0; }
    static constexpr __device__ bool dead(int var, int half, int i) { return var == 0 ? (half == 1 && i >= 4) : (half == 0 && i < 12); }
    static constexpr __device__ int live4(int var) { return var == 0 ? 0 : 12; }
    static constexpr __device__ int kslo(int var) { return var == 0 ? 0 : 1; }
    static constexpr __device__ int kshi(int var) { return var == 0 ? 3 : 4; }
    template <int VAR> __device__ __forceinline__ void transform_v(f32x16& p0, f32x16& p1, int t, int wid, int r32, int hi) const {
        const int r = 4 * R4 + (wid >> 1), qc = (wid & 1) * 32 + r32, c0 = clampi(qc - 8, 0, 48);
        const LAS float* trow = tab + (kr_lo + t - r + 7) * 31 + (15 - qc);
        const LAS float* th = trow + 4 * hi; const unsigned u0 = (unsigned)(4 * hi - c0);
#pragma unroll
        for (int i = 0; i < 16; ++i) { const int kq = (i & 3) + 8 * (i >> 2);
            if (!dead(VAR, 0, i)) { const float b_ = th[kq]; const float f_ = __builtin_fmaf(p0[i], 0.125f * att::LOG2E, b_); p0[i] = (u0 + (unsigned)kq < 16u) ? f_ : -INFINITY; }
            if (!dead(VAR, 1, i)) { const float b_ = th[kq + 32]; const float f_ = __builtin_fmaf(p1[i], 0.125f * att::LOG2E, b_); p1[i] = (u0 + (unsigned)(kq + 32) < 16u) ? f_ : -INFINITY; } }
    }
    __device__ __forceinline__ att::bf16* o_ptr(int wid, int row) const { return out + (size_t)(tok0 + (4 * R4 + (wid >> 1)) * 64 + (wid & 1) * 32 + row) * DM + h * 64; }
    __device__ __forceinline__ void lse_out(int, int, float) const {}
};
struct PolMLA {
    static constexpr int NLSE = 0; static constexpr int ND0 = 6; static constexpr bool FUSED = true; static constexpr float SC = 0.10206207261596577f * att::LOG2E;
    __device__ __forceinline__ void mask(f32x16&, f32x16&, int, int, int, int) const {}
    const att::bf16* qkv2; const att::bf16* kpe; att::bf16* out; const float2* rope; int tok0, h, qt, S;
    __device__ __forceinline__ void init(int r, const unsigned char* ws) { int within; decode_unit(r, S, tok0, h, within); qt = within;
        qkv2 = (const att::bf16*)(ws + WS_QKV2); kpe = (const att::bf16*)(ws + WS_KPE); out = (att::bf16*)(ws + WS_ATT); rope = (const float2*)(ws + WS_ROPE_R); }
    __device__ __forceinline__ int ntiles() const { return S >> 6; }
    __device__ __forceinline__ const att::bf16* q_ptr(int wid, int r32) const { return qkv2 + (size_t)(tok0 + qt * 256 + wid * 32 + r32) * N_UP + h * 96; }
    __device__ __forceinline__ void q_fix(bf16x8 (&qr)[ND0], int wid, int r32, int hi) const { rope8(qr[4], qr[5], rope + (size_t)(qt * 256 + wid * 32 + r32) * 16 + 8 * hi); }
    __device__ __forceinline__ const void* k_src(int t, int wid, int lane) const { return qkv2 + (size_t)(tok0 + t * 64 + lane) * N_UP + 768 + h * 128 + wid * 8; }
    static constexpr int KSTRIDE = 64 * N_UP * 2, K2STRIDE = 64 * 32 * 2;
    __device__ __forceinline__ const unsigned char* k_base() const { return (const unsigned char*)(qkv2 + (size_t)tok0 * N_UP + 768 + h * 128); }
    __device__ __forceinline__ const unsigned char* k2_base() const { return (const unsigned char*)(kpe + (size_t)tok0 * 32); }
    static __device__ __forceinline__ unsigned k_lofs(int wid, int lane) { return (unsigned)(lane * N_UP + wid * 8) * 2u; }
    static __device__ __forceinline__ unsigned k2_lofs(int wid, int lane) { return (unsigned)(lane * 32 + wid * 8) * 2u; }
    static __device__ __forceinline__ unsigned v_lofs(int wid, int lane) { return (unsigned)((16 * (wid & 3) + (lane >> 2)) * N_UP + 64 + (wid >> 2) * 32 + (lane & 3) * 8) * 2u; }
    __device__ __forceinline__ const void* k2_src(int t, int wid, int lane) const { return kpe + (size_t)(tok0 + t * 64 + lane) * 32 + wid * 8; }
    __device__ __forceinline__ const void* v_src(int t, int wid, int lane) const { return qkv2 + (size_t)(tok0 + t * 64 + 16 * (wid & 3) + (lane >> 2)) * N_UP + 768 + h * 128 + 64 + (wid >> 2) * 32 + (lane & 3) * 8; }
    __device__ __forceinline__ bool needs(int, int) const { return true; }
    __device__ __forceinline__ void transform(f32x16&, f32x16&, int, int, int, int) const {}
    __device__ __forceinline__ att::bf16* o_ptr(int wid, int row) const { return out + (size_t)(tok0 + qt * 256 + wid * 32 + row) * DM + 512 + h * 64; }
    __device__ __forceinline__ void lse_out(int, int, float) const {}
};
struct PolDil {
    static constexpr int NLSE = 1;   static constexpr int ND0 = 4; static constexpr bool FUSED = true; static constexpr float SC = 0.125f * att::LOG2E;
    const att::bf16* qkv; att::bf16* og; float* lse; const float2* rope; int gi, d, tok0, h, rho, blk, ks, t_lo, nt, rbase;
    __device__ __forceinline__ void init(int r, int gi_, const unsigned char* ws) { int S, within; decode_unit(r, S, tok0, h, within); gi = gi_; d = 1 << (2 * gi);
        const int Ssub = S / d, nblk = Ssub >> 8; rho = within / nblk; blk = within % nblk; ks = 256 * blk - 64; t_lo = ks < 0 ? 1 : 0; rbase = tok0 + rho * Ssub;
        int t_hi = (Ssub - ks) >> 6; if (t_hi > 6) t_hi = 6; nt = t_hi - t_lo;
        qkv = (const att::bf16*)(ws + WS_QKV); og = (att::bf16*)(ws + WS_OG) + (size_t)gi * NTOK * 512; lse = (float*)(ws + WS_LSE) + (size_t)gi * NTOK * 8; rope = (const float2*)(ws + WS_ROPE_H); }
    __device__ __forceinline__ int ntiles() const { return nt; }
    __device__ __forceinline__ int qtok(int wid, int row) const { return tok0 + (256 * blk + 32 * wid + row) * d + rho; }
    __device__ __forceinline__ const att::bf16* q_ptr(int wid, int r32) const { return qkv + (size_t)(rbase + 256 * blk + 32 * wid + r32) * N_DIL + gi * 1536 + h * 64; }
    __device__ __forceinline__ void q_fix(bf16x8 (&)[ND0], int, int, int) const {}
    __device__ __forceinline__ const void* k_src(int t, int wid, int lane) const { return qkv + (size_t)(rbase + ks + 64 * (t + t_lo) + lane) * N_DIL + gi * 1536 + 512 + h * 64 + wid * 8; }
    __device__ __forceinline__ const void* k2_src(int, int, int) const { return nullptr; }
    __device__ __forceinline__ const void* v_src(int t, int wid, int lane) const { return qkv + (size_t)(rbase + ks + 64 * (t + t_lo) + 16 * (wid & 3) + (lane >> 2)) * N_DIL + gi * 1536 + 1024 + h * 64 + (wid >> 2) * 32 + (lane & 3) * 8; }
    __device__ __forceinline__ bool needs(int t, int wid) const { const int kt0 = ks + 64 * (t + t_lo), q0 = 256 * blk + 32 * wid; return kt0 + 63 >= q0 - 64 && kt0 <= q0 + 95; }
    __device__ __forceinline__ void transform(f32x16&, f32x16&, int, int, int, int) const {}
    __device__ __forceinline__ void mask(f32x16& p0, f32x16& p1, int t, int wid, int r32, int hi) const {
        const int rel0 = ks + 64 * (t + t_lo) - (256 * blk + 32 * wid);
        if (rel0 == 0 || rel0 == -32) return;
        const unsigned base = (unsigned)(rel0 - r32 + 64 + 4 * hi);
#pragma unroll
        for (int i = 0; i < 16; ++i) { const unsigned c = (unsigned)((i & 3) + 8 * (i >> 2));
            p0[i] = (base + c <= 128u) ? p0[i] : -INFINITY; p1[i] = (base + c + 32u <= 128u) ? p1[i] : -INFINITY; }
    }
    __device__ __forceinline__ att::bf16* o_ptr(int wid, int row) const { return og + (size_t)qtok(wid, row) * 512 + h * 64; }
    __device__ __forceinline__ void lse_out(int wid, int r32, float v) const { lse[(size_t)qtok(wid, r32) * 8 + h] = v; }
};


constexpr int DS_SLOT = 32768, DS_KB = 16384, DS_OST = 3 * DS_SLOT;
static_assert(DS_OST + 8 * 4096 <= RING_BYTES, "dilated attention LDS");
__device__ __forceinline__ void dil_unit_init(PolDil& P_, int n, int NU, int vcu, int G, const unsigned char* ws) {
    const bool ok = n >= 0 && n < NU; const int u = ok ? vcu + n * G : vcu;
    P_.init(u & 2047, u >> 11, ws); if (!ok) P_.nt = 0;
}
__device__ __forceinline__ void dil_skew(int wv, PP p, LAS unsigned char* shm, int vcu, int G) {
    using namespace att;
    const unsigned char* ws = p->ws;
    const int tid = opaque_tid(wv), lane = tid & 63, r32 = lane & 31, hi = lane >> 5; const int wid = __builtin_amdgcn_readfirstlane(tid >> 6);
    const int j = wid >> 1;
    const unsigned lds0 = (unsigned)(uintptr_t)shm;
    LAS float* wsf = (LAS float*)(shm + DS_OST + wid * 4096);
    int NU = 0; for (int u = vcu; u < 3 * 2048; u += G) ++NU;
    PolDil pPrev, pCur, pNext; dil_unit_init(pPrev, -1, NU, vcu, G, ws); dil_unit_init(pCur, 0, NU, vcu, G, ws); dil_unit_init(pNext, 1, NU, vcu, G, ws);
#define DS_DMA(PL, i, sl) do { int t_ = (i) - (PL).t_lo; const int tm_ = (PL).nt > 0 ? (PL).nt - 1 : 0; t_ = t_ < 0 ? 0 : (t_ > tm_ ? tm_ : t_); \
      const unsigned b_ = (unsigned)__builtin_amdgcn_readfirstlane(lds0 + (sl) * DS_SLOT + ((i) >= 3 ? DS_KB : 0) + wid * 1024); \
      glds16((PL).k_src(t_, wid, lane), b_); glds16((PL).v_src(t_, wid, lane), b_ + 8192u); } while (0)
    bf16x8 qr[4], qn[4];
    { const bf16* qp = pCur.q_ptr(wid, r32);
#pragma unroll
      for (int d0 = 0; d0 < 4; ++d0) qr[d0] = *reinterpret_cast<const bf16x8*>(qp + d0 * 16 + hi * 8); }
#pragma unroll
    for (int d0 = 0; d0 < 4; ++d0) qn[d0] = qr[d0];
    DS_DMA(pCur, 0, 0); DS_DMA(pPrev, 3, 0); DS_DMA(pCur, 1, 1); DS_DMA(pPrev, 4, 1);
    float m = -1e30f, lsum = 0.f; f32x16 o[2]; o[0] = f32x16{}; o[1] = f32x16{};
    const int vlane = ((lane >> 4) & 1) * 32 + (lane & 3) * 8 + (4 * hi + ((lane & 15) >> 2)) * 64;
    ATT_WAIT_BAR(4);
    int s_cur = 0, x_prev = 0;
#define DS_STEP(r) do { \
    { const int sl2 = s_cur >= 1 ? s_cur - 1 : 2; \
      if ((r) == 0) { DS_DMA(pCur, 2, sl2); DS_DMA(pPrev, 5, sl2); } else if ((r) == 1) { DS_DMA(pNext, 0, sl2); DS_DMA(pCur, 3, sl2); } else { DS_DMA(pNext, 1, sl2); DS_DMA(pCur, 4, sl2); } } \
    const bool inA = j <= (r); const PolDil own = inA ? pCur : pPrev; const int i = inA ? (r) : 3 + (r); const int k = i - j; int x_cur = 0; \
    const bool live = own.nt > 0; \
    if (live && k == 0) { m = -1e30f; lsum = 0.f; o[0] = f32x16{}; o[1] = f32x16{}; \
      const PolDil suc = inA ? pNext : pCur; \
      if (suc.nt > 0) { const bf16* qp = suc.q_ptr(wid, r32); \
        _Pragma("unroll") for (int d0 = 0; d0 < 4; ++d0) qn[d0] = *reinterpret_cast<const bf16x8*>(qp + d0 * 16 + hi * 8); \
        x_cur = 4; } } \
    if (live && i >= own.t_lo && i < own.t_lo + own.nt) { \
      const LAS unsigned char* kt = shm + s_cur * DS_SLOT + (inA ? 0 : DS_KB); \
      f32x16 p0 = f32x16{}, p1 = f32x16{}; \
      qkt<4>(p0, p1, kt, qr, r32, hi); \
      { const int rel0 = own.ks + 64 * i - (256 * own.blk + 32 * wid);        \
        if (!(rel0 == 0 || rel0 == -32)) { const unsigned base = (unsigned)(rel0 - r32 + 64 + 4 * hi); \
          _Pragma("unroll") for (int ii = 0; ii < 16; ++ii) { const unsigned c = (unsigned)((ii & 3) + 8 * (ii >> 2)); \
            p0[ii] = (base + c <= 128u) ? p0[ii] : -INFINITY; p1[ii] = (base + c + 32u <= 128u) ? p1[ii] : -INFINITY; } } } \
      const float rm = rowmax(p0, p1) * PolDil::SC; \
      const bool grow = rm > m + THR; \
      if (__any(grow)) { const float mn = grow ? rm : m; const float f = __builtin_amdgcn_exp2f(m - mn); m = mn; lsum *= f; \
        if (hi == 0) wsf[r32] = f; \
        asm volatile("s_waitcnt lgkmcnt(0)" ::: "memory"); \
        _Pragma("unroll") for (int rr = 0; rr < 16; ++rr) { const float ff = wsf[crow(rr, hi)]; o[0][rr] *= ff; o[1][rr] *= ff; } } \
      float sacc = 0.f; \
      _Pragma("unroll") for (int rr = 0; rr < 16; ++rr) { p0[rr] = __builtin_amdgcn_exp2f(__builtin_fmaf(p0[rr], PolDil::SC, -m)); p1[rr] = __builtin_amdgcn_exp2f(__builtin_fmaf(p1[rr], PolDil::SC, -m)); sacc += p0[rr]; sacc += p1[rr]; } \
      lsum += sacc; \
      u32x4 pw0, pw1, pw2, pw3; \
      pw0 = (u32x4){cvtpk_s(p0[0], p0[1]), cvtpk_s(p0[2], p0[3]), cvtpk_s(p0[4], p0[5]), cvtpk_s(p0[6], p0[7])}; \
      pw1 = (u32x4){cvtpk_s(p0[8], p0[9]), cvtpk_s(p0[10], p0[11]), cvtpk_s(p0[12], p0[13]), cvtpk_s(p0[14], p0[15])}; \
      pw2 = (u32x4){cvtpk_s(p1[0], p1[1]), cvtpk_s(p1[2], p1[3]), cvtpk_s(p1[4], p1[5]), cvtpk_s(p1[6], p1[7])}; \
      pw3 = (u32x4){cvtpk_s(p1[8], p1[9]), cvtpk_s(p1[10], p1[11]), cvtpk_s(p1[12], p1[13]), cvtpk_s(p1[14], p1[15])}; \
      ATT_SBAR(); \
      pv(o, (int)lds0 + s_cur * DS_SLOT + (inA ? 0 : DS_KB) + 8192 + vlane, __builtin_bit_cast(bf16x8, pw0), __builtin_bit_cast(bf16x8, pw1), __builtin_bit_cast(bf16x8, pw2), __builtin_bit_cast(bf16x8, pw3)); } \
    if (live && k == 2) {                                             \
      float ls = lsum; { auto rr = __builtin_amdgcn_permlane32_swap(__float_as_uint(ls), __float_as_uint(ls), false, false); ls = __uint_as_float(rr[0]) + __uint_as_float(rr[1]); } \
      if (hi == 0) { wsf[32 + r32] = ls; own.lse_out(wid, r32, (m + __builtin_amdgcn_logf(ls)) * LN2); } \
      asm volatile("s_waitcnt lgkmcnt(0)" ::: "memory"); \
      float rli[16]; \
      _Pragma("unroll") for (int rr = 0; rr < 16; ++rr) rli[rr] = __builtin_amdgcn_rcpf(wsf[32 + crow(rr, hi)]); \
      asm volatile("s_waitcnt lgkmcnt(0)" ::: "memory"); \
      LAS bf16* stg = (LAS bf16*)(shm + DS_OST) + wid * 2048; \
      _Pragma("unroll") for (int rr = 0; rr < 16; ++rr) { const int orow = crow(rr, hi); \
        _Pragma("unroll") for (int d0 = 0; d0 < 2; ++d0) stg[orow * 64 + d0 * 32 + r32] = (bf16)(cvtpk_s(o[d0][rr] * rli[rr], 0.f) & 0xffffu); } \
      asm volatile("s_waitcnt lgkmcnt(0)" ::: "memory"); \
      _Pragma("unroll") for (int q4 = 0; q4 < 4; ++q4) { const int row = q4 * 8 + (lane >> 3), ch = lane & 7; const u32x4 v = *(const LAS u32x4*)(stg + row * 64 + ch * 8); *(u32x4*)(own.o_ptr(wid, row) + ch * 8) = v; } \
      x_cur = 5; \
      asm volatile("" : "+v"(qn[0]), "+v"(qn[1]), "+v"(qn[2]), "+v"(qn[3]));        \
      _Pragma("unroll") for (int d0 = 0; d0 < 4; ++d0) qr[d0] = qn[d0]; } \
    { const int xs = x_prev + x_cur;                                  \
      if (xs == 4) ATT_WAIT_BAR(8); else if (xs == 5) ATT_WAIT_BAR(9); else if (xs == 9) ATT_WAIT_BAR(13); else ATT_WAIT_BAR(4); }        \
    x_prev = x_cur; s_cur = (s_cur == 2) ? 0 : s_cur + 1; \
    } while (0)
#pragma unroll 1
    for (int a = 0; a <= NU; ++a) {
        DS_STEP(0); DS_STEP(1); DS_STEP(2);
        pPrev = pCur; pCur = pNext; dil_unit_init(pNext, a + 2, NU, vcu, G, ws);
    }
    ATT_WAIT_BAR(0);
#undef DS_STEP
#undef DS_DMA
}

__device__ __forceinline__ void pc_post_mixer(PP p, int layer, LAS unsigned char* lds, int vcu, int G, int tid, int lane, int wave) {
    constexpr int PST = 1028;
    LAS float* vec = (LAS float*)lds; LAS float* panel = (LAS float*)(lds + 20480); LAS float* part = panel + 16 * PST;
    static_assert(20480 + 16 * PST * 4 + 8 * 16 * 16 * 4 <= 131072, "post-mixer LDS map");
    const float* wrg = p->in[21] + (size_t)layer * DM * NEXP;
    float wreg[8][4];
#pragma unroll
    for (int s_ = 0; s_ < 8; ++s_)
#pragma unroll
        for (int jj = 0; jj < 4; ++jj) wreg[s_][jj] = wrg[(size_t)(128 * wave + 16 * s_ + 4 * (lane >> 4) + jj) * NEXP + (lane & 15)];
    __syncthreads();
    for (int i = tid; i < DM; i += NTHREADS) { vec[3 * DM + i] = p->in[15][layer * DM + i]; vec[4 * DM + i] = p->in[16][layer * DM + i]; }
    const bf16* mix = (const bf16*)(p->ws + WS_MIX);
    for (int ch = vcu; ch < NTOK / 256; ch += G) {
        const int t0 = ch * 256, b = tok_bidx(t0), tw = t0 + wave * 32;
        __syncthreads();
        load_mod_vec<true>(p, vec, 2 * layer, b, 2, tid); load_mod_vec<true>(p, vec + DM, 2 * layer + 1, b, 0, tid); load_mod_vec<true>(p, vec + 2 * DM, 2 * layer + 1, b, 1, tid);
        __syncthreads();
#define PC_LOAD(X, M, r_) do { const int t_ = tw + (r_); const GAS f32x4* xr_ = (const GAS f32x4*)(layer == 0 ? x_in_row(p, t_) : p->out + (size_t)t_ * DM) + lane; const GAS v2u* mr_ = (const GAS v2u*)(mix + (size_t)t_ * DM) + lane; \
            _Pragma("unroll") for (int j_ = 0; j_ < 4; ++j_) { X[j_] = xr_[64 * j_]; M[j_] = mr_[64 * j_]; } } while (0)
#define PC_PART1(X, M, r_, slot_) do { const int t = tw + (r_); \
            LAS float* vec_ = vec; asm volatile("" : "+v"(vec_));     \
            f32x4 v[4]; float s = 0.f; \
            _Pragma("unroll") for (int j = 0; j < 4; ++j) { const f32x4 x = X[j]; const v2u m2 = M[j]; const f32x4 gt = *(const LAS f32x4*)(vec_ + 4 * lane + 256 * j); \
                const f32x4 o = {bflo(m2.x), bfhi(m2.x), bflo(m2.y), bfhi(m2.y)}; v[j] = x * DN_ALPHA + gt * o; s += (v[j].x + v[j].y) + (v[j].z + v[j].w); } \
            if ((r_) + 2 < 32) PC_LOAD(X, M, (r_) + 2); \
            const float mean = wave_sum(s) * (1.f / DM); float s2 = 0.f; \
            _Pragma("unroll") for (int j = 0; j < 4; ++j) { v[j] = v[j] - mean; s2 += (v[j].x * v[j].x + v[j].y * v[j].y) + (v[j].z * v[j].z + v[j].w * v[j].w); } \
            const float rstd = 1.f / sqrtf(wave_sum(s2) * (1.f / DM) + LN_EPS); \
            GAS f32x4* orow = (GAS f32x4*)(p->out + (size_t)t * DM) + lane; \
            _Pragma("unroll") for (int j = 0; j < 4; ++j) { const int c = 4 * lane + 256 * j; \
                const f32x4 g = *(const LAS f32x4*)(vec_ + 3 * DM + c), bb = *(const LAS f32x4*)(vec_ + 4 * DM + c), sh = *(const LAS f32x4*)(vec_ + DM + c), sc = *(const LAS f32x4*)(vec_ + 2 * DM + c); \
                const f32x4 x1 = v[j] * rstd * g + bb; orow[64 * j] = x1; const f32x4 hh = x1 * (1.0f + sc) + sh; v[j] = hh; \
                *(LAS f32x4*)(panel + (slot_) * PST + c) = hh; } \
            { GAS unsigned* o4 = (GAS unsigned*)(p->ws + WS_H + (size_t)t * DM) + lane;        \
                _Pragma("unroll") for (int j = 0; j < 4; ++j) o4[64 * j] = pg8::pk4_fp8(v[j].x, v[j].y, v[j].z, v[j].w); } \
            } while (0)
#define PC_PART2(r_, slot_) do { const int t = tw + (r_); const int e_ = lane & 15, pg_ = lane >> 4; \
            float lg = part[((pg_) * 16 + (slot_)) * 16 + e_] + part[((pg_ + 4) * 16 + (slot_)) * 16 + e_]; \
            { auto rr = __builtin_amdgcn_permlane16_swap(__float_as_uint(lg), __float_as_uint(lg), false, false); lg = __uint_as_float(rr[0]) + __uint_as_float(rr[1]); } \
            { auto rr = __builtin_amdgcn_permlane32_swap(__float_as_uint(lg), __float_as_uint(lg), false, false); lg = __uint_as_float(rr[0]) + __uint_as_float(rr[1]); } \
            float mx = lg; mx = fmaxf(mx, dpp_f<0xB1>(mx)); mx = fmaxf(mx, dpp_f<0x4E>(mx)); mx = fmaxf(mx, dpp_f<0x141>(mx)); mx = fmaxf(mx, dpp_f<0x140>(mx)); \
            const float ex = __expf(lg - mx); float den = ex; den += dpp_f<0xB1>(den); den += dpp_f<0x4E>(den); den += dpp_f<0x141>(den); den += dpp_f<0x140>(den); \
            float af_ = ex / den; af_ = (af_ >= 0.f && af_ <= 1.f) ? af_ : 0.f;        \
            if (lane < NEXP) ((float*)(p->ws + WS_AFF))[((size_t)(t >> 15) * NEXP + lane) * GTOK + (t & (GTOK - 1))] = af_; } while (0)
        f32x4 xa[4], xb[4]; v2u ma[4], mb[4];
        PC_LOAD(xa, ma, 0); PC_LOAD(xb, mb, 1);
        _Pragma("unroll 1") for (int i = 0; i < 32; i += 2) {
            PC_PART1(xa, ma, i, 2 * wave); PC_PART1(xb, mb, i + 1, 2 * wave + 1);
            asm volatile("s_waitcnt lgkmcnt(0)\n\ts_barrier" ::: "memory");
            { pg8::f32x4 D = {0.f, 0.f, 0.f, 0.f}; const LAS float* brow = panel + (lane & 15) * PST + 128 * wave + 4 * (lane >> 4);
#pragma unroll
              for (int s_ = 0; s_ < 8; ++s_) { const f32x4 hv = *(const LAS f32x4*)(brow + 16 * s_);
                  D = __builtin_amdgcn_mfma_f32_16x16x4f32(wreg[s_][0], hv.x, D, 0, 0, 0); D = __builtin_amdgcn_mfma_f32_16x16x4f32(wreg[s_][1], hv.y, D, 0, 0, 0);
                  D = __builtin_amdgcn_mfma_f32_16x16x4f32(wreg[s_][2], hv.z, D, 0, 0, 0); D = __builtin_amdgcn_mfma_f32_16x16x4f32(wreg[s_][3], hv.w, D, 0, 0, 0); }
              *(LAS f32x4*)(part + ((wave * 16 + (lane & 15)) * 16 + 4 * (lane >> 4))) = (f32x4){D[0], D[1], D[2], D[3]}; }
            asm volatile("s_waitcnt lgkmcnt(0)\n\ts_barrier" ::: "memory");
            PC_PART2(i, 2 * wave); PC_PART2(i + 1, 2 * wave + 1);
        }
#undef PC_LOAD
#undef PC_PART1
#undef PC_PART2
    }
}

__device__ __forceinline__ void topk_phase(PP p, LAS unsigned char* lds, int tid, int lane, int wave) {
    LAS int* red = (LAS int*)lds;
    for (int prob = blockIdx.x; prob < 2 * NEXP; prob += gridDim.x) {
        const float* a = (const float*)(p->ws + WS_AFF) + (size_t)prob * GTOK + tid * 64;
        unsigned v[64];
#pragma unroll
        for (int i = 0; i < 16; ++i) { const v4u x = ((const GAS v4u*)a)[i]; v[4 * i] = x.x; v[4 * i + 1] = x.y; v[4 * i + 2] = x.z; v[4 * i + 3] = x.w; }
        unsigned prefix = 0u;
        __syncthreads();
#pragma unroll 1
        for (int bit = 30; bit >= 0; --bit) {
            const unsigned cand = prefix | (1u << bit); int c = 0;
#pragma unroll
            for (int i = 0; i < 64; ++i) c += (int)((cand - 1u - v[i]) >> 31);
            c = wave_sum_i(c);
            if (lane == 0) red[(bit & 1) * 8 + wave] = c;
            __syncthreads();
            int tot = 0;
#pragma unroll
            for (int w = 0; w < 8; ++w) tot += red[(bit & 1) * 8 + w];
            if (tot >= CAP) prefix = cand;
        }
        const unsigned T = prefix;
        unsigned cg = 0u, ce = 0u;
#pragma unroll
        for (int i = 0; i < 64; ++i) { cg += (v[i] > T) ? 1u : 0u; ce += (v[i] == T) ? 1u : 0u; if ((i & 7) == 7) __builtin_amdgcn_sched_barrier(0); }
        const unsigned pack = cg | (ce << 16); unsigned x = pack;
#pragma unroll
        for (int o = 1; o < 64; o <<= 1) { const unsigned y = (unsigned)__builtin_amdgcn_ds_bpermute(((lane - o) & 63) << 2, (int)x); if (lane >= o) x += y; }
        if (lane == 63) red[32 + wave] = (int)x;
        __syncthreads();
        unsigned off = 0u, tot = 0u;
#pragma unroll
        for (int w = 0; w < 8; ++w) { const unsigned tw = (unsigned)red[32 + w]; tot += tw; off += (w < wave) ? tw : 0u; }
        const unsigned excl = x - pack + off;
        unsigned gt_before = excl & 0xffffu, eq_before = excl >> 16; const unsigned need_eq = (unsigned)CAP - (tot & 0xffffu);
        int* idx = (int*)(p->ws + WS_IDX) + (size_t)prob * CAP; float* gv = (float*)(p->ws + WS_GATEV) + (size_t)prob * CAP;
        int so[64];
#pragma unroll
        for (int i = 0; i < 64; ++i) {
            const bool isg = v[i] > T, ise = v[i] == T; const bool sel = isg || (ise && eq_before < need_eq);
            const unsigned slot = gt_before + (eq_before < need_eq ? eq_before : need_eq);
            if (sel) { idx[slot] = (prob >> 4) * GTOK + tid * 64 + i; gv[slot] = __uint_as_float(v[i]); }
            so[i] = sel ? (int)slot : -1; gt_before += isg ? 1u : 0u; eq_before += ise ? 1u : 0u; if ((i & 7) == 7) __builtin_amdgcn_sched_barrier(0); }
        GAS v4u* sp = (GAS v4u*)((int*)(p->ws + WS_SLOTOF) + (size_t)prob * GTOK + tid * 64);
#pragma unroll
        for (int i = 0; i < 16; ++i) { v4u w; w.x = (unsigned)so[4 * i]; w.y = (unsigned)so[4 * i + 1]; w.z = (unsigned)so[4 * i + 2]; w.w = (unsigned)so[4 * i + 3]; sp[i] = w; }
        __syncthreads();
    }
}

__device__ __forceinline__ f32x4 pd_fp8x4(unsigned w) { const auto lo = __builtin_amdgcn_cvt_pk_f32_fp8((int)w, false), hi = __builtin_amdgcn_cvt_pk_f32_fp8((int)w, true); return (f32x4){lo[0], lo[1], hi[0], hi[1]}; }
__device__ __forceinline__ void pd_post_moe(PP p, int layer, LAS unsigned char* lds, int vcu, int G, int tid, int lane, int wave) {
    LAS float* vec = (LAS float*)lds;
    LAS int* st_slot = (LAS int*)(lds + 32768) + wave * 1024;
    LAS float* st_gate = (LAS float*)(st_slot + 512);
    __syncthreads();
    for (int i = tid; i < DM; i += NTHREADS) { vec[DM + i] = p->in[19][layer * DM + i]; vec[2 * DM + i] = p->in[20][layer * DM + i]; }
    const unsigned char* ye = p->ws + WS_YE;
    for (int ch = vcu; ch < NTOK / 256; ch += G) {
        const int t0 = ch * 256, b = tok_bidx(t0), g = t0 >> 15, tw = t0 + wave * 32;
        __syncthreads();
        load_mod_vec<true>(p, vec, 2 * layer + 1, b, 2, tid);
        if (layer == 0) { load_mod_vec<true>(p, vec + 3 * DM, 2, b, 0, tid); load_mod_vec<true>(p, vec + 4 * DM, 2, b, 1, tid); }
        { const int sub = lane >> 4, e = lane & 15;
          const int* so = (const int*)(p->ws + WS_SLOTOF) + ((size_t)g * NEXP + e) * GTOK + (tw & (GTOK - 1)); const float* gvp = (const float*)(p->ws + WS_GATEV) + ((size_t)g * NEXP + e) * CAP;
          int s8[8]; float g8[8];
#pragma unroll
          for (int j = 0; j < 8; ++j) s8[j] = so[4 * j + sub];
#pragma unroll
          for (int j = 0; j < 8; ++j) g8[j] = gvp[s8[j] < 0 ? 0 : s8[j]];
#pragma unroll
          for (int j = 0; j < 8; ++j) { const float gg = s8[j] >= 0 ? g8[j] * (1.0f / YE_QS) : 0.f; st_slot[(4 * j + sub) * 16 + e] = s8[j]; st_gate[(4 * j + sub) * 16 + e] = gg; } }
        __syncthreads();
        const unsigned char* yeg = ye + (size_t)g * NEXP * CAP * DM;
#define PD_STAGE(S_, i_) do { const int t_ = tw + (i_); int sl_ = -1; float gv_ = 0.f; if (lane < NEXP) { sl_ = st_slot[(i_) * 16 + lane]; gv_ = st_gate[(i_) * 16 + lane]; } \
            unsigned mk_ = (unsigned)__ballot(sl_ >= 0); \
            _Pragma("unroll") for (int k_ = 0; k_ < 4; ++k_) { const unsigned char* rp_ = yeg; float g_ = 0.f; \
                if (mk_) { const int e_ = __builtin_ctz(mk_); mk_ &= mk_ - 1u; const int s_ = __builtin_amdgcn_readlane(sl_, e_); g_ = __int_as_float(__builtin_amdgcn_readlane(__float_as_int(gv_), e_)); rp_ = yeg + ((size_t)e_ * CAP + s_) * DM; } \
                g##S_[k_] = g_; const GAS unsigned* yr_ = (const GAS unsigned*)rp_ + lane; _Pragma("unroll") for (int j_ = 0; j_ < 4; ++j_) y##S_[k_][j_] = yr_[64 * j_]; } \
            slot##S_ = sl_; gval##S_ = gv_; rest##S_ = mk_; \
            const GAS f32x4* xr_ = (const GAS f32x4*)(p->out + (size_t)t_ * DM) + lane; _Pragma("unroll") for (int j_ = 0; j_ < 4; ++j_) x##S_[j_] = xr_[64 * j_]; } while (0)
#define PD_ROW(S_, i_) do { const int t = tw + (i_); \
            LAS float* vec_ = vec; asm volatile("" : "+v"(vec_)); \
            f32x4 y[4]; \
            _Pragma("unroll") for (int j = 0; j < 4; ++j) { y[j] = (f32x4){0.f, 0.f, 0.f, 0.f}; \
                _Pragma("unroll") for (int k = 0; k < 4; ++k) y[j] += pd_fp8x4(y##S_[k][j]) * g##S_[k]; } \
            { unsigned rest = rest##S_; while (rest) { const int e = __builtin_ctz(rest); rest &= rest - 1u;            \
                const int sl = __builtin_amdgcn_readlane(slot##S_, e); const float gv = __int_as_float(__builtin_amdgcn_readlane(__float_as_int(gval##S_), e)); \
                const GAS unsigned* yr = (const GAS unsigned*)(yeg + ((size_t)e * CAP + sl) * DM) + lane; \
                _Pragma("unroll") for (int j = 0; j < 4; ++j) y[j] += pd_fp8x4(yr[64 * j]) * gv; } } \
            GAS f32x4* xr = (GAS f32x4*)(p->out + (size_t)t * DM) + lane; \
            f32x4 v[4]; float s = 0.f; \
            _Pragma("unroll") for (int j = 0; j < 4; ++j) { const f32x4 gt = *(const LAS f32x4*)(vec_ + 4 * lane + 256 * j); v[j] = x##S_[j] * DN_ALPHA + gt * y[j]; s += (v[j].x + v[j].y) + (v[j].z + v[j].w); } \
            if ((i_) + 2 < 32) PD_STAGE(S_, (i_) + 2); \
            const float mean = wave_sum(s) * (1.f / DM); float s2 = 0.f; \
            _Pragma("unroll") for (int j = 0; j < 4; ++j) { v[j] = v[j] - mean; s2 += (v[j].x * v[j].x + v[j].y * v[j].y) + (v[j].z * v[j].z + v[j].w * v[j].w); } \
            const float rstd = 1.f / sqrtf(wave_sum(s2) * (1.f / DM) + LN_EPS); \
            _Pragma("unroll") for (int j = 0; j < 4; ++j) { const int c = 4 * lane + 256 * j; const f32x4 gg = *(const LAS f32x4*)(vec_ + DM + c), bb = *(const LAS f32x4*)(vec_ + 2 * DM + c); \
                const f32x4 x2 = v[j] * rstd * gg + bb; xr[64 * j] = x2; \
                if (layer == 0) { const f32x4 sh = *(const LAS f32x4*)(vec_ + 3 * DM + c), sc = *(const LAS f32x4*)(vec_ + 4 * DM + c); v[j] = x2 * (1.0f + sc) + sh; } } \
            if (layer == 0) store_row_bf16((bf16*)(p->ws + WS_H) + (size_t)t * DM, v, lane); } while (0)
        f32x4 xA[4], xB[4]; unsigned yA[4][4], yB[4][4]; float gA[4], gB[4]; int slotA = -1, slotB = -1; float gvalA = 0.f, gvalB = 0.f; unsigned restA = 0u, restB = 0u;
        PD_STAGE(A, 0); PD_STAGE(B, 1);
        _Pragma("unroll 1") for (int i = 0; i < 32; i += 2) { PD_ROW(A, i); PD_ROW(B, i + 1); }
#undef PD_STAGE
#undef PD_ROW
    }
}

__device__ __forceinline__ void merge_phase(PP p, int vcu, int G, int lane, int wave) {
    const int gw = vcu * NWAVES + wave, NGW = G * NWAVES;
    const bf16* og = (const bf16*)(p->ws + WS_OG); const float* lse = (const float*)(p->ws + WS_LSE); bf16* mrg = (bf16*)(p->ws + WS_MRG);
    for (int t = gw; t < NTOK; t += NGW) {
        const int h = lane >> 3;
        const float l0 = lse[(size_t)t * 8 + h], l1 = lse[(size_t)NTOK * 8 + (size_t)t * 8 + h], l2 = lse[(size_t)2 * NTOK * 8 + (size_t)t * 8 + h];
        const float mx = fmaxf(l0, fmaxf(l1, l2)); float w0 = __expf(l0 - mx), w1 = __expf(l1 - mx), w2 = __expf(l2 - mx); const float inv = 1.0f / (w0 + w1 + w2); w0 *= inv; w1 *= inv; w2 *= inv;
        const v4u a = *((const GAS v4u*)(og + (size_t)t * 512) + lane), b = *((const GAS v4u*)(og + (size_t)NTOK * 512 + (size_t)t * 512) + lane), c = *((const GAS v4u*)(og + (size_t)2 * NTOK * 512 + (size_t)t * 512) + lane);
        v4u o;
#define MRG1(f) o.f = pk2(w0 * bflo(a.f) + w1 * bflo(b.f) + w2 * bflo(c.f), w0 * bfhi(a.f) + w1 * bfhi(b.f) + w2 * bfhi(c.f))
        MRG1(x); MRG1(y); MRG1(z); MRG1(w);
#undef MRG1
        *((GAS v4u*)(mrg + (size_t)t * 512) + lane) = o;
    }
}

__global__ void __launch_bounds__(NTHREADS, 2) fwd_kernel(Params p_unused) {
    extern __shared__ __attribute__((aligned(16))) unsigned char lds_raw[];
    LAS unsigned char* lds = (LAS unsigned char*)lds_raw;
    const int G = gridDim.x; const int bx = blockIdx.x; const int vcu = (G % 8 == 0) ? (bx % 8) * (G / 8) + bx / 8 : bx;
    int wv = __builtin_amdgcn_readfirstlane((int)threadIdx.x >> 6); asm volatile("" : "+s"(wv));
    { const int tid = opaque_tid(wv); for (int u = tid; u < (LDS_BYTES - LDSCTL_OFF) / 4; u += NTHREADS) ((LAS unsigned*)(lds + LDSCTL_OFF))[u] = 0u; }
    __syncthreads();
    XcdBarrier bar = xcd_barrier_post((unsigned*)(params_ptr()->ws + WS_CTL) + CW_BAR, (volatile LAS unsigned*)(lds + MISC_OFF) + 8);
    int ph = 0;
#ifdef TM_MASK
    unsigned long long tm_prev = __builtin_amdgcn_s_memrealtime(), tm_acc = 0ull;
#define TSTAMP(cls) do { const unsigned long long _n = __builtin_amdgcn_s_memrealtime(); if ((TM_MASK >> (cls)) & 1u) tm_acc += _n - tm_prev; tm_prev = _n; } while (0)
#else
#define TSTAMP(cls) do { } while (0)
#endif
#define SEAM() do { ++ph; if (ph >= params_ptr()->ph_hi) return; if (ph > params_ptr()->ph_lo) xcd_barrier(bar, wv); } while (0)
#define RUN (ph >= params_ptr()->ph_lo)
#define TL() const PP p = params_ptr(); unsigned char* ws = p->ws; (void)ws; const int tid = opaque_tid(wv), lane = tid & 63, wave = wv; (void)lane; (void)wave

    if (RUN) { TL(); p0_prologue(p, lds, vcu, G, tid, lane, wave); } SEAM(); TSTAMP(0);
    if (RUN) { TL(); p1_modulate(p, lds, vcu, G, tid, lane, wave); } SEAM(); TSTAMP(1);

    for (int layer = 0; layer < 2; ++layer) {
        if (layer == 0) {
            if (RUN) { const PP p = params_ptr(); unsigned char* ws = p->ws; pg8::Gemm g{(const bf16*)(ws + WS_H), (const bf16*)(ws + WS_WIN0), NTOK, N_IN0, DM}; pg8::StaticOrder S; S.init(NTOK, N_IN0, G, bx, 0);
              pg8::EpiBf16 E{(bf16*)(ws + WS_PROJ), N_IN0}; pg8::gemm_phase(wv, lds, g, S, E); } SEAM(); TSTAMP(2);
            if (RUN) { TL(); p3_mla_prep(p, vcu, G, lane, wave); } SEAM(); TSTAMP(3);
            if (RUN) { const PP p = params_ptr(); unsigned char* ws = p->ws; pg8::Gemm g{(const bf16*)(ws + WS_A2), (const bf16*)(ws + WS_WUP), NTOK, N_UP, K_UP}; pg8::StaticOrder S; S.init(NTOK, N_UP, G, bx, 0);
              pg8::EpiBf16 E{(bf16*)(ws + WS_QKV2), N_UP}; pg8::gemm_phase(wv, lds, g, S, E); } SEAM(); TSTAMP(4);
            if (RUN) { TL(); LAS float* tab = (LAS float*)(lds + att::L_TAB);
              __syncthreads();
              for (int i = tid; i < 8 * 465; i += NTHREADS) tab[i] = p->in[5][i] * att::LOG2E;
              __syncthreads();
              const int nk = (MOE_TILES - vcu + G - 1) / G; int nmla = 0; for (int r = vcu; r < 2048; r += G) ++nmla;
              { PolNA cur, nx; bool pre = false; int u = 0;
                for (int r = vcu; r < 2048; r += G, ++u) { if (u == 0) cur.init(r, ws, tab); const bool hn = r + G < 2048; if (hn) nx.init(r + G, ws, tab);
                  CvtRider<true> rd; const int k = nmla * 16 + u * 8 + wv, k1 = u * 8 + wv;
                  rd.init(p, 0, k < nk ? k * G + vcu : -1, k1 * G + vcu < moe1_split(G) ? k1 * G + vcu : -1, 1); att::attn_unit(wv, cur, lds, rd, nx, hn, pre); pre = hn; cur = nx; } } TSTAMP(5);
              { PolMLA cur, nx; bool pre = false; int u = 0;
                for (int r = vcu; r < 2048; r += G, ++u) { if (u == 0) cur.init(r, ws); const bool hn = r + G < 2048; if (hn) nx.init(r + G, ws);
                  CvtStream rd; const int k = (u * 8 + wv) * 2; rd.init(p, k < nk ? k * G + vcu : -1, k + 1 < nk ? (k + 1) * G + vcu : -1); att::attn_unit_pipe(wv, cur, lds, rd, nx, hn, pre); pre = hn; cur = nx; } }
              { const int lane2 = opaque_tid(wv) & 63;
                for (int k = nmla * 16 + nmla * 8 + wv; k < nk; k += 8) { const CvtTile T = moe_tile(p, 0, k * G + vcu, 1); f32x4 w[16]; cvt_tile_load(T, lane2, w); cvt_tile_store_any(T, lane2, w); } } } SEAM(); TSTAMP(6);
            if (RUN) { const PP p = params_ptr(); unsigned char* ws = p->ws; pg8::Gemm g{(const bf16*)(ws + WS_ATT), (const bf16*)(ws + WS_WOUT0), NTOK, DM, DM}; pg8::StaticOrder S; S.init(NTOK, DM, G, bx, 0);
              pg8::EpiBf16 E{(bf16*)(ws + WS_MIX), DM}; pg8::gemm_phase(wv, lds, g, S, E); } SEAM(); TSTAMP(7);
        } else {
            if (RUN) { const PP p = params_ptr(); unsigned char* ws = p->ws; pg8::Gemm g{(const bf16*)(ws + WS_H), (const bf16*)(ws + WS_WDIL), NTOK, N_DIL, DM}; pg8::StaticOrder S; S.init(NTOK, N_DIL, G, bx, 0);
              pg8::EpiBf16Dil E{(bf16*)(ws + WS_QKV), N_DIL, (const float2*)(ws + WS_ROPE_H)}; pg8::gemm_phase(wv, lds, g, S, E); } SEAM(); TSTAMP(14);
            if (RUN) { const PP p = params_ptr(); unsigned char* ws = p->ws; __syncthreads();
              const int nk = (moe1_split(G) - vcu + G - 1) / G; int nna = 0; for (int r = vcu; r < 2048; r += G) ++nna; const int it = nna;
              dil_skew(wv, p, lds, vcu, G);
              { const int lane = opaque_tid(wv) & 63; for (int k = it * 8 + wv; k < nk; k += 8) { const CvtTile T = moe_tile(p, 1, k * G + vcu, 1); f32x4 w[16]; cvt_tile_load(T, lane, w); cvt_tile_store<true>(T, lane, w); } } } SEAM(); TSTAMP(16);
            if (RUN) { TL(); merge_phase(p, vcu, G, lane, wave); } SEAM(); TSTAMP(17);
            if (RUN) { const PP p = params_ptr(); unsigned char* ws = p->ws; pg8::Gemm g{(const bf16*)(ws + WS_MRG), (const bf16*)(ws + WS_WOUT1), NTOK, DM, 512}; pg8::StaticOrder S; S.init(NTOK, DM, G, bx, 0);
              pg8::EpiBf16 E{(bf16*)(ws + WS_MIX), DM}; pg8::gemm_phase(wv, lds, g, S, E); } SEAM(); TSTAMP(18);
        }
        if (RUN) { TL(); if (layer == 0) pc_post_mixer(p, 0, lds, vcu, G, tid, lane, wave); else pc_post_mixer(p, 1, lds, vcu, G, tid, lane, wave); } SEAM(); TSTAMP(8);
        if (RUN) { TL(); topk_phase(p, lds, tid, lane, wave);
          if (bx >= 2 * NEXP) {
            const int it_end = layer == 0 ? moe1_split2(G) : MOE_TILES;
            for (int it = (layer == 0 ? moe1_split(G) : moe1_split2(G)) + (bx - 2 * NEXP) * 8 + wave; it < it_end; it += (G - 2 * NEXP) * 8) { const CvtTile T = moe_tile(p, 1, it, 1); f32x4 w[16]; cvt_tile_load(T, lane, w); cvt_tile_store<true>(T, lane, w); } } } SEAM(); TSTAMP(9);
        { constexpr int MR = 2 * NEXP * CAP;
            if (RUN) { const PP p = params_ptr(); unsigned char* ws = p->ws; pg8::StaticOrder S; S.init(MR, 2 * FF, G, bx, 1); const int* ix = (const int*)(ws + WS_IDX);
              { pg8::Gemm g{(const bf16*)(ws + WS_H), (const bf16*)(ws + WS_W13 + (layer ? W13_L1OFF : 0)), MR, 2 * FF, DM};
                  pg8::EpiSwiGluF8 E{ws + WS_HH, FF, 1.0f / W13_QS}; pg8::gemm_phase<pg8::EpiSwiGluF8, pg8::StaticOrder, true, true>(wv, lds, g, S, E, ix); } } SEAM(); TSTAMP(11);
            if (RUN) { const PP p = params_ptr(); unsigned char* ws = p->ws; pg8::Gemm g{(const bf16*)(ws + WS_HH), (const bf16*)(ws + WS_W2 + (layer ? W2_L1OFF : 0)), MR, DM, FF}; pg8::StaticOrder S; S.init(MR, DM, G, bx, 1);
              { pg8::EpiF8S E{ws + WS_YE, DM, YE_QS / W2_QS}; pg8::gemm_phase<pg8::EpiF8S, pg8::StaticOrder, false, true>(wv, lds, g, S, E); } } SEAM(); TSTAMP(12);
        }
        if (RUN) { TL(); pd_post_moe(p, layer, lds, vcu, G, tid, lane, wave);
        }
        if (layer == 0) SEAM();
        TSTAMP(13);
    }
#ifdef TM_MASK
    if (blockIdx.x == 0) { const unsigned long long t0 = __builtin_amdgcn_s_memrealtime(); while (__builtin_amdgcn_s_memrealtime() - t0 < TM_AMP * tm_acc) __builtin_amdgcn_s_sleep(8); }
#endif
#undef TL
#undef SEAM
}


extern "C" void kernel_launch(void* const* d_in, const int* in_sizes, int n_in, void* d_out, int out_size, void* d_ws, size_t ws_size, hipStream_t stream) {
    static int grid = 0;
    if (grid == 0) {
        if (n_in != 25 || out_size != NTOK * DM || ws_size < WS_END) { fprintf(stderr, "kernel_launch: unexpected shapes (n_in %d, out %d, ws %zu, need %zu); nothing launched\n", n_in, out_size, ws_size, (size_t)WS_END); grid = -1; return; }
        int dev = 0, cus = 0, per_cu = 0;
        if (hipGetDevice(&dev) != hipSuccess || hipDeviceGetAttribute(&cus, hipDeviceAttributeMultiprocessorCount, dev) != hipSuccess) { grid = -1; return; }
        if (hipFuncSetAttribute((const void*)fwd_kernel, hipFuncAttributeMaxDynamicSharedMemorySize, LDS_BYTES) != hipSuccess) { fprintf(stderr, "kernel_launch: hipFuncSetAttribute failed\n"); grid = -1; return; }
        if (hipOccupancyMaxActiveBlocksPerMultiprocessor(&per_cu, (const void*)fwd_kernel, NTHREADS, LDS_BYTES) != hipSuccess || per_cu < 1) fprintf(stderr, "kernel_launch: occupancy query reports %d\n", per_cu);
        (void)hipGetLastError();
        grid = cus;
    }
    if (grid < 0) return;
    if (hipMemsetAsync((char*)d_ws + WS_CTL, 0, CTL_ZERO_BYTES, stream) != hipSuccess) return;
    Params p{};
    for (int i = 0; i < 25; ++i) p.in[i] = (const float*)d_in[i];
    p.out = (float*)d_out; p.ws = (unsigned char*)d_ws;
#ifndef PH_HI
#define PH_HI 1000
#endif
    p.ph_lo = 0; p.ph_hi = PH_HI;
    hipLaunchKernelGGL(fwd_kernel, dim3(grid), dim3(NTHREADS), LDS_BYTES, stream, p);
    const hipError_t le = hipPeekAtLastError();
    if (le != hipSuccess) fprintf(stderr, "kernel_launch: launch failed: %s\n", hipGetErrorName(le));
}
```
